# Optimizing an MI355X kernel written in HIP

```python
import math, functools
import jax, jax.numpy as jnp
from jax import lax
import numpy as np


D_MODEL = 2048
BATCH = 4
SEQ = 2048
DEPTH = 1
DEC_BATCH = 128
DEC_SEQ = 4
PAST_LEN = 8192
PAGE_SIZE = 128

HEAD_DIM = 64
ATTN_WIDTH = D_MODEL // 2
N_HEADS = ATTN_WIDTH // HEAD_DIM
N_KV_HEADS = max(1, N_HEADS // 8)
GROUP = N_HEADS // N_KV_HEADS
WINDOW = 128
BLOCK = 128
GMLP_WIDTH = D_MODEL - ATTN_WIDTH
GMLP_HEADS = 8
GMLP_HEAD_DIM = GMLP_WIDTH // GMLP_HEADS
CHUNK = 128
D_FF = 4 * D_MODEL
NUM_BUCKETS = 32
MAX_DISTANCE = 128
EPS = 1e-6

Q_COLS = N_HEADS * HEAD_DIM
KV_COLS = N_KV_HEADS * HEAD_DIM
IN_COLS = Q_COLS + 2 * KV_COLS + 2 * GMLP_WIDTH
SPLITS = (Q_COLS, Q_COLS + KV_COLS, Q_COLS + 2 * KV_COLS, Q_COLS + 2 * KV_COLS + GMLP_WIDTH)

kernel_name = 'hymba_swa_sink_gmlp_decoder_step'


def rmsnorm(x, gain):
    x32 = x.astype(jnp.float32)
    y = x32 * lax.rsqrt(jnp.mean(x32 * x32, axis=-1, keepdims=True) + EPS)
    return (y * gain.astype(jnp.float32)).astype(x.dtype)


def adaln_params(c, w_ada, b_ada):
    mod = jax.nn.silu(c) @ w_ada + b_ada
    return jnp.split(mod[:, None, :], 6, axis=-1)


def t5_bucket(dist):
    n = jnp.maximum(dist, 0)
    max_exact = NUM_BUCKETS // 2
    nf = jnp.maximum(n, 1).astype(jnp.float32)
    large = max_exact + (jnp.log(nf / max_exact) / math.log(MAX_DISTANCE / max_exact)
                         * (NUM_BUCKETS - max_exact)).astype(jnp.int32)
    large = jnp.minimum(large, NUM_BUCKETS - 1)
    return jnp.where(n < max_exact, n, large)


def rel_bias(dist, rel_table):
    b = rel_table[t5_bucket(dist)].astype(jnp.float32)
    b = jnp.transpose(b, (2, 0, 1))
    return b.reshape(N_KV_HEADS, GROUP, dist.shape[0], dist.shape[1])


def sink_attend(q, k, v, bias, valid, sinks):
    scale = HEAD_DIM ** -0.5
    logits = jnp.einsum('...qkgd,...jkd->...kgqj', q, k).astype(jnp.float32) * scale + bias
    logits = jnp.where(valid, logits, -1e30)
    sink = sinks.astype(jnp.float32).reshape(N_KV_HEADS, GROUP)[:, :, None, None]
    m = jnp.maximum(jnp.max(logits, axis=-1, keepdims=True), sink)
    p = jnp.exp(logits - m)
    probs = p / (jnp.sum(p, axis=-1, keepdims=True) + jnp.exp(sink - m))
    return jnp.einsum('...kgqj,...jkd->...qkgd', probs.astype(v.dtype), v)


def attention_prompt(q, k, v, rel_table, sinks):
    B, S = q.shape[:2]
    nb = S // BLOCK
    qb = q.reshape(B, nb, BLOCK, N_KV_HEADS, GROUP, HEAD_DIM)
    pad = ((0, 0), (BLOCK, 0), (0, 0), (0, 0))
    k_prev = jnp.pad(k, pad)[:, :S].reshape(B, nb, BLOCK, N_KV_HEADS, HEAD_DIM)
    v_prev = jnp.pad(v, pad)[:, :S].reshape(B, nb, BLOCK, N_KV_HEADS, HEAD_DIM)
    kb = jnp.concatenate([k_prev, k.reshape(B, nb, BLOCK, N_KV_HEADS, HEAD_DIM)], axis=2)
    vb = jnp.concatenate([v_prev, v.reshape(B, nb, BLOCK, N_KV_HEADS, HEAD_DIM)], axis=2)
    qi = jnp.arange(BLOCK)[:, None]
    kj = jnp.arange(2 * BLOCK)[None, :]
    dist = BLOCK + qi - kj
    key_pos = jnp.arange(nb)[:, None, None] * BLOCK - BLOCK + kj[None]
    valid = (dist >= 0) & (dist < WINDOW) & (key_pos >= 0)
    out = sink_attend(qb, kb, vb, rel_bias(dist, rel_table), valid[:, None, None], sinks)
    return out.reshape(B, S, ATTN_WIDTH)


def attention_sample(q, k, v, cache_k, cache_v, rel_table, sinks):
    DB, T = q.shape[:2]
    W = cache_k.shape[1]
    kk = jnp.concatenate([cache_k, k], axis=1)
    vv = jnp.concatenate([cache_v, v], axis=1)
    dist = W + jnp.arange(T)[:, None] - jnp.arange(W + T)[None, :]
    valid = (dist >= 0) & (dist < WINDOW)
    out = sink_attend(q, kk, vv, rel_bias(dist, rel_table), valid, sinks)
    return out.reshape(DB, T, ATTN_WIDTH)


def gmlp_spatial_gate(u, v, w_s, b_s, v_gain):
    B, S, _ = u.shape
    L = min(S, CHUNK)
    n = S // L
    u = u.reshape(B, n, L, GMLP_HEADS, GMLP_HEAD_DIM)
    v = rmsnorm(v.reshape(B, n, L, GMLP_HEADS, GMLP_HEAD_DIM), v_gain)
    w = jnp.tril(w_s[:, :L, :L])
    mixed = jnp.einsum('hij,bnjhc->bnihc', w, v) + jnp.transpose(b_s[:, :L])[None, None, :, :, None]
    out = (u * mixed).reshape(B, S, GMLP_WIDTH)
    return out, v.reshape(B, S, GMLP_HEADS, GMLP_HEAD_DIM)


def trunk_layer(x, c, attend, w_ada, b_ada, g_pre_mix, w_in, gmlp_v_gain, gmlp_w_s, gmlp_b_s,
                g_attn_out, g_gmlp_out, w_out, g_post_mix, g_pre_ff, w_ff1, w_ff2, g_post_ff):
    B, S, _ = x.shape
    sh_m, sc_m, gt_m, sh_f, sc_f, gt_f = adaln_params(c, w_ada, b_ada)
    h = rmsnorm(x, g_pre_mix) * (1 + sc_m) + sh_m
    q, k, v, gu, gv = jnp.split(h @ w_in, SPLITS, axis=-1)
    q = q.reshape(B, S, N_KV_HEADS, GROUP, HEAD_DIM)
    k = k.reshape(B, S, N_KV_HEADS, HEAD_DIM)
    v = v.reshape(B, S, N_KV_HEADS, HEAD_DIM)
    attn_out = attend(q, k, v)
    gmlp_out, v_rows = gmlp_spatial_gate(jax.nn.gelu(gu), jax.nn.gelu(gv), gmlp_w_s, gmlp_b_s, gmlp_v_gain)
    merged = jnp.concatenate([rmsnorm(attn_out, g_attn_out), rmsnorm(gmlp_out, g_gmlp_out)], axis=-1)
    x = x + gt_m * rmsnorm(merged @ w_out, g_post_mix)
    h = rmsnorm(x, g_pre_ff) * (1 + sc_f) + sh_f
    f = jnp.square(jax.nn.relu(h @ w_ff1)) @ w_ff2
    x = x + gt_f * rmsnorm(f, g_post_ff)
    return x, k, v, v_rows


def setup_inputs(seed: int = 0) -> dict:
    key = jax.random.key(seed)
    ks = jax.random.split(key, 24)
    f32 = jnp.float32

    def nrm(k, shape, scale):
        return jax.random.normal(k, shape, f32) * scale

    cw = min(WINDOW, PAST_LEN)
    d_s = D_MODEL ** -0.5
    return {
        'x_prompt': nrm(ks[0], (BATCH, SEQ, D_MODEL), 1.0),
        'x_sample': nrm(ks[1], (DEC_BATCH, DEC_SEQ, D_MODEL), 1.0),
        'cache_k': nrm(ks[2], (DEPTH, DEC_BATCH, cw, N_KV_HEADS, HEAD_DIM), 1.0),
        'cache_v': nrm(ks[3], (DEPTH, DEC_BATCH, cw, N_KV_HEADS, HEAD_DIM), 1.0),
        'c_prompt': nrm(ks[4], (BATCH, D_MODEL), 1.0),
        'c_sample': nrm(ks[5], (DEC_BATCH, D_MODEL), 1.0),
        'rel_bias_table': nrm(ks[6], (NUM_BUCKETS, N_HEADS), 0.5),
        'w_ada': nrm(ks[7], (DEPTH, D_MODEL, 6 * D_MODEL), 0.5 * d_s),
        'b_ada': nrm(ks[8], (DEPTH, 6 * D_MODEL), 0.02),
        'g_pre_mix': 1.0 + nrm(ks[9], (DEPTH, D_MODEL), 0.05),
        'w_in': nrm(ks[10], (DEPTH, D_MODEL, IN_COLS), d_s),
        'attn_sinks': nrm(ks[11], (DEPTH, N_HEADS), 1.0),
        'gmlp_v_gain': 1.0 + nrm(ks[12], (DEPTH, GMLP_HEADS, GMLP_HEAD_DIM), 0.05),
        'gmlp_w_s': nrm(ks[13], (DEPTH, GMLP_HEADS, CHUNK, CHUNK), CHUNK ** -0.5),
        'gmlp_b_s': 1.0 + nrm(ks[14], (DEPTH, GMLP_HEADS, CHUNK), 0.05),
        'g_attn_out': 1.0 + nrm(ks[15], (DEPTH, ATTN_WIDTH), 0.05),
        'g_gmlp_out': 1.0 + nrm(ks[16], (DEPTH, GMLP_WIDTH), 0.05),
        'w_out': nrm(ks[17], (DEPTH, D_MODEL, D_MODEL), d_s),
        'g_post_mix': 1.0 + nrm(ks[18], (DEPTH, D_MODEL), 0.05),
        'g_pre_ff': 1.0 + nrm(ks[19], (DEPTH, D_MODEL), 0.05),
        'w_ff1': nrm(ks[20], (DEPTH, D_MODEL, D_FF), d_s),
        'w_ff2': nrm(ks[21], (DEPTH, D_FF, D_MODEL), D_FF ** -0.5),
        'g_post_ff': 1.0 + nrm(ks[22], (DEPTH, D_MODEL), 0.05),
    }


def reference(x_prompt, x_sample, cache_k, cache_v, c_prompt, c_sample, rel_bias_table, w_ada, b_ada,
              g_pre_mix, w_in, attn_sinks, gmlp_v_gain, gmlp_w_s, gmlp_b_s, g_attn_out, g_gmlp_out,
              w_out, g_post_mix, g_pre_ff, w_ff1, w_ff2, g_post_ff):
    y_p, y_s = x_prompt, x_sample
    kp_rows, vp_rows, ks_rows, vs_rows, gv_rows = [], [], [], [], []
    cw_prompt = min(WINDOW, x_prompt.shape[1])
    for l in range(DEPTH):
        weights = (w_ada[l], b_ada[l], g_pre_mix[l], w_in[l], gmlp_v_gain[l], gmlp_w_s[l], gmlp_b_s[l],
                   g_attn_out[l], g_gmlp_out[l], w_out[l], g_post_mix[l], g_pre_ff[l], w_ff1[l], w_ff2[l],
                   g_post_ff[l])
        attend_p = functools.partial(attention_prompt, rel_table=rel_bias_table, sinks=attn_sinks[l])
        attend_s = functools.partial(attention_sample, cache_k=cache_k[l], cache_v=cache_v[l],
                                     rel_table=rel_bias_table, sinks=attn_sinks[l])
        y_p, k_p, v_p, _ = trunk_layer(y_p, c_prompt, attend_p, *weights)
        y_s, k_s, v_s, gv_s = trunk_layer(y_s, c_sample, attend_s, *weights)
        kp_rows.append(k_p[:, k_p.shape[1] - cw_prompt:])
        vp_rows.append(v_p[:, v_p.shape[1] - cw_prompt:])
        ks_rows.append(k_s)
        vs_rows.append(v_s)
        gv_rows.append(gv_s)
    new_k_prompt = jnp.stack(kp_rows, axis=0)
    new_v_prompt = jnp.stack(vp_rows, axis=0)
    new_k_sample = jnp.stack(ks_rows, axis=0)
    new_v_sample = jnp.stack(vs_rows, axis=0)
    gmlp_v_sample = jnp.stack(gv_rows, axis=0)
    return (y_p, y_s, new_k_prompt, new_v_prompt, new_k_sample, new_v_sample, gmlp_v_sample)
```

```cpp
#include <hip/hip_runtime.h>
#include <hip/hip_cooperative_groups.h>
#include <cstdio>
#include <cstdint>
#include <cmath>
namespace cg = cooperative_groups;

#ifndef MK_N_LAUNCHES
#define MK_N_LAUNCHES 1
#endif
#ifndef MK_CG_SYNC
#define MK_CG_SYNC 1
#endif

namespace pg8 {
#define PG8_LAS __attribute__((address_space(3)))
typedef unsigned short bf16_t;
typedef short bf16x8 __attribute__((ext_vector_type(8)));
typedef float f32x4 __attribute__((ext_vector_type(4)));
typedef unsigned u32x4 __attribute__((ext_vector_type(4)));
typedef unsigned u32x2 __attribute__((ext_vector_type(2)));
constexpr int BM = 256, BK = 64, HALF = 128, HTB = HALF * BK * 2, STAGE_BYTES = 8 * HTB, NXCD = 8, WGM = 8;

__host__ __device__ __forceinline__ int lds_byte(int r, int c) { const int st = (r >> 4) * 2 + (c >> 5), rr = r & 15, cc = c & 31, ob = rr * 64 + cc * 2; return st * 1024 + (ob ^ (((ob >> 9) & 1) << 5)); }
__host__ __device__ __forceinline__ void stage_rc(int b, int& R, int& C) { const int st = b / 1024, sb = b % 1024, swz = sb ^ (((sb >> 9) & 1) << 5); R = (st >> 1) * 16 + swz / 64; C = (st & 1) * 32 + (swz % 64) / 2; }
__host__ __device__ __forceinline__ int perm32(int rho) { const int n = rho >> 4, i = rho & 15; return 8 * (i >> 2) + 4 * n + (i & 3); }

struct Unit { int pm, pn; };
struct Gemm { const bf16_t* A; const bf16_t* Bt; int M, N, K; };

struct StaticOrder {
    int nM, nN, nwg, G, c;
    __host__ __device__ void init(int M, int N, int G_, int c_) { nM = M / BM; nN = N / BM; nwg = nM * nN; G = G_; c = c_; }
    __host__ __device__ bool next(int i, Unit& u) const {
        const long L = (long)i * G + c; if (L >= nwg) return false;
        int wgid = (int)L; { const int q = nwg / NXCD, r = nwg % NXCD, xcd = wgid % NXCD, off = wgid / NXCD; wgid = (xcd < r ? xcd * (q + 1) : r * (q + 1) + (xcd - r) * q) + off; }
        const int nig = WGM * nN, gid = wgid / nig, fm = gid * WGM, gsz = (nM - fm) < WGM ? (nM - fm) : WGM;
        u.pm = fm + ((wgid % nig) % gsz); u.pn = (wgid % nig) / gsz; return true;
    }
    __device__ __forceinline__ void a_ready(const Unit&) const {}
    __device__ __forceinline__ void done(const Unit&) const {}
};

__device__ __forceinline__ unsigned cvt_pk_bf16(float lo, float hi) { unsigned r; asm volatile("v_cvt_pk_bf16_f32 %0, %1, %2" : "=v"(r) : "v"(lo), "v"(hi)); return r; }

__device__ __forceinline__ float gelu_tanh(float x) {
    const float u = x * (0.7978845608028654f + 0.035677408136300125f * x * x);
    const float e = __builtin_amdgcn_exp2f(-2.885390081777927f * u);
    return x * __builtin_amdgcn_rcpf(1.0f + e);
}

constexpr int OY = 0, OKP = 17825792, OVP = 17891328, OKS = 17956864, OVS = 18022400, OGV = 18087936, OUT_TOTAL = 18612224;
constexpr float QSCALE = 0.125f * 1.4426950408889634f;

struct EpiInProj {
    static constexpr bool PERM = true, AFTER_DRAIN = false, MID = false;
    bf16_t *Q, *Kb, *Vb, *GU, *GV; float* out;
    __device__ __forceinline__ void unit_start(const Unit&, int, int) const {}
    __device__ __forceinline__ void mid(f32x4 (&)[2][2][4][2], int, int, int) const {}
    __device__ __forceinline__ void operator()(const f32x4 (&acc)[2][2][4][2], const Unit& u, int wr, int wc, int fr, int fq, int) const {
        const int row0 = u.pm * BM + wr * 64 + fr, cl = wc * 32 + 8 * fq;
        if (u.pn < 4) {
#pragma unroll
            for (int ai = 0; ai < 2; ++ai)
#pragma unroll
                for (int m = 0; m < 4; ++m) { bf16_t* rowp = Q + (size_t)(row0 + ai * HALF + m * 16) * 1024 + u.pn * 256 + cl;
#pragma unroll
                    for (int bj = 0; bj < 2; ++bj) { const f32x4 v0 = acc[ai][bj][m][0] * QSCALE, v1 = acc[ai][bj][m][1] * QSCALE;
                        u32x4 w; w.x = cvt_pk_bf16(v0[0], v0[1]); w.y = cvt_pk_bf16(v0[2], v0[3]); w.z = cvt_pk_bf16(v1[0], v1[1]); w.w = cvt_pk_bf16(v1[2], v1[3]);
                        *(u32x4*)(rowp + bj * HALF) = w; } }
        } else if (u.pn == 4) {
#pragma unroll
            for (int ai = 0; ai < 2; ++ai)
#pragma unroll
                for (int m = 0; m < 4; ++m) { const int row = row0 + ai * HALF + m * 16;
#pragma unroll
                    for (int bj = 0; bj < 2; ++bj) { const f32x4 v0 = acc[ai][bj][m][0], v1 = acc[ai][bj][m][1];
                        u32x4 w; w.x = cvt_pk_bf16(v0[0], v0[1]); w.y = cvt_pk_bf16(v0[2], v0[3]); w.z = cvt_pk_bf16(v1[0], v1[1]); w.w = cvt_pk_bf16(v1[2], v1[3]);
                        bf16_t* base = bj == 0 ? Kb : Vb;
                        *(u32x4*)(base + (size_t)row * 128 + cl) = w;
                        float* o = nullptr;
                        if (row < 8192) { const int t = row & 2047; if (t >= 1920) o = out + (bj == 0 ? OKP : OVP) + ((row >> 11) * 128 + (t - 1920)) * 128 + cl; }
                        else o = out + (bj == 0 ? OKS : OVS) + (row - 8192) * 128 + cl;
                        if (o) { *(f32x4*)o = v0; *(f32x4*)(o + 4) = v1; } } }
        } else {
            bf16_t* base = u.pn < 9 ? GU : GV; const int coff = (u.pn < 9 ? u.pn - 5 : u.pn - 9) * 256 + cl;
#pragma unroll
            for (int ai = 0; ai < 2; ++ai)
#pragma unroll
                for (int m = 0; m < 4; ++m) { bf16_t* rowp = base + (size_t)(row0 + ai * HALF + m * 16) * 1024 + coff;
#pragma unroll
                    for (int bj = 0; bj < 2; ++bj) { const f32x4 v0 = acc[ai][bj][m][0], v1 = acc[ai][bj][m][1];
                        u32x4 w; w.x = cvt_pk_bf16(gelu_tanh(v0[0]), gelu_tanh(v0[1])); w.y = cvt_pk_bf16(gelu_tanh(v0[2]), gelu_tanh(v0[3]));
                        w.z = cvt_pk_bf16(gelu_tanh(v1[0]), gelu_tanh(v1[1])); w.w = cvt_pk_bf16(gelu_tanh(v1[2]), gelu_tanh(v1[3]));
                        *(u32x4*)(rowp + bj * HALF) = w; } }
        }
    }
};

struct EpiRelu2 {
    static constexpr bool PERM = true, AFTER_DRAIN = false, MID = false;
    bf16_t* O; int ldc;
    __device__ __forceinline__ void unit_start(const Unit&, int, int) const {}
    __device__ __forceinline__ void mid(f32x4 (&)[2][2][4][2], int, int, int) const {}
    __device__ __forceinline__ void operator()(const f32x4 (&acc)[2][2][4][2], const Unit& u, int wr, int wc, int fr, int fq, int) const {
        const int row0 = u.pm * BM + wr * 64 + fr, col0 = u.pn * BM + wc * 32 + 8 * fq;
#pragma unroll
        for (int ai = 0; ai < 2; ++ai)
#pragma unroll
            for (int m = 0; m < 4; ++m) { bf16_t* rowp = O + (size_t)(row0 + ai * HALF + m * 16) * ldc + col0;
#pragma unroll
                for (int bj = 0; bj < 2; ++bj) { f32x4 v0 = acc[ai][bj][m][0], v1 = acc[ai][bj][m][1];
#pragma unroll
                    for (int e = 0; e < 4; ++e) { const float a = fmaxf(v0[e], 0.f), b = fmaxf(v1[e], 0.f); v0[e] = a * a; v1[e] = b * b; }
                    u32x4 w; w.x = cvt_pk_bf16(v0[0], v0[1]); w.y = cvt_pk_bf16(v0[2], v0[3]); w.z = cvt_pk_bf16(v1[0], v1[1]); w.w = cvt_pk_bf16(v1[2], v1[3]);
                    *(u32x4*)(rowp + bj * HALF) = w; } }
    }
};

template <bool SCALE> struct EpiF32Ssq {
    static constexpr bool PERM = false, AFTER_DRAIN = false, MID = SCALE;
    float* O; float* ssq; const float* ssqm; PG8_LAS float* xr;
    __device__ __forceinline__ void unit_start(const Unit& u, int ui, int tid) const {
        if (SCALE) { if (tid < 256) { const float* p = ssqm + (size_t)(u.pm * BM + tid) * 24; float sa = 0.f, sg = 0.f;
#pragma unroll
                for (int i = 0; i < 4; ++i) { const f32x4 v = *(const f32x4*)(p + 4 * i); sa += (v[0] + v[1]) + (v[2] + v[3]); }
#pragma unroll
                for (int i = 4; i < 6; ++i) { const f32x4 v = *(const f32x4*)(p + 4 * i); sg += (v[0] + v[1]) + (v[2] + v[3]); }
                const float ra = 1.0f / sqrtf(sa * (1.0f / 1024.0f) + 1e-6f), rg = 1.0f / sqrtf(sg * (1.0f / 1024.0f) + 1e-6f);
                xr[(ui & 1) * 512 + tid] = ra / rg; xr[(ui & 1) * 512 + 256 + tid] = rg; } }
    }
    __device__ __forceinline__ void mid(f32x4 (&acc)[2][2][4][2], int ui, int wr, int fr) const {
        if (SCALE) {
#pragma unroll
            for (int ai = 0; ai < 2; ++ai)
#pragma unroll
                for (int m = 0; m < 4; ++m) { const float r = xr[(ui & 1) * 512 + ai * HALF + wr * 64 + m * 16 + fr];
#pragma unroll
                    for (int bj = 0; bj < 2; ++bj)
#pragma unroll
                        for (int n = 0; n < 2; ++n) acc[ai][bj][m][n] = acc[ai][bj][m][n] * r; } }
    }
    __device__ __forceinline__ void operator()(const f32x4 (&acc)[2][2][4][2], const Unit& u, int wr, int wc, int fr, int fq, int ui) const {
        const int col0 = u.pn * BM + wc * 32 + 4 * fq;
#pragma unroll
        for (int ai = 0; ai < 2; ++ai)
#pragma unroll
            for (int m = 0; m < 4; ++m) { const int rl = ai * HALF + wr * 64 + m * 16 + fr, row = u.pm * BM + rl;
                const float rg = SCALE ? xr[(ui & 1) * 512 + 256 + rl] : 1.0f; float s = 0.f;
#pragma unroll
                for (int bj = 0; bj < 2; ++bj)
#pragma unroll
                    for (int n = 0; n < 2; ++n) { const f32x4 v = acc[ai][bj][m][n] * rg; s += (v[0] * v[0] + v[1] * v[1]) + (v[2] * v[2] + v[3] * v[3]);
                        *(f32x4*)(O + (size_t)row * 2048 + col0 + bj * HALF + n * 16) = v; }
                s += __shfl_xor(s, 16); s += __shfl_xor(s, 32);
                if (fq == 0) ssq[(size_t)row * 32 + u.pn * 4 + wc] = s; }
    }
};

template <class Epi, class Sched, bool ALIGN_EPI = false, bool SP2 = false>
__device__ __forceinline__ void gemm_phase(PG8_LAS unsigned char* lds, const Gemm g, const Sched& S, const Epi& E) {
    const int tid = threadIdx.x, wid = __builtin_amdgcn_readfirstlane(tid >> 6), lane = tid & 63, wr = wid >> 2, wc = wid & 3, fr = lane & 15, fq = lane >> 4;
    const int K = g.K, nt = K / BK;
    unsigned voffA[2], voffB[2];
#pragma unroll
    for (int i = 0; i < 2; ++i) { int R, C; stage_rc(tid * 16 + i * 8192, R, C); const int Rb = Epi::PERM ? ((R & ~31) + perm32(R & 31)) : R;
        voffA[i] = (unsigned)(R * K + C) * 2u; voffB[i] = (unsigned)(Rb * K + C) * 2u; }
    const size_t kstep = (size_t)(BK * 2);
    const size_t hstep = (size_t)HALF * K * 2;
    const size_t tstep = 2 * hstep;
    const unsigned ldsw = (unsigned)wid * 1024u;
    const int aoff = lds_byte(wr * 64 + fr, fq * 8), boff = lds_byte(wc * 32 + fr, fq * 8);
#define PG8_SA(b, h) (((b) * 2 + (h)) * HTB)
#define PG8_SB(b, h) ((4 + (b) * 2 + (h)) * HTB)
#define PG8_STAGE(bufoff, gbase, voff) do { _Pragma("unroll") for (int _i = 0; _i < 2; ++_i) \
        __builtin_amdgcn_global_load_lds((const unsigned*)((const char*)(gbase) + (voff)[_i]), (PG8_LAS unsigned*)(lds + (bufoff) + ldsw + _i * 8192), 16, 0, 0); } while (0)
#define PG8_LDA(dst, b, h) do { _Pragma("unroll") for (int m = 0; m < 4; ++m) _Pragma("unroll") for (int k = 0; k < 2; ++k) dst[m][k] = *(const PG8_LAS bf16x8*)(lds + PG8_SA(b, h) + aoff + m * 2048 + k * 1024); } while (0)
#define PG8_LDB(dst, b, h) do { _Pragma("unroll") for (int n = 0; n < 2; ++n) _Pragma("unroll") for (int k = 0; k < 2; ++k) dst[n][k] = *(const PG8_LAS bf16x8*)(lds + PG8_SB(b, h) + boff + n * 2048 + k * 1024); } while (0)
#define PG8_MMA(ai, bj, At, Bt) do { __builtin_amdgcn_s_setprio(1); _Pragma("unroll") for (int m = 0; m < 4; ++m) _Pragma("unroll") for (int n = 0; n < 2; ++n) _Pragma("unroll") for (int k = 0; k < 2; ++k) \
        acc[ai][bj][m][n] = __builtin_amdgcn_mfma_f32_16x16x32_bf16(Bt[n][k], At[m][k], acc[ai][bj][m][n], 0, 0, 0); __builtin_amdgcn_s_setprio(0); } while (0)
#define PG8_WAIT_V(n) asm volatile("s_waitcnt vmcnt(" #n ")" ::: "memory")
#define PG8_WAIT_L(n) asm volatile("s_waitcnt lgkmcnt(" #n ")" ::: "memory")
#define PG8_BAR __builtin_amdgcn_s_barrier()
#define PG8_SCHED __builtin_amdgcn_sched_barrier(0)
    Unit cur, nxt; int ui = 0;
    if (!S.next(0, cur)) return;
    f32x4 acc[2][2][4][2];
#pragma unroll
    for (int a = 0; a < 2; ++a)
#pragma unroll
        for (int b = 0; b < 2; ++b)
#pragma unroll
            for (int m = 0; m < 4; ++m)
#pragma unroll
                for (int n = 0; n < 2; ++n) acc[a][b][m][n] = (f32x4){0.f, 0.f, 0.f, 0.f};
    bf16x8 At[4][2], B0[2][2], B1[2][2];
    const char* cA = (const char*)g.A + (size_t)cur.pm * tstep; const char* cB = (const char*)g.Bt + (size_t)cur.pn * tstep;
    S.a_ready(cur);
    if constexpr (SP2) {
        PG8_STAGE(PG8_SB(0, 0), cB, voffB); PG8_STAGE(PG8_SB(0, 1), cB + hstep, voffB); PG8_STAGE(PG8_SA(0, 0), cA, voffA); PG8_STAGE(PG8_SA(0, 1), cA + hstep, voffA);
        if (wr == 1) PG8_BAR;
        PG8_WAIT_V(2); PG8_BAR;
        PG8_STAGE(PG8_SB(1, 0), cB + kstep, voffB); PG8_STAGE(PG8_SA(1, 0), cA + kstep, voffA); PG8_STAGE(PG8_SB(1, 1), cB + hstep + kstep, voffB);
        PG8_WAIT_V(6); PG8_BAR;
    } else {
        PG8_STAGE(PG8_SB(0, 0), cB, voffB); PG8_STAGE(PG8_SA(0, 0), cA, voffA); PG8_STAGE(PG8_SB(0, 1), cB + hstep, voffB); PG8_STAGE(PG8_SA(0, 1), cA + hstep, voffA);
        if (wr == 1) PG8_BAR;
        PG8_WAIT_V(4); PG8_BAR;
        PG8_STAGE(PG8_SB(1, 0), cB + kstep, voffB); PG8_STAGE(PG8_SA(1, 0), cA + kstep, voffA); PG8_STAGE(PG8_SB(1, 1), cB + hstep + kstep, voffB);
        PG8_WAIT_V(6); PG8_BAR;
    }
    for (;;) {
        const bool has_next = S.next(ui + 1, nxt);
        const char* nA = has_next ? (const char*)g.A + (size_t)nxt.pm * tstep : cA; const char* nB = has_next ? (const char*)g.Bt + (size_t)nxt.pn * tstep : cB;
        if constexpr (Epi::MID) E.unit_start(cur, ui, tid);
        for (int t = 0; t < nt; t += 2) {
            const bool last = (t == nt - 2);
            const char* a1 = cA + (size_t)(t + 1) * kstep;
            const char* a2 = last ? nA : cA + (size_t)(t + 2) * kstep; const char* b2 = last ? nB : cB + (size_t)(t + 2) * kstep;
            const char* a3 = a2 + kstep; const char* b3 = b2 + kstep;
            if (last && has_next) S.a_ready(nxt);
            if constexpr (Epi::MID) { if (t == (nt >> 1)) E.mid(acc, ui, wr, fr); }
            if constexpr (SP2) {
            PG8_LDB(B0, 0, 0); PG8_LDB(B1, 0, 1); PG8_SCHED; PG8_LDA(At, 0, 0); PG8_STAGE(PG8_SA(1, 1), a1 + hstep, voffA);
            PG8_WAIT_V(8); PG8_WAIT_L(0); PG8_BAR; PG8_MMA(0, 0, At, B0); PG8_MMA(0, 1, At, B1); PG8_BAR; PG8_SCHED;
            PG8_LDA(At, 0, 1); PG8_STAGE(PG8_SB(0, 0), b2, voffB); PG8_STAGE(PG8_SB(0, 1), b2 + hstep, voffB); PG8_STAGE(PG8_SA(0, 0), a2, voffA);
            PG8_WAIT_V(8); PG8_WAIT_L(0); PG8_BAR; PG8_MMA(1, 0, At, B0); PG8_MMA(1, 1, At, B1); PG8_BAR; PG8_SCHED;
            PG8_LDB(B0, 1, 0); PG8_LDB(B1, 1, 1); PG8_SCHED; PG8_LDA(At, 1, 0); PG8_STAGE(PG8_SA(0, 1), a2 + hstep, voffA);
            PG8_WAIT_V(8); PG8_WAIT_L(0); PG8_BAR; PG8_MMA(0, 0, At, B0); PG8_MMA(0, 1, At, B1); PG8_BAR; PG8_SCHED;
            PG8_LDA(At, 1, 1); PG8_STAGE(PG8_SB(1, 0), b3, voffB); PG8_STAGE(PG8_SB(1, 1), b3 + hstep, voffB); PG8_STAGE(PG8_SA(1, 0), a3, voffA);
            PG8_WAIT_V(8); PG8_WAIT_L(0); PG8_BAR; PG8_MMA(1, 0, At, B0); PG8_MMA(1, 1, At, B1); PG8_BAR; PG8_SCHED;
            } else {
            PG8_LDB(B0, 0, 0); PG8_SCHED; PG8_LDA(At, 0, 0); PG8_STAGE(PG8_SA(1, 1), a1 + hstep, voffA);
            PG8_WAIT_L(8); PG8_BAR; PG8_WAIT_L(0); PG8_MMA(0, 0, At, B0); PG8_BAR; PG8_SCHED;
            PG8_LDB(B1, 0, 1); PG8_STAGE(PG8_SB(0, 0), b2, voffB);
            PG8_BAR; PG8_WAIT_L(0); PG8_MMA(0, 1, At, B1); PG8_BAR;
            PG8_LDA(At, 0, 1); PG8_STAGE(PG8_SA(0, 0), a2, voffA);
            PG8_BAR; PG8_WAIT_L(0); PG8_MMA(1, 0, At, B0); PG8_BAR; PG8_SCHED;
            PG8_STAGE(PG8_SB(0, 1), b2 + hstep, voffB);
            PG8_WAIT_V(6); PG8_BAR; PG8_MMA(1, 1, At, B1); PG8_BAR;
            PG8_LDB(B0, 1, 0); PG8_SCHED; PG8_LDA(At, 1, 0); PG8_STAGE(PG8_SA(0, 1), a2 + hstep, voffA);
            PG8_WAIT_L(8); PG8_BAR; PG8_WAIT_L(0); PG8_MMA(0, 0, At, B0); PG8_BAR; PG8_SCHED;
            PG8_LDB(B1, 1, 1); PG8_STAGE(PG8_SB(1, 0), b3, voffB);
            PG8_BAR; PG8_WAIT_L(0); PG8_MMA(0, 1, At, B1); PG8_BAR;
            PG8_LDA(At, 1, 1); PG8_STAGE(PG8_SA(1, 0), a3, voffA);
            PG8_BAR; PG8_WAIT_L(0); PG8_MMA(1, 0, At, B0); PG8_BAR; PG8_SCHED;
            PG8_STAGE(PG8_SB(1, 1), b3 + hstep, voffB);
            PG8_WAIT_V(6); PG8_BAR; PG8_MMA(1, 1, At, B1); PG8_BAR;
            }
        }
        if constexpr (ALIGN_EPI) { if (wr == 0) PG8_BAR; }
        if constexpr (!Epi::AFTER_DRAIN) { E(acc, cur, wr, wc, fr, fq, ui); S.done(cur); }
        if (!has_next) break;
#pragma unroll
        for (int a = 0; a < 2; ++a)
#pragma unroll
            for (int b = 0; b < 2; ++b)
#pragma unroll
                for (int m = 0; m < 4; ++m)
#pragma unroll
                    for (int n = 0; n < 2; ++n) acc[a][b][m][n] = (f32x4){0.f, 0.f, 0.f, 0.f};
        cur = nxt; cA = nA; cB = nB; ++ui;
        if constexpr (ALIGN_EPI) { if (wr == 1) PG8_BAR; }
    }
    PG8_WAIT_V(0);
    if constexpr (!ALIGN_EPI) { if (wr == 0) PG8_BAR; }
    PG8_BAR;
#undef PG8_SA
#undef PG8_SB
#undef PG8_STAGE
#undef PG8_LDA
#undef PG8_LDB
#undef PG8_MMA
#undef PG8_WAIT_V
#undef PG8_WAIT_L
#undef PG8_BAR
#undef PG8_SCHED
}
}

constexpr int NWAVES = 8;
constexpr int DM = 2048, MP = 8192, MS = 512, M = MP + MS, INC = 3328, DFF = 8192, NMOD = 12288;
constexpr float EPS = 1e-6f, LOG2E = 1.4426950408889634f;
constexpr int N_PHASES = 9;
constexpr int N_LAUNCHES = MK_N_LAUNCHES;

constexpr size_t MiB = 1u << 20;
constexpr size_t WS_CTL = 0, CTL_ZERO_BYTES = 1 * MiB;
constexpr size_t WS_WIN = 2 * MiB, WS_WOUT = 16 * MiB, WS_WFF1 = 24 * MiB, WS_WFF2 = 56 * MiB;
constexpr size_t WS_MOD = 88 * MiB;
constexpr size_t WS_SSQM = 95 * MiB, WS_SSQO = 96 * MiB, WS_SSQF = 98 * MiB;
constexpr size_t WS_H = 100 * MiB;
constexpr size_t WS_Q = 134 * MiB, WS_K = 151 * MiB, WS_V = 154 * MiB, WS_GU = 157 * MiB, WS_GV = 174 * MiB;
constexpr size_t WS_MG = 191 * MiB;
constexpr size_t WS_O = 225 * MiB;
constexpr size_t WS_F1 = 134 * MiB;
constexpr size_t WS_F = 293 * MiB;
constexpr size_t WS_END = 361 * MiB;
static_assert(WS_SSQM + (size_t)M * 24 * 4 <= WS_SSQO && WS_SSQO + (size_t)M * 32 * 4 <= WS_SSQF && WS_SSQF + (size_t)M * 32 * 4 <= WS_H, "partials");
static_assert(WS_MOD + (size_t)132 * NMOD * 4 <= WS_SSQM && WS_H + (size_t)M * DM * 2 <= WS_Q && WS_Q + (size_t)M * 1024 * 2 <= WS_K && WS_K + (size_t)M * 128 * 2 <= WS_V &&
              WS_V + (size_t)M * 128 * 2 <= WS_GU && WS_GU + (size_t)M * 1024 * 2 <= WS_GV && WS_GV + (size_t)M * 1024 * 2 <= WS_MG && WS_MG + (size_t)M * DM * 2 <= WS_O &&
              WS_O + (size_t)M * DM * 4 <= WS_F && WS_F1 + (size_t)M * DFF * 2 <= WS_F && WS_F + (size_t)M * DM * 4 <= WS_END, "d_ws map");
static_assert(WS_WIN + (size_t)INC * DM * 2 <= WS_WOUT && WS_WOUT + (size_t)DM * DM * 2 <= WS_WFF1 && WS_WFF1 + (size_t)DFF * DM * 2 <= WS_WFF2 && WS_WFF2 + (size_t)DFF * DM * 2 <= WS_MOD, "weights");
constexpr int CW_BAR = 4096;

constexpr int RING_BYTES = 131072;
constexpr int X_RATIO = 131072;
constexpr int X_BKT = X_RATIO + 4096;
constexpr int X_TAB = X_BKT + 512;
constexpr int X_PTR = X_TAB + 2048;
constexpr int X_MISC = 139264;
constexpr int LDS_BYTES = 147456;

#define GAS __attribute__((address_space(1)))
#define LAS __attribute__((address_space(3)))
typedef unsigned short bf16;
typedef unsigned v4u __attribute__((ext_vector_type(4)));
typedef unsigned v2u __attribute__((ext_vector_type(2)));
typedef float f32x4 __attribute__((ext_vector_type(4)));
typedef float f32x2 __attribute__((ext_vector_type(2)));
typedef short bf16x8 __attribute__((ext_vector_type(8)));
typedef GAS unsigned gu32;
#define RLX_AGENT __ATOMIC_RELAXED, __HIP_MEMORY_SCOPE_AGENT
#define LDS_WAIT() asm volatile("s_waitcnt lgkmcnt(0)" ::: "memory")
#define VM_WAIT() asm volatile("s_waitcnt vmcnt(0)" ::: "memory")

__device__ __forceinline__ unsigned cvtpk(float lo, float hi) { return pg8::cvt_pk_bf16(lo, hi); }
__device__ __forceinline__ float bf2f(unsigned b) { return __uint_as_float(b << 16); }
__device__ __forceinline__ float bflo(unsigned w) { return __uint_as_float(w << 16); }
__device__ __forceinline__ float bfhi(unsigned w) { return __uint_as_float(w & 0xffff0000u); }
__device__ __forceinline__ bf16x8 pack8(f32x4 a, f32x4 b) { v4u w; w.x = cvtpk(a[0], a[1]); w.y = cvtpk(a[2], a[3]); w.z = cvtpk(b[0], b[1]); w.w = cvtpk(b[2], b[3]); return __builtin_bit_cast(bf16x8, w); }
__device__ __forceinline__ float wave_sum(float v) {
#pragma unroll
    for (int o = 1; o < 64; o <<= 1) v += __shfl_xor(v, o);
    return v;
}
__device__ __forceinline__ float silu_f(float x) { return x * __builtin_amdgcn_rcpf(1.0f + __builtin_amdgcn_exp2f(-LOG2E * x)); }
#define MFMA16(a, b, c) __builtin_amdgcn_mfma_f32_16x16x32_bf16((a), (b), (c), 0, 0, 0)

#define XB_TMO      128
#define XB_XCNT(j)  (256  + 64 * (j))
#define XB_XSUB(j)  (1280 + 64 * (j))
#define XB_XGEN(j)  (2304 + 64 * (j))
#define XB_TOP      3328
#define XB_TOPGEN   3392
#define XCD_BAR_WORDS 3456
#define XB_SPIN_CAP (1u << 18)
__device__ __forceinline__ unsigned xb_ld(unsigned* p)              { return __hip_atomic_load(p, __ATOMIC_RELAXED, __HIP_MEMORY_SCOPE_AGENT); }
__device__ __forceinline__ unsigned xb_add(unsigned* p, unsigned v) { return __hip_atomic_fetch_add(p, v, __ATOMIC_RELAXED, __HIP_MEMORY_SCOPE_AGENT); }
__device__ __forceinline__ unsigned xb_xcc_id() { return (unsigned)__builtin_amdgcn_s_getreg((3 << 11) | 20) & 0xFu; }
#define XB_SPIN(cond, bar) do { unsigned _sp = 0; while (cond) { __builtin_amdgcn_s_sleep(1); \
    if ((++_sp & 255u) == 0u) { if (xb_ld(&(bar)[XB_TMO])) break; if (_sp > XB_SPIN_CAP) { atomicAdd(&(bar)[XB_TMO], 1u); break; } } } } while (0)
struct XcdBarrier { unsigned* bar; unsigned x; volatile LAS unsigned* st; };
__device__ __forceinline__ XcdBarrier xcd_barrier_post(unsigned* bar, volatile LAS unsigned* st) {
    XcdBarrier b; b.bar = bar; b.x = xb_xcc_id(); b.st = st;
    if (threadIdx.x == 0) (void)xb_add(&bar[XB_XCNT(b.x)], 1u);
    return b;
}
__device__ __forceinline__ void xcd_barrier_complete(unsigned* bar, unsigned x, unsigned& nloc, unsigned& nx) {
    const unsigned G = gridDim.x * gridDim.y * gridDim.z;
    unsigned sum, cnt, mine, sp = 0u;
    for (;;) {
        sum = 0u; cnt = 0u; mine = 0u;
#pragma unroll
        for (unsigned j = 0; j < 16; ++j) { const unsigned c = xb_ld(&bar[XB_XCNT(j)]); sum += c; cnt += (c > 0u) ? 1u : 0u; mine = (j == x) ? c : mine; }
        if (sum == G) break;
        __builtin_amdgcn_s_sleep(1);
        if ((++sp & 255u) == 0u) { if (xb_ld(&bar[XB_TMO])) break; if (sp > XB_SPIN_CAP) { atomicAdd(&bar[XB_TMO], 1u); break; } }
    }
    nloc = mine > 0u ? mine : 1u; nx = cnt > 0u ? cnt : 1u;
}
__device__ __forceinline__ void xcd_barrier(const XcdBarrier& b) {
    asm volatile("s_waitcnt vmcnt(0)" ::: "memory");
    __syncthreads();
    if (threadIdx.x == 0) {
        unsigned* bar = b.bar;
        __builtin_amdgcn_s_waitcnt(0);
        unsigned nloc = b.st[0], nx = b.st[1];
        if (nloc == 0u) { xcd_barrier_complete(bar, b.x, nloc, nx); b.st[0] = nloc; b.st[1] = nx; }
        const unsigned old = xb_add(&bar[XB_XSUB(b.x)], 1u);
        const unsigned gen = old / nloc;
        if (old + 1u == (gen + 1u) * nloc) {
            __builtin_amdgcn_fence(__ATOMIC_RELEASE, "agent");
            asm volatile("s_waitcnt vmcnt(0)" ::: "memory");
            const unsigned og = xb_add(&bar[XB_TOP], 1u);
            const unsigned tg = og / nx;
            if (og + 1u == (tg + 1u) * nx) xb_add(&bar[XB_TOPGEN], 1u);
            else XB_SPIN(xb_ld(&bar[XB_TOPGEN]) == tg, bar);
            __builtin_amdgcn_fence(__ATOMIC_ACQUIRE, "agent");
            xb_add(&bar[XB_XGEN(b.x)], 1u);
            asm volatile("s_waitcnt vmcnt(0)" ::: "memory");
        } else {
            XB_SPIN(xb_ld(&bar[XB_XGEN(b.x)]) == gen, bar);
            __builtin_amdgcn_fence(__ATOMIC_ACQUIRE, "agent");
            asm volatile("s_waitcnt vmcnt(0)" ::: "memory");
        }
    }
    __syncthreads();
}

__device__ __forceinline__ void p0_transpose_item(const float* W, int K, int N, bf16* WT, const float* kscale, LAS float* scr, int item, int lane) {
    const int nblk = N / 32, kb = item / nblk, nb = item % nblk, k0 = 64 * kb, n0 = 32 * nb;
#pragma unroll 8
    for (int i = 0; i < 32; ++i) { const int kk = 2 * i + (lane >> 5); float v = W[(size_t)(k0 + kk) * N + n0 + (lane & 31)]; if (kscale) v *= kscale[k0 + kk]; scr[kk * 33 + (lane & 31)] = v; }
    LDS_WAIT(); asm volatile("" ::: "memory");
    const int c = lane & 7;
#pragma unroll
    for (int j = 0; j < 4; ++j) { const int n = (lane >> 3) + 8 * j; const LAS float* s = scr + (8 * c) * 33 + n;
        v4u o; o.x = cvtpk(s[0 * 33], s[1 * 33]); o.y = cvtpk(s[2 * 33], s[3 * 33]); o.z = cvtpk(s[4 * 33], s[5 * 33]); o.w = cvtpk(s[6 * 33], s[7 * 33]);
        *(GAS v4u*)(WT + (size_t)(n0 + n) * K + k0 + 8 * c) = o; }
    LDS_WAIT(); asm volatile("" ::: "memory");
}

__device__ __forceinline__ void adaln_phase(LAS unsigned char* lds, int vcu, int G, int tid, int wid, int lane, const float* c_prompt, const float* c_sample,
                                            const float* w_ada, const float* b_ada, float* mod) {
    const int fr = lane & 15, g = lane >> 4;
    LAS float* scr = (LAS float*)(lds + wid * 16384);
    const unsigned wvoff = (unsigned)(((lane >> 2) * NMOD + 4 * (lane & 3)) * 4);
    const unsigned coff = (unsigned)((fr * DM + 8 * g) * 4);
    const int scr_w = (lane >> 2) * 52 + 4 * (lane & 3);
    const float* c0row = (fr < 4 ? c_prompt + (size_t)fr * DM : c_sample + (size_t)(fr - 4) * DM) + 8 * g;
    for (int strip = vcu; strip < NMOD / 48; strip += G) {
        const int n0 = strip * 48;
        f32x4 acc[9][3];
#pragma unroll
        for (int rf = 0; rf < 9; ++rf)
#pragma unroll
            for (int nf = 0; nf < 3; ++nf) acc[rf][nf] = (f32x4){0.f, 0.f, 0.f, 0.f};
        for (int kb = 0; kb < 4; ++kb) {
            const int k0 = wid * 256 + kb * 64;
            const char* wb = (const char*)(w_ada + (size_t)k0 * NMOD + n0);
            f32x4 wv[12];
#pragma unroll
            for (int i = 0; i < 12; ++i) wv[i] = *(const f32x4*)(wb + (size_t)(16 * (i / 3)) * NMOD * 4 + 64 * (i % 3) + wvoff);
#pragma unroll
            for (int i = 0; i < 12; ++i) *(LAS f32x4*)(scr + scr_w + 16 * (i / 3) * 52 + 16 * (i % 3)) = wv[i];
            LDS_WAIT(); asm volatile("" ::: "memory");
#pragma unroll 1
            for (int kk = 0; kk < 2; ++kk) {
                bf16x8 bfr[3];
#pragma unroll
                for (int nf = 0; nf < 3; ++nf) { const LAS float* s = scr + (32 * kk + 8 * g) * 52 + 16 * nf + fr;
                    bfr[nf] = pack8((f32x4){s[0], s[52], s[104], s[156]}, (f32x4){s[208], s[260], s[312], s[364]}); }
                const char* cs = (const char*)(c_sample + k0 + 32 * kk);
#pragma unroll
                for (int rf = 0; rf < 9; ++rf) {
                    f32x4 a = (f32x4){0.f, 0.f, 0.f, 0.f}, b = a;
                    if (rf == 0) { a = *(const f32x4*)(c0row + k0 + 32 * kk); b = *(const f32x4*)(c0row + k0 + 32 * kk + 4); }
                    else if (rf < 8) { const char* p = cs + (size_t)(16 * rf - 4) * DM * 4 + coff; a = *(const f32x4*)p; b = *(const f32x4*)(p + 16); }
                    else if (fr < 4) { const char* p = cs + (size_t)(16 * rf - 4) * DM * 4 + coff; a = *(const f32x4*)p; b = *(const f32x4*)(p + 16); }
#pragma unroll
                    for (int e = 0; e < 4; ++e) { a[e] = silu_f(a[e]); b[e] = silu_f(b[e]); }
                    const bf16x8 af = pack8(a, b);
#pragma unroll
                    for (int nf = 0; nf < 3; ++nf) acc[rf][nf] = MFMA16(af, bfr[nf], acc[rf][nf]); }
            }
            LDS_WAIT(); asm volatile("" ::: "memory");
        }
#pragma unroll
        for (int p = 0; p < 3; ++p) {
            __syncthreads();
            LAS float* red = (LAS float*)lds + wid * 2304;
#pragma unroll
            for (int rf = 0; rf < 9; ++rf)
#pragma unroll
                for (int i = 0; i < 4; ++i) red[(16 * rf + 4 * g + i) * 16 + fr] = acc[rf][p][i];
            __syncthreads();
            for (int e = tid; e < 2304; e += 512) { const int r = e >> 4, c = e & 15; float sum = 0.f;
#pragma unroll
                for (int w = 0; w < 8; ++w) sum += ((LAS float*)lds)[w * 2304 + e];
                if (r < 132) mod[(size_t)r * NMOD + n0 + 16 * p + c] = sum + b_ada[n0 + 16 * p + c]; }
        }
        __syncthreads();
    }
}

__device__ __forceinline__ const float* x_row(const float* xp, const float* xs, int m) { return m < MP ? xp + (size_t)m * DM : xs + (size_t)(m - MP) * DM; }
__device__ __forceinline__ int mod_row(int m) { return m < MP ? (m >> 11) : 4 + ((m - MP) >> 2); }

__device__ __forceinline__ void p1_rows(int gw, int NGW, int lane, const float* xp, const float* xs, const float* mod, const float* gpre, bf16* H) {
    for (int m = gw; m < M; m += NGW) {
        const f32x4* xr = (const f32x4*)x_row(xp, xs, m) + lane;
        const float* mr = mod + (size_t)mod_row(m) * NMOD;
        f32x4 v[8]; float s = 0.f;
#pragma unroll
        for (int j = 0; j < 8; ++j) { v[j] = xr[64 * j]; s += (v[j][0] * v[j][0] + v[j][1] * v[j][1]) + (v[j][2] * v[j][2] + v[j][3] * v[j][3]); }
        const float rstd = 1.0f / sqrtf(wave_sum(s) * (1.0f / DM) + EPS);
        v2u* o8 = (v2u*)(H + (size_t)m * DM) + lane;
#pragma unroll
        for (int j = 0; j < 8; ++j) { const int k = 4 * (lane + 64 * j);
            const f32x4 gg = *(const f32x4*)(gpre + k), sh = *(const f32x4*)(mr + k), sc = *(const f32x4*)(mr + DM + k);
            const f32x4 h = v[j] * rstd * gg * (sc + 1.0f) + sh;
            o8[64 * j] = (v2u){cvtpk(h[0], h[1]), cvtpk(h[2], h[3])}; }
    }
}
__device__ __forceinline__ void p5_rows(int gw, int NGW, int lane, const float* xp, const float* xs, const float* mod, const float* O, const float* ssqo,
                                        const float* gpost, const float* gpreff, float* out, bf16* H) {
    for (int m = gw; m < M; m += NGW) {
        const f32x4* xr = (const f32x4*)x_row(xp, xs, m) + lane;
        const f32x4* orow = (const f32x4*)(O + (size_t)m * DM) + lane;
        const float* mr = mod + (size_t)mod_row(m) * NMOD;
        const float so = wave_sum(lane < 32 ? ssqo[(size_t)m * 32 + lane] : 0.f);
        const float rstdo = 1.0f / sqrtf(so * (1.0f / DM) + EPS);
        f32x4 v[8]; float s = 0.f;
#pragma unroll
        for (int j = 0; j < 8; ++j) { const int k = 4 * (lane + 64 * j);
            const f32x4 gt = *(const f32x4*)(mr + 2 * DM + k), gp = *(const f32x4*)(gpost + k);
            v[j] = xr[64 * j] + gt * (orow[64 * j] * rstdo * gp);
            s += (v[j][0] * v[j][0] + v[j][1] * v[j][1]) + (v[j][2] * v[j][2] + v[j][3] * v[j][3]); }
        const float rstd = 1.0f / sqrtf(wave_sum(s) * (1.0f / DM) + EPS);
        f32x4* xo = (f32x4*)(out + (size_t)m * DM) + lane;
        v2u* o8 = (v2u*)(H + (size_t)m * DM) + lane;
#pragma unroll
        for (int j = 0; j < 8; ++j) { const int k = 4 * (lane + 64 * j);
            xo[64 * j] = v[j];
            const f32x4 gg = *(const f32x4*)(gpreff + k), sh = *(const f32x4*)(mr + 3 * DM + k), sc = *(const f32x4*)(mr + 4 * DM + k);
            const f32x4 h = v[j] * rstd * gg * (sc + 1.0f) + sh;
            o8[64 * j] = (v2u){cvtpk(h[0], h[1]), cvtpk(h[2], h[3])}; }
    }
}
__device__ __forceinline__ void p8_rows(int gw, int NGW, int lane, const float* mod, const float* F, const float* ssqf, const float* gpostff, float* out) {
    for (int m = gw; m < M; m += NGW) {
        const f32x4* frow = (const f32x4*)(F + (size_t)m * DM) + lane;
        f32x4* xo = (f32x4*)(out + (size_t)m * DM) + lane;
        const float* mr = mod + (size_t)mod_row(m) * NMOD;
        const float sf = wave_sum(lane < 32 ? ssqf[(size_t)m * 32 + lane] : 0.f);
        const float rstdf = 1.0f / sqrtf(sf * (1.0f / DM) + EPS);
#pragma unroll
        for (int j = 0; j < 8; ++j) { const int k = 4 * (lane + 64 * j);
            const f32x4 gt = *(const f32x4*)(mr + 5 * DM + k), gp = *(const f32x4*)(gpostff + k);
            xo[64 * j] = xo[64 * j] + gt * (frow[64 * j] * rstdf * gp); }
    }
}

constexpr int AT_K = 0, AT_V = 36864, AT_LUT = 70656;
__device__ __forceinline__ void attn_prompt_unit(LAS unsigned char* lds, int b, int nb, int h, const bf16* Qb, const bf16* Kb, const bf16* Vb, bf16* MG, float* ssqm,
                                                 const float* sinks, int tid, int wid, int lane) {
    const int kvh = h >> 3, tokq = b * 2048 + nb * 128, tokk = tokq - 128;
    const LAS int* bkt = (const LAS int*)(lds + X_BKT); const LAS float* tab = (const LAS float*)(lds + X_TAB);
    __syncthreads();
#pragma unroll
    for (int i = 0; i < 4; ++i) { const int idx = tid + 512 * i, key = idx >> 3, ch = idx & 7;
        v4u v = (v4u){0u, 0u, 0u, 0u}; if (nb > 0 || key >= 128) v = *(const v4u*)(Kb + (size_t)(tokk + key) * 128 + kvh * 64 + ch * 8);
        *(LAS v4u*)(lds + AT_K + key * 144 + ch * 16) = v; }
#pragma unroll
    for (int i = 0; i < 4; ++i) { const int idx = tid + 512 * i, key = idx & 255, ch = idx >> 8;
        v4u v = (v4u){0u, 0u, 0u, 0u}; if (nb > 0 || key >= 128) v = *(const v4u*)(Vb + (size_t)(tokk + key) * 128 + kvh * 64 + ch * 8);
        LAS unsigned short* vt = (LAS unsigned short*)(lds + AT_V) + (ch * 8) * 264 + key;
        vt[0 * 264] = (unsigned short)(v.x & 0xffffu); vt[1 * 264] = (unsigned short)(v.x >> 16); vt[2 * 264] = (unsigned short)(v.y & 0xffffu); vt[3 * 264] = (unsigned short)(v.y >> 16);
        vt[4 * 264] = (unsigned short)(v.z & 0xffffu); vt[5 * 264] = (unsigned short)(v.z >> 16); vt[6 * 264] = (unsigned short)(v.w & 0xffffu); vt[7 * 264] = (unsigned short)(v.w >> 16); }
    if (tid < 128) ((LAS float*)(lds + AT_LUT))[tid] = tab[bkt[tid] * 16 + h];
    __syncthreads();
    const int fr = lane & 15, g = lane >> 4, f0 = wid < 6 ? wid : 6, qi = 16 * wid + fr;
    const bf16* qp = Qb + (size_t)(tokq + qi) * 1024 + h * 64 + 8 * g;
    const bf16x8 q0 = *(const bf16x8*)qp, q1 = *(const bf16x8*)(qp + 32);
    f32x4 s[10];
#pragma unroll
    for (int f = 0; f < 10; ++f) { const LAS unsigned char* kp = lds + AT_K + (16 * (f0 + f) + fr) * 144 + 16 * g;
        const bf16x8 k0 = *(const LAS bf16x8*)kp, k1 = *(const LAS bf16x8*)(kp + 64);
        s[f] = MFMA16(k0, q0, ((f32x4){0.f, 0.f, 0.f, 0.f})); s[f] = MFMA16(k1, q1, s[f]); }
    const LAS float* lut = (const LAS float*)(lds + AT_LUT);
    const float sk = sinks[h] * LOG2E;
    float mx = -INFINITY;
#pragma unroll
    for (int f = 0; f < 10; ++f)
#pragma unroll
        for (int i = 0; i < 4; ++i) { const int kj = 16 * (f0 + f) + 4 * g + i, dist = 128 + qi - kj; const bool valid = (dist >= 0) && (dist < 128) && (nb > 0 || kj >= 128);
            const float v = valid ? s[f][i] + lut[dist & 127] : -INFINITY; s[f][i] = v; mx = fmaxf(mx, v); }
    mx = fmaxf(mx, __shfl_xor(mx, 16)); mx = fmaxf(mx, __shfl_xor(mx, 32)); mx = fmaxf(mx, sk);
    float l = 0.f;
#pragma unroll
    for (int f = 0; f < 10; ++f)
#pragma unroll
        for (int i = 0; i < 4; ++i) { const float p = __builtin_amdgcn_exp2f(s[f][i] - mx); s[f][i] = p; l += p; }
    l += __shfl_xor(l, 16); l += __shfl_xor(l, 32); l += __builtin_amdgcn_exp2f(sk - mx);
    const float rl = 1.0f / l;
    f32x4 o[4];
#pragma unroll
    for (int df = 0; df < 4; ++df) o[df] = (f32x4){0.f, 0.f, 0.f, 0.f};
#pragma unroll
    for (int si = 0; si < 5; ++si) { const bf16x8 pb = pack8(s[2 * si], s[2 * si + 1]); const int key0 = 16 * (f0 + 2 * si);
#pragma unroll
        for (int df = 0; df < 4; ++df) { const LAS unsigned char* vp = lds + AT_V + ((16 * df + fr) * 264 + key0 + 4 * g) * 2;
            const v2u lo = *(const LAS v2u*)vp, hi = *(const LAS v2u*)(vp + 32);
            const bf16x8 va = __builtin_bit_cast(bf16x8, ((v4u){lo.x, lo.y, hi.x, hi.y}));
            o[df] = MFMA16(va, pb, o[df]); } }
    float ss = 0.f; bf16* op = MG + (size_t)(tokq + qi) * DM + h * 64 + 4 * g;
#pragma unroll
    for (int df = 0; df < 4; ++df) { const f32x4 v = o[df] * rl; ss += (v[0] * v[0] + v[1] * v[1]) + (v[2] * v[2] + v[3] * v[3]);
        *(v2u*)(op + 16 * df) = (v2u){cvtpk(v[0], v[1]), cvtpk(v[2], v[3])}; }
    ss += __shfl_xor(ss, 16); ss += __shfl_xor(ss, 32);
    if (g == 0) ssqm[(size_t)(tokq + qi) * 24 + h] = ss;
}

constexpr int SA_K = 0, SA_V = 41472, SA_END = 84480;
__device__ __forceinline__ void attn_sample_unit(LAS unsigned char* lds, int db, const bf16* Qb, const bf16* Kb, const bf16* Vb, const float* cache_k, const float* cache_v,
                                                 bf16* MG, float* ssqm, const float* sinks, int tid, int wid, int lane) {
    const LAS int* bkt = (const LAS int*)(lds + X_BKT); const LAS float* tab = (const LAS float*)(lds + X_TAB);
    const int tok0 = MP + db * 4;
    __syncthreads();
    for (int i = tid; i < SA_END / 16; i += 512) *(LAS v4u*)(lds + i * 16) = (v4u){0u, 0u, 0u, 0u};
    __syncthreads();
#pragma unroll
    for (int i = 0; i < 8; ++i) { const int idx = tid + 512 * i, j = idx >> 5, kvh = (idx >> 4) & 1, c4 = idx & 15;
        const f32x4 kv = *(const f32x4*)(cache_k + (size_t)db * 16384 + (size_t)idx * 4), vv = *(const f32x4*)(cache_v + (size_t)db * 16384 + (size_t)idx * 4);
        *(LAS v2u*)(lds + SA_K + (kvh * 144 + j) * 144 + 8 * c4) = (v2u){cvtpk(kv[0], kv[1]), cvtpk(kv[2], kv[3])};
        const unsigned w0 = cvtpk(vv[0], vv[1]), w1 = cvtpk(vv[2], vv[3]);
        LAS unsigned short* vt = (LAS unsigned short*)(lds + SA_V) + (kvh * 64 + 4 * c4) * 168 + j;
        vt[0] = (unsigned short)(w0 & 0xffffu); vt[168] = (unsigned short)(w0 >> 16); vt[336] = (unsigned short)(w1 & 0xffffu); vt[504] = (unsigned short)(w1 >> 16); }
    if (tid < 64) { const int t = tid >> 4, kvh = (tid >> 3) & 1, ch = tid & 7;
        const v4u kv = *(const v4u*)(Kb + (size_t)(tok0 + t) * 128 + kvh * 64 + 8 * ch), vv = *(const v4u*)(Vb + (size_t)(tok0 + t) * 128 + kvh * 64 + 8 * ch);
        *(LAS v4u*)(lds + SA_K + (kvh * 144 + 128 + t) * 144 + 16 * ch) = kv;
        LAS unsigned short* vt = (LAS unsigned short*)(lds + SA_V) + (kvh * 64 + 8 * ch) * 168 + 128 + t;
        vt[0 * 168] = (unsigned short)(vv.x & 0xffffu); vt[1 * 168] = (unsigned short)(vv.x >> 16); vt[2 * 168] = (unsigned short)(vv.y & 0xffffu); vt[3 * 168] = (unsigned short)(vv.y >> 16);
        vt[4 * 168] = (unsigned short)(vv.z & 0xffffu); vt[5 * 168] = (unsigned short)(vv.z >> 16); vt[6 * 168] = (unsigned short)(vv.w & 0xffffu); vt[7 * 168] = (unsigned short)(vv.w >> 16); }
    __syncthreads();
    if (wid < 4) {
        const int fr = lane & 15, g = lane >> 4, kvh = wid >> 1, hh = 4 * wid + (fr >> 2), t = fr & 3;
        const bf16* qp = Qb + (size_t)(tok0 + t) * 1024 + hh * 64 + 8 * g;
        const bf16x8 q0 = *(const bf16x8*)qp, q1 = *(const bf16x8*)(qp + 32);
        f32x4 s[10];
#pragma unroll
        for (int f = 0; f < 9; ++f) { const LAS unsigned char* kp = lds + SA_K + (kvh * 144 + 16 * f + fr) * 144 + 16 * g;
            const bf16x8 k0 = *(const LAS bf16x8*)kp, k1 = *(const LAS bf16x8*)(kp + 64);
            s[f] = MFMA16(k0, q0, ((f32x4){0.f, 0.f, 0.f, 0.f})); s[f] = MFMA16(k1, q1, s[f]); }
        s[9] = (f32x4){0.f, 0.f, 0.f, 0.f};
        const float sk = sinks[hh] * LOG2E;
        float mx = -INFINITY;
#pragma unroll
        for (int f = 0; f < 9; ++f)
#pragma unroll
            for (int i = 0; i < 4; ++i) { const int j = 16 * f + 4 * g + i, dist = 128 + t - j; const bool valid = (dist >= 0) && (dist < 128);
                const float v = valid ? s[f][i] + tab[bkt[dist & 127] * 16 + hh] : -INFINITY; s[f][i] = v; mx = fmaxf(mx, v); }
        mx = fmaxf(mx, __shfl_xor(mx, 16)); mx = fmaxf(mx, __shfl_xor(mx, 32)); mx = fmaxf(mx, sk);
        float l = 0.f;
#pragma unroll
        for (int f = 0; f < 9; ++f)
#pragma unroll
            for (int i = 0; i < 4; ++i) { const float p = __builtin_amdgcn_exp2f(s[f][i] - mx); s[f][i] = p; l += p; }
        l += __shfl_xor(l, 16); l += __shfl_xor(l, 32); l += __builtin_amdgcn_exp2f(sk - mx);
        const float rl = 1.0f / l;
        f32x4 o[4];
#pragma unroll
        for (int df = 0; df < 4; ++df) o[df] = (f32x4){0.f, 0.f, 0.f, 0.f};
#pragma unroll
        for (int si = 0; si < 5; ++si) { const bf16x8 pb = pack8(s[2 * si], s[2 * si + 1]);
#pragma unroll
            for (int df = 0; df < 4; ++df) { const LAS unsigned char* vp = lds + SA_V + ((kvh * 64 + 16 * df + fr) * 168 + 32 * si + 4 * g) * 2;
                const v2u lo = *(const LAS v2u*)vp, hi = *(const LAS v2u*)(vp + 32);
                const bf16x8 va = __builtin_bit_cast(bf16x8, ((v4u){lo.x, lo.y, hi.x, hi.y}));
                o[df] = MFMA16(va, pb, o[df]); } }
        float ss = 0.f; bf16* op = MG + (size_t)(tok0 + t) * DM + hh * 64 + 4 * g;
#pragma unroll
        for (int df = 0; df < 4; ++df) { const f32x4 v = o[df] * rl; ss += (v[0] * v[0] + v[1] * v[1]) + (v[2] * v[2] + v[3] * v[3]);
            *(v2u*)(op + 16 * df) = (v2u){cvtpk(v[0], v[1]), cvtpk(v[2], v[3])}; }
        ss += __shfl_xor(ss, 16); ss += __shfl_xor(ss, 32);
        if (g == 0) ssqm[(size_t)(tok0 + t) * 24 + hh] = ss;
    }
}

constexpr int GM_W = 0, GM_V = 34816, GM_RED = 69632;
__device__ __forceinline__ void gmlp_prompt_unit(LAS unsigned char* lds, int b, int n, int h, const bf16* GU, const bf16* GV, const float* w_s, const float* b_s, const float* vgain,
                                                 bf16* MG, float* ssqm, int tid, int wid, int lane) {
    const int tok0 = b * 2048 + n * 128;
    __syncthreads();
#pragma unroll
    for (int ii = 0; ii < 8; ++ii) { const int idx = tid + 512 * ii, i = idx >> 5, j4 = idx & 31; f32x4 w = *(const f32x4*)(w_s + ((size_t)h * 128 + i) * 128 + 4 * j4);
#pragma unroll
        for (int e = 0; e < 4; ++e) if (4 * j4 + e > i) w[e] = 0.f;
        *(LAS v2u*)(lds + GM_W + i * 272 + 8 * j4) = (v2u){cvtpk(w[0], w[1]), cvtpk(w[2], w[3])}; }
    const int j = tid & 127, chq = tid >> 7;
    v4u vr[4]; float sq = 0.f;
#pragma unroll
    for (int ii = 0; ii < 4; ++ii) { const int ch = chq + 4 * ii; vr[ii] = *(const v4u*)(GV + (size_t)(tok0 + j) * 1024 + h * 128 + 8 * ch);
#pragma unroll
        for (int e = 0; e < 4; ++e) { const float a = bflo(vr[ii][e]), c = bfhi(vr[ii][e]); sq += a * a + c * c; } }
    ((LAS float*)(lds + GM_RED))[chq * 128 + j] = sq;
    __syncthreads();
    { const LAS float* red = (const LAS float*)(lds + GM_RED); const float tot = (red[j] + red[128 + j]) + (red[256 + j] + red[384 + j]);
      const float rstd = 1.0f / sqrtf(tot * (1.0f / 128.0f) + EPS);
      LAS unsigned short* vt = (LAS unsigned short*)(lds + GM_V);
#pragma unroll
      for (int ii = 0; ii < 4; ++ii) { const int ch = chq + 4 * ii; const f32x4 g0 = *(const f32x4*)(vgain + h * 128 + 8 * ch), g1 = *(const f32x4*)(vgain + h * 128 + 8 * ch + 4);
#pragma unroll
          for (int e = 0; e < 4; ++e) { const float ga = e < 2 ? g0[2 * e] : g1[2 * e - 4], gb = e < 2 ? g0[2 * e + 1] : g1[2 * e - 3];
              const unsigned w = cvtpk(bflo(vr[ii][e]) * rstd * ga, bfhi(vr[ii][e]) * rstd * gb);
              vt[(8 * ch + 2 * e) * 136 + j] = (unsigned short)(w & 0xffffu); vt[(8 * ch + 2 * e + 1) * 136 + j] = (unsigned short)(w >> 16); } } }
    __syncthreads();
    const int fr = lane & 15, g = lane >> 4, ns = (wid >> 1) + 1;
    f32x4 acc[8];
#pragma unroll
    for (int cf = 0; cf < 8; ++cf) acc[cf] = (f32x4){0.f, 0.f, 0.f, 0.f};
    for (int s = 0; s < ns; ++s) { const bf16x8 bw = *(const LAS bf16x8*)(lds + GM_W + (16 * wid + fr) * 272 + (32 * s + 8 * g) * 2);
#pragma unroll
        for (int cf = 0; cf < 8; ++cf) { const bf16x8 av = *(const LAS bf16x8*)(lds + GM_V + (16 * cf + fr) * 272 + (32 * s + 8 * g) * 2); acc[cf] = MFMA16(av, bw, acc[cf]); } }
    const int i = 16 * wid + fr, tok = tok0 + i; const float bs = b_s[h * 128 + i]; float ss = 0.f;
    const bf16* up = GU + (size_t)tok * 1024 + h * 128 + 4 * g; bf16* op = MG + (size_t)tok * DM + 1024 + h * 128 + 4 * g;
#pragma unroll
    for (int cf = 0; cf < 8; ++cf) { const v2u uu = *(const v2u*)(up + 16 * cf);
        f32x4 v; v[0] = bflo(uu.x) * (acc[cf][0] + bs); v[1] = bfhi(uu.x) * (acc[cf][1] + bs); v[2] = bflo(uu.y) * (acc[cf][2] + bs); v[3] = bfhi(uu.y) * (acc[cf][3] + bs);
        ss += (v[0] * v[0] + v[1] * v[1]) + (v[2] * v[2] + v[3] * v[3]);
        *(v2u*)(op + 16 * cf) = (v2u){cvtpk(v[0], v[1]), cvtpk(v[2], v[3])}; }
    ss += __shfl_xor(ss, 16); ss += __shfl_xor(ss, 32);
    if (g == 0) ssqm[(size_t)tok * 24 + 16 + h] = ss;
}

__device__ __forceinline__ void gmlp_sample_wave(int db, int h, const bf16* GU, const bf16* GV, const float* w_s, const float* b_s, const float* vgain, bf16* MG, float* ssqm, float* out, int lane) {
    const int tok0 = MP + db * 4, c = 2 * lane;
    const f32x2 gn = *(const f32x2*)(vgain + h * 128 + c);
    float vn[4][2];
#pragma unroll
    for (int t = 0; t < 4; ++t) { const unsigned w = *(const unsigned*)(GV + (size_t)(tok0 + t) * 1024 + h * 128 + c); const float a = bflo(w), b2 = bfhi(w);
        const float rstd = 1.0f / sqrtf(wave_sum(a * a + b2 * b2) * (1.0f / 128.0f) + EPS);
        vn[t][0] = a * rstd * gn[0]; vn[t][1] = b2 * rstd * gn[1];
        *(f32x2*)(out + pg8::OGV + ((size_t)(db * 4 + t) * 8 + h) * 128 + c) = (f32x2){vn[t][0], vn[t][1]}; }
#pragma unroll
    for (int i = 0; i < 4; ++i) { float m0 = b_s[h * 128 + i], m1 = m0;
#pragma unroll
        for (int jj = 0; jj <= i; ++jj) { const float w = w_s[((size_t)h * 128 + i) * 128 + jj]; m0 += w * vn[jj][0]; m1 += w * vn[jj][1]; }
        const unsigned uw = *(const unsigned*)(GU + (size_t)(tok0 + i) * 1024 + h * 128 + c);
        const float o0 = bflo(uw) * m0, o1 = bfhi(uw) * m1;
        *(unsigned*)(MG + (size_t)(tok0 + i) * DM + 1024 + h * 128 + c) = cvtpk(o0, o1);
        const float ss = wave_sum(o0 * o0 + o1 * o1);
        if (lane == 0) ssqm[(size_t)(tok0 + i) * 24 + 16 + h] = ss; }
}

__device__ __forceinline__ const float* in_ptr(LAS unsigned char* lds, int i) {
    const unsigned long long v = ((const LAS unsigned long long*)(lds + X_PTR))[i];
    const unsigned lo = __builtin_amdgcn_readfirstlane((unsigned)v), hi = __builtin_amdgcn_readfirstlane((unsigned)(v >> 32));
    return (const float*)(const GAS float*)(((unsigned long long)hi << 32) | lo);
}
struct Args { const float* in[23]; float* out; unsigned char* ws; int ph_lo, ph_hi; };
__global__ void __launch_bounds__(NWAVES * 64, 2) mk_fwd(Args args) {
    extern __shared__ __attribute__((aligned(16))) unsigned char lds_raw[];
    LAS unsigned char* lds = (LAS unsigned char*)lds_raw;
    const int tid = threadIdx.x, lane = tid & 63, wid = __builtin_amdgcn_readfirstlane(tid >> 6);
    const int G = gridDim.x, bx = blockIdx.x, vcu = (G % 8 == 0) ? (bx % 8) * (G / 8) + bx / 8 : bx;
    const int gw = vcu * NWAVES + wid, NGW = G * NWAVES;
    unsigned char* ws = args.ws;
    float* out = args.out;
    bf16* Win_t = (bf16*)(ws + WS_WIN); bf16* Wout_t = (bf16*)(ws + WS_WOUT); bf16* Wff1_t = (bf16*)(ws + WS_WFF1); bf16* Wff2_t = (bf16*)(ws + WS_WFF2);
    float* mod = (float*)(ws + WS_MOD); float* ssqm = (float*)(ws + WS_SSQM); float* ssqo = (float*)(ws + WS_SSQO); float* ssqf = (float*)(ws + WS_SSQF);
    bf16* H = (bf16*)(ws + WS_H); bf16* Qb = (bf16*)(ws + WS_Q); bf16* Kb = (bf16*)(ws + WS_K); bf16* Vb = (bf16*)(ws + WS_V); bf16* GU = (bf16*)(ws + WS_GU); bf16* GV = (bf16*)(ws + WS_GV);
    bf16* MG = (bf16*)(ws + WS_MG); float* Ob = (float*)(ws + WS_O); bf16* F1 = (bf16*)(ws + WS_F1); float* Fb = (float*)(ws + WS_F);

    for (int u = tid; u < (LDS_BYTES - X_MISC) / 4; u += NWAVES * 64) ((LAS unsigned*)(lds + X_MISC))[u] = 0u;
    if (tid < 128) { const int n = tid; int bk = n; if (n >= 16) { bk = 16 + (int)(logf((float)n / 16.0f) / 2.0794415416798357f * 16.0f); bk = bk < 31 ? bk : 31; } ((LAS int*)(lds + X_BKT))[tid] = bk; }
    ((LAS float*)(lds + X_TAB))[tid] = args.in[6][tid] * LOG2E;
    if (tid < 23) ((LAS unsigned long long*)(lds + X_PTR))[tid] = (unsigned long long)args.in[tid];
    __syncthreads();
#define INP(i) in_ptr(lds, (i))
#if !MK_CG_SYNC
    XcdBarrier bar = xcd_barrier_post((unsigned*)(ws + WS_CTL) + CW_BAR, (volatile LAS unsigned*)(lds + X_MISC));
#define GRID_BAR(seam) do { if ((seam) == 0) cg::this_grid().sync(); else xcd_barrier(bar); } while (0)
#else
#define GRID_BAR(seam) cg::this_grid().sync()
#endif
    const int lo = args.ph_lo, hi = args.ph_hi;
#ifndef PH_MASK
#define PH_MASK 0x1ff
#endif
#define IN(k) ((((PH_MASK) >> (k)) & 1) && lo <= (k) && (k) < hi)
#define BOTH(k) (IN(k) && IN((k) + 1))

    if (IN(0)) {
        adaln_phase(lds, vcu, G, tid, wid, lane, INP(4), INP(5), INP(7), INP(8), mod);
        LAS float* scr = (LAS float*)(lds + wid * 16384);
        constexpr int I_IN = (DM / 64) * (INC / 32), I_OUT = (DM / 64) * (DM / 32), I_F1 = (DM / 64) * (DFF / 32), I_F2 = (DFF / 64) * (DM / 32);
        constexpr int NITEMS = I_IN + I_OUT + I_F1 + I_F2;
        for (int it = gw; it < NITEMS; it += NGW) {
            int r = it;
            if (r < I_IN) { p0_transpose_item(INP(10), DM, INC, Win_t, nullptr, scr, r, lane); continue; } r -= I_IN;
            if (r < I_OUT) { const int kb = r / (DM / 32); p0_transpose_item(INP(17), DM, DM, Wout_t, kb < 16 ? INP(15) : INP(16) - 1024, scr, r, lane); continue; } r -= I_OUT;
            if (r < I_F1) { p0_transpose_item(INP(20), DM, DFF, Wff1_t, nullptr, scr, r, lane); continue; } r -= I_F1;
            p0_transpose_item(INP(21), DFF, DM, Wff2_t, nullptr, scr, r, lane);
        }
        if (BOTH(0)) GRID_BAR(0);
    }
    if (IN(1)) { p1_rows(gw, NGW, lane, INP(0), INP(1), mod, INP(9), H); if (BOTH(1)) GRID_BAR(1); }
    if (IN(2)) {
        pg8::Gemm g{H, Win_t, M, INC, DM}; pg8::StaticOrder S; S.init(M, INC, G, bx);
        pg8::EpiInProj E{Qb, Kb, Vb, GU, GV, out};
        pg8::gemm_phase<pg8::EpiInProj, pg8::StaticOrder, true, true>(lds, g, S, E);
        if (BOTH(2)) GRID_BAR(2);
    }
    if (IN(3)) {
        constexpr int N_AP = 1024, N_GP = 512, N_SA = 128, N_SG = 128;
        for (int r = vcu; r < N_AP; r += G) attn_prompt_unit(lds, r >> 8, (r >> 4) & 15, r & 15, Qb, Kb, Vb, MG, ssqm, INP(11), tid, wid, lane);
        for (int r = vcu; r < N_GP; r += G) gmlp_prompt_unit(lds, r >> 7, (r >> 3) & 15, r & 7, GU, GV, INP(13), INP(14), INP(12), MG, ssqm, tid, wid, lane);
        for (int r = vcu; r < N_SA; r += G) attn_sample_unit(lds, r, Qb, Kb, Vb, INP(2), INP(3), MG, ssqm, INP(11), tid, wid, lane);
        for (int r = (vcu + G - (G >> 1)) % G; r < N_SG; r += G) { const int wu = r * 8 + wid; gmlp_sample_wave(wu >> 3, wu & 7, GU, GV, INP(13), INP(14), INP(12), MG, ssqm, out, lane); }
        __syncthreads();
        if (BOTH(3)) GRID_BAR(3);
    }
    if (IN(4)) {
        pg8::Gemm g{MG, Wout_t, M, DM, DM}; pg8::StaticOrder S; S.init(M, DM, G, bx);
        pg8::EpiF32Ssq<true> E{Ob, ssqo, ssqm, (LAS float*)(lds + X_RATIO)};
        pg8::gemm_phase<pg8::EpiF32Ssq<true>, pg8::StaticOrder, true, true>(lds, g, S, E);
        if (BOTH(4)) GRID_BAR(4);
    }
    if (IN(5)) { p5_rows(gw, NGW, lane, INP(0), INP(1), mod, Ob, ssqo, INP(18), INP(19), out, H); if (BOTH(5)) GRID_BAR(5); }
    if (IN(6)) {
        pg8::Gemm g{H, Wff1_t, M, DFF, DM}; pg8::StaticOrder S; S.init(M, DFF, G, bx);
        pg8::EpiRelu2 E{F1, DFF};
        pg8::gemm_phase<pg8::EpiRelu2, pg8::StaticOrder, true, true>(lds, g, S, E);
        if (BOTH(6)) GRID_BAR(6);
    }
    if (IN(7)) {
        pg8::Gemm g{F1, Wff2_t, M, DM, DFF}; pg8::StaticOrder S; S.init(M, DM, G, bx);
        pg8::EpiF32Ssq<false> E{Fb, ssqf, nullptr, (LAS float*)(lds + X_RATIO)};
        pg8::gemm_phase<pg8::EpiF32Ssq<false>, pg8::StaticOrder, true, true>(lds, g, S, E);
        if (BOTH(7)) GRID_BAR(7);
    }
    if (IN(8)) { p8_rows(gw, NGW, lane, mod, Fb, ssqf, INP(22), out); }
#undef IN
#undef BOTH
}

extern "C" void kernel_launch(void* const* d_in, const int* in_sizes, int n_in, void* d_out, int out_size, void* d_ws, size_t ws_size, hipStream_t stream) {
    static int grid = 0;
    if (grid == 0) {
        if (n_in != 23 || out_size != pg8::OUT_TOTAL || ws_size < WS_END) { fprintf(stderr, "kernel_launch: unexpected shapes: n_in %d out %d ws %zu (need >= %zu)\n", n_in, out_size, ws_size, (size_t)WS_END); grid = -1; return; }
        int dev = 0, cus = 0, per_cu = 0;
        if (hipGetDevice(&dev) != hipSuccess || hipDeviceGetAttribute(&cus, hipDeviceAttributeMultiprocessorCount, dev) != hipSuccess) { grid = -1; return; }
        if (hipFuncSetAttribute((const void*)mk_fwd, hipFuncAttributeMaxDynamicSharedMemorySize, LDS_BYTES) != hipSuccess) { fprintf(stderr, "kernel_launch: hipFuncSetAttribute failed\n"); grid = -1; return; }
        if (hipOccupancyMaxActiveBlocksPerMultiprocessor(&per_cu, (const void*)mk_fwd, NWAVES * 64, LDS_BYTES) != hipSuccess || per_cu < 1) { fprintf(stderr, "kernel_launch: occupancy query says %d\n", per_cu); (void)hipGetLastError(); grid = -1; return; }
        grid = cus;
    }
    if (grid < 0) return;
    (void)hipMemsetAsync((char*)d_ws + WS_CTL, 0, CTL_ZERO_BYTES, stream);
    Args a{};
    for (int i = 0; i < 23; ++i) a.in[i] = (const float*)d_in[i];
    a.out = (float*)d_out; a.ws = (unsigned char*)d_ws;
    if (N_LAUNCHES == 1) {
        a.ph_lo = 0; a.ph_hi = N_PHASES;
        void* kargs[] = {&a};
        hipError_t e = hipLaunchCooperativeKernel((const void*)mk_fwd, dim3(grid), dim3(NWAVES * 64), kargs, LDS_BYTES, stream);
        if (e != hipSuccess) fprintf(stderr, "kernel_launch: cooperative launch failed: %s (grid %d)\n", hipGetErrorString(e), grid);
    } else {
        for (int p = 0; p < N_PHASES; ++p) { a.ph_lo = p; a.ph_hi = p + 1;
            hipLaunchKernelGGL(mk_fwd, dim3(grid), dim3(NWAVES * 64), LDS_BYTES, stream, a); }
    }
}
```

```cpp
#include <hip/hip_runtime.h>
#include <hip/hip_cooperative_groups.h>
#include <cstdio>
#include <cstdint>
#include <cmath>
namespace cg = cooperative_groups;

#ifndef MK_N_LAUNCHES
#define MK_N_LAUNCHES 1
#endif
#ifndef MK_CG_SYNC
#define MK_CG_SYNC 0
#endif

namespace pg8 {
#define PG8_LAS __attribute__((address_space(3)))
typedef unsigned short bf16_t;
typedef short bf16x8 __attribute__((ext_vector_type(8)));
typedef float f32x4 __attribute__((ext_vector_type(4)));
typedef unsigned u32x4 __attribute__((ext_vector_type(4)));
typedef unsigned u32x2 __attribute__((ext_vector_type(2)));
constexpr int BM = 256, BK = 64, HALF = 128, HTB = HALF * BK * 2, STAGE_BYTES = 8 * HTB, NXCD = 8, WGM = 8;

__host__ __device__ __forceinline__ int lds_byte(int r, int c) { const int st = (r >> 4) * 2 + (c >> 5), rr = r & 15, cc = c & 31, ob = rr * 64 + cc * 2; return st * 1024 + (ob ^ (((ob >> 9) & 1) << 5)); }
__host__ __device__ __forceinline__ void stage_rc(int b, int& R, int& C) { const int st = b / 1024, sb = b % 1024, swz = sb ^ (((sb >> 9) & 1) << 5); R = (st >> 1) * 16 + swz / 64; C = (st & 1) * 32 + (swz % 64) / 2; }
__host__ __device__ __forceinline__ int perm32(int rho) { const int n = rho >> 4, i = rho & 15; return 8 * (i >> 2) + 4 * n + (i & 3); }

struct Unit { int pm, pn; };
struct Gemm { const bf16_t* A; const bf16_t* Bt; int M, N, K; };

struct StaticOrder {
    int nM, nN, nwg, G, c;
    __host__ __device__ void init(int M, int N, int G_, int c_) { nM = M / BM; nN = N / BM; nwg = nM * nN; G = G_; c = c_; }
    __host__ __device__ bool next(int i, Unit& u) const {
        const long L = (long)i * G + c; if (L >= nwg) return false;
        int wgid = (int)L; { const int q = nwg / NXCD, r = nwg % NXCD, xcd = wgid % NXCD, off = wgid / NXCD; wgid = (xcd < r ? xcd * (q + 1) : r * (q + 1) + (xcd - r) * q) + off; }
        const int nig = WGM * nN, gid = wgid / nig, fm = gid * WGM, gsz = (nM - fm) < WGM ? (nM - fm) : WGM;
        u.pm = fm + ((wgid % nig) % gsz); u.pn = (wgid % nig) / gsz; return true;
    }
    __device__ __forceinline__ void a_ready(const Unit&) const {}
    __device__ __forceinline__ void done(const Unit&) const {}
};

__device__ __forceinline__ unsigned cvt_pk_bf16(float lo, float hi) { unsigned r; asm volatile("v_cvt_pk_bf16_f32 %0, %1, %2" : "=v"(r) : "v"(lo), "v"(hi)); return r; }

__device__ __forceinline__ float gelu_tanh(float x) {
    const float u = x * (0.7978845608028654f + 0.035677408136300125f * x * x);
    const float e = __builtin_amdgcn_exp2f(-2.885390081777927f * u);
    return x * __builtin_amdgcn_rcpf(1.0f + e);
}

constexpr int OY = 0, OKP = 17825792, OVP = 17891328, OKS = 17956864, OVS = 18022400, OGV = 18087936, OUT_TOTAL = 18612224;
constexpr float QSCALE = 0.125f * 1.4426950408889634f;

struct EpiInProj {
    static constexpr bool PERM = true, AFTER_DRAIN = false, MID = false;
    bf16_t *Q, *Kb, *Vb, *GU, *GV; float* out;
    __device__ __forceinline__ void unit_start(const Unit&, int, int) const {}
    __device__ __forceinline__ void mid(f32x4 (&)[2][2][4][2], int, int, int) const {}
    __device__ __forceinline__ void operator()(const f32x4 (&acc)[2][2][4][2], const Unit& u, int wr, int wc, int fr, int fq, int) const {
        const int row0 = u.pm * BM + wr * 64 + fr, cl = wc * 32 + 8 * fq;
        if (u.pn < 4) {
#pragma unroll
            for (int ai = 0; ai < 2; ++ai)
#pragma unroll
                for (int m = 0; m < 4; ++m) { bf16_t* rowp = Q + (size_t)(row0 + ai * HALF + m * 16) * 1024 + u.pn * 256 + cl;
#pragma unroll
                    for (int bj = 0; bj < 2; ++bj) { const f32x4 v0 = acc[ai][bj][m][0] * QSCALE, v1 = acc[ai][bj][m][1] * QSCALE;
                        u32x4 w; w.x = cvt_pk_bf16(v0[0], v0[1]); w.y = cvt_pk_bf16(v0[2], v0[3]); w.z = cvt_pk_bf16(v1[0], v1[1]); w.w = cvt_pk_bf16(v1[2], v1[3]);
                        *(u32x4*)(rowp + bj * HALF) = w; } }
        } else if (u.pn == 4) {
#pragma unroll
            for (int ai = 0; ai < 2; ++ai)
#pragma unroll
                for (int m = 0; m < 4; ++m) { const int row = row0 + ai * HALF + m * 16;
#pragma unroll
                    for (int bj = 0; bj < 2; ++bj) { const f32x4 v0 = acc[ai][bj][m][0], v1 = acc[ai][bj][m][1];
                        u32x4 w; w.x = cvt_pk_bf16(v0[0], v0[1]); w.y = cvt_pk_bf16(v0[2], v0[3]); w.z = cvt_pk_bf16(v1[0], v1[1]); w.w = cvt_pk_bf16(v1[2], v1[3]);
                        bf16_t* base = bj == 0 ? Kb : Vb;
                        *(u32x4*)(base + (size_t)row * 128 + cl) = w;
                        float* o = nullptr;
                        if (row < 8192) { const int t = row & 2047; if (t >= 1920) o = out + (bj == 0 ? OKP : OVP) + ((row >> 11) * 128 + (t - 1920)) * 128 + cl; }
                        else o = out + (bj == 0 ? OKS : OVS) + (row - 8192) * 128 + cl;
                        if (o) { *(f32x4*)o = v0; *(f32x4*)(o + 4) = v1; } } }
        } else {
            bf16_t* base = u.pn < 9 ? GU : GV; const int coff = (u.pn < 9 ? u.pn - 5 : u.pn - 9) * 256 + cl;
#pragma unroll
            for (int ai = 0; ai < 2; ++ai)
#pragma unroll
                for (int m = 0; m < 4; ++m) { bf16_t* rowp = base + (size_t)(row0 + ai * HALF + m * 16) * 1024 + coff;
#pragma unroll
                    for (int bj = 0; bj < 2; ++bj) { const f32x4 v0 = acc[ai][bj][m][0], v1 = acc[ai][bj][m][1];
                        u32x4 w; w.x = cvt_pk_bf16(gelu_tanh(v0[0]), gelu_tanh(v0[1])); w.y = cvt_pk_bf16(gelu_tanh(v0[2]), gelu_tanh(v0[3]));
                        w.z = cvt_pk_bf16(gelu_tanh(v1[0]), gelu_tanh(v1[1])); w.w = cvt_pk_bf16(gelu_tanh(v1[2]), gelu_tanh(v1[3]));
                        *(u32x4*)(rowp + bj * HALF) = w; } }
        }
    }
};

struct EpiRelu2 {
    static constexpr bool PERM = true, AFTER_DRAIN = false, MID = false;
    bf16_t* O; int ldc;
    __device__ __forceinline__ void unit_start(const Unit&, int, int) const {}
    __device__ __forceinline__ void mid(f32x4 (&)[2][2][4][2], int, int, int) const {}
    __device__ __forceinline__ void operator()(const f32x4 (&acc)[2][2][4][2], const Unit& u, int wr, int wc, int fr, int fq, int) const {
        const int row0 = u.pm * BM + wr * 64 + fr, col0 = u.pn * BM + wc * 32 + 8 * fq;
#pragma unroll
        for (int ai = 0; ai < 2; ++ai)
#pragma unroll
            for (int m = 0; m < 4; ++m) { bf16_t* rowp = O + (size_t)(row0 + ai * HALF + m * 16) * ldc + col0;
#pragma unroll
                for (int bj = 0; bj < 2; ++bj) { f32x4 v0 = acc[ai][bj][m][0], v1 = acc[ai][bj][m][1];
#pragma unroll
                    for (int e = 0; e < 4; ++e) { const float a = fmaxf(v0[e], 0.f), b = fmaxf(v1[e], 0.f); v0[e] = a * a; v1[e] = b * b; }
                    u32x4 w; w.x = cvt_pk_bf16(v0[0], v0[1]); w.y = cvt_pk_bf16(v0[2], v0[3]); w.z = cvt_pk_bf16(v1[0], v1[1]); w.w = cvt_pk_bf16(v1[2], v1[3]);
                    *(u32x4*)(rowp + bj * HALF) = w; } }
    }
};

template <bool SCALE> struct EpiF32Ssq {
    static constexpr bool PERM = false, AFTER_DRAIN = false, MID = SCALE;
    float* O; float* ssq; const float* ssqm; PG8_LAS float* xr;
    __device__ __forceinline__ void unit_start(const Unit& u, int ui, int tid) const {
        if (SCALE) { if (tid < 256) { const float* p = ssqm + (size_t)(u.pm * BM + tid) * 24; float sa = 0.f, sg = 0.f;
#pragma unroll
                for (int i = 0; i < 4; ++i) { const f32x4 v = *(const f32x4*)(p + 4 * i); sa += (v[0] + v[1]) + (v[2] + v[3]); }
#pragma unroll
                for (int i = 4; i < 6; ++i) { const f32x4 v = *(const f32x4*)(p + 4 * i); sg += (v[0] + v[1]) + (v[2] + v[3]); }
                const float ra = 1.0f / sqrtf(sa * (1.0f / 1024.0f) + 1e-6f), rg = 1.0f / sqrtf(sg * (1.0f / 1024.0f) + 1e-6f);
                xr[(ui & 1) * 512 + tid] = ra / rg; xr[(ui & 1) * 512 + 256 + tid] = rg; } }
    }
    __device__ __forceinline__ void mid(f32x4 (&acc)[2][2][4][2], int ui, int wr, int fr) const {
        if (SCALE) {
#pragma unroll
            for (int ai = 0; ai < 2; ++ai)
#pragma unroll
                for (int m = 0; m < 4; ++m) { const float r = xr[(ui & 1) * 512 + ai * HALF + wr * 64 + m * 16 + fr];
#pragma unroll
                    for (int bj = 0; bj < 2; ++bj)
#pragma unroll
                        for (int n = 0; n < 2; ++n) acc[ai][bj][m][n] = acc[ai][bj][m][n] * r; } }
    }
    __device__ __forceinline__ void operator()(const f32x4 (&acc)[2][2][4][2], const Unit& u, int wr, int wc, int fr, int fq, int ui) const {
        const int col0 = u.pn * BM + wc * 32 + 4 * fq;
#pragma unroll
        for (int ai = 0; ai < 2; ++ai)
#pragma unroll
            for (int m = 0; m < 4; ++m) { const int rl = ai * HALF + wr * 64 + m * 16 + fr, row = u.pm * BM + rl;
                const float rg = SCALE ? xr[(ui & 1) * 512 + 256 + rl] : 1.0f; float s = 0.f;
#pragma unroll
                for (int bj = 0; bj < 2; ++bj)
#pragma unroll
                    for (int n = 0; n < 2; ++n) { const f32x4 v = acc[ai][bj][m][n] * rg; s += (v[0] * v[0] + v[1] * v[1]) + (v[2] * v[2] + v[3] * v[3]);
                        *(f32x4*)(O + (size_t)row * 2048 + col0 + bj * HALF + n * 16) = v; }
                s += __shfl_xor(s, 16); s += __shfl_xor(s, 32);
                if (fq == 0) ssq[(size_t)row * 32 + u.pn * 4 + wc] = s; }
    }
};

template <class Epi, class Sched, bool ALIGN_EPI = false, bool SP2 = false>
__device__ __forceinline__ void gemm_phase(PG8_LAS unsigned char* lds, const Gemm g, const Sched& S, const Epi& E) {
    const int tid = threadIdx.x, wid = __builtin_amdgcn_readfirstlane(tid >> 6), lane = tid & 63, wr = wid >> 2, wc = wid & 3, fr = lane & 15, fq = lane >> 4;
    const int K = g.K, nt = K / BK;
    unsigned voffA[2], voffB[2];
#pragma unroll
    for (int i = 0; i < 2; ++i) { int R, C; stage_rc(tid * 16 + i * 8192, R, C); const int Rb = Epi::PERM ? ((R & ~31) + perm32(R & 31)) : R;
        voffA[i] = (unsigned)(R * K + C) * 2u; voffB[i] = (unsigned)(Rb * K + C) * 2u; }
    const size_t kstep = (size_t)(BK * 2);
    const size_t hstep = (size_t)HALF * K * 2;
    const size_t tstep = 2 * hstep;
    const unsigned ldsw = (unsigned)wid * 1024u;
    const int aoff = lds_byte(wr * 64 + fr, fq * 8), boff = lds_byte(wc * 32 + fr, fq * 8);
#define PG8_SA(b, h) (((b) * 2 + (h)) * HTB)
#define PG8_SB(b, h) ((4 + (b) * 2 + (h)) * HTB)
#define PG8_STAGE(bufoff, gbase, voff) do { _Pragma("unroll") for (int _i = 0; _i < 2; ++_i) \
        __builtin_amdgcn_global_load_lds((const unsigned*)((const char*)(gbase) + (voff)[_i]), (PG8_LAS unsigned*)(lds + (bufoff) + ldsw + _i * 8192), 16, 0, 0); } while (0)
#define PG8_LDA(dst, b, h) do { _Pragma("unroll") for (int m = 0; m < 4; ++m) _Pragma("unroll") for (int k = 0; k < 2; ++k) dst[m][k] = *(const PG8_LAS bf16x8*)(lds + PG8_SA(b, h) + aoff + m * 2048 + k * 1024); } while (0)
#define PG8_LDB(dst, b, h) do { _Pragma("unroll") for (int n = 0; n < 2; ++n) _Pragma("unroll") for (int k = 0; k < 2; ++k) dst[n][k] = *(const PG8_LAS bf16x8*)(lds + PG8_SB(b, h) + boff + n * 2048 + k * 1024); } while (0)
#define PG8_MMA(ai, bj, At, Bt) do { __builtin_amdgcn_s_setprio(1); _Pragma("unroll") for (int m = 0; m < 4; ++m) _Pragma("unroll") for (int n = 0; n < 2; ++n) _Pragma("unroll") for (int k = 0; k < 2; ++k) \
        acc[ai][bj][m][n] = __builtin_amdgcn_mfma_f32_16x16x32_bf16(Bt[n][k], At[m][k], acc[ai][bj][m][n], 0, 0, 0); __builtin_amdgcn_s_setprio(0); } while (0)
#define PG8_WAIT_V(n) asm volatile("s_waitcnt vmcnt(" #n ")" ::: "memory")
#define PG8_WAIT_L(n) asm volatile("s_waitcnt lgkmcnt(" #n ")" ::: "memory")
#define PG8_BAR __builtin_amdgcn_s_barrier()
#define PG8_SCHED __builtin_amdgcn_sched_barrier(0)
    Unit cur, nxt; int ui = 0;
    if (!S.next(0, cur)) return;
    f32x4 acc[2][2][4][2];
#pragma unroll
    for (int a = 0; a < 2; ++a)
#pragma unroll
        for (int b = 0; b < 2; ++b)
#pragma unroll
            for (int m = 0; m < 4; ++m)
#pragma unroll
                for (int n = 0; n < 2; ++n) acc[a][b][m][n] = (f32x4){0.f, 0.f, 0.f, 0.f};
    bf16x8 At[4][2], B0[2][2], B1[2][2];
    const char* cA = (const char*)g.A + (size_t)cur.pm * tstep; const char* cB = (const char*)g.Bt + (size_t)cur.pn * tstep;
    S.a_ready(cur);
    if constexpr (SP2) {
        PG8_STAGE(PG8_SB(0, 0), cB, voffB); PG8_STAGE(PG8_SB(0, 1), cB + hstep, voffB); PG8_STAGE(PG8_SA(0, 0), cA, voffA); PG8_STAGE(PG8_SA(0, 1), cA + hstep, voffA);
        if (wr == 1) PG8_BAR;
        PG8_WAIT_V(2); PG8_BAR;
        PG8_STAGE(PG8_SB(1, 0), cB + kstep, voffB); PG8_STAGE(PG8_SA(1, 0), cA + kstep, voffA); PG8_STAGE(PG8_SB(1, 1), cB + hstep + kstep, voffB);
        PG8_WAIT_V(6); PG8_BAR;
    } else {
        PG8_STAGE(PG8_SB(0, 0), cB, voffB); PG8_STAGE(PG8_SA(0, 0), cA, voffA); PG8_STAGE(PG8_SB(0, 1), cB + hstep, voffB); PG8_STAGE(PG8_SA(0, 1), cA + hstep, voffA);
        if (wr == 1) PG8_BAR;
        PG8_WAIT_V(4); PG8_BAR;
        PG8_STAGE(PG8_SB(1, 0), cB + kstep, voffB); PG8_STAGE(PG8_SA(1, 0), cA + kstep, voffA); PG8_STAGE(PG8_SB(1, 1), cB + hstep + kstep, voffB);
        PG8_WAIT_V(6); PG8_BAR;
    }
    for (;;) {
        const bool has_next = S.next(ui + 1, nxt);
        const char* nA = has_next ? (const char*)g.A + (size_t)nxt.pm * tstep : cA; const char* nB = has_next ? (const char*)g.Bt + (size_t)nxt.pn * tstep : cB;
        if constexpr (Epi::MID) E.unit_start(cur, ui, tid);
        for (int t = 0; t < nt; t += 2) {
            const bool last = (t == nt - 2);
            const char* a1 = cA + (size_t)(t + 1) * kstep;
            const char* a2 = last ? nA : cA + (size_t)(t + 2) * kstep; const char* b2 = last ? nB : cB + (size_t)(t + 2) * kstep;
            const char* a3 = a2 + kstep; const char* b3 = b2 + kstep;
            if (last && has_next) S.a_ready(nxt);
            if constexpr (Epi::MID) { if (t == (nt >> 1)) E.mid(acc, ui, wr, fr); }
            if constexpr (SP2) {
            PG8_LDB(B0, 0, 0); PG8_LDB(B1, 0, 1); PG8_SCHED; PG8_LDA(At, 0, 0); PG8_STAGE(PG8_SA(1, 1), a1 + hstep, voffA);
            PG8_WAIT_V(8); PG8_WAIT_L(0); PG8_BAR; PG8_MMA(0, 0, At, B0); PG8_MMA(0, 1, At, B1); PG8_BAR; PG8_SCHED;
            PG8_LDA(At, 0, 1); PG8_STAGE(PG8_SB(0, 0), b2, voffB); PG8_STAGE(PG8_SB(0, 1), b2 + hstep, voffB); PG8_STAGE(PG8_SA(0, 0), a2, voffA);
            PG8_WAIT_V(8); PG8_WAIT_L(0); PG8_BAR; PG8_MMA(1, 0, At, B0); PG8_MMA(1, 1, At, B1); PG8_BAR; PG8_SCHED;
            PG8_LDB(B0, 1, 0); PG8_LDB(B1, 1, 1); PG8_SCHED; PG8_LDA(At, 1, 0); PG8_STAGE(PG8_SA(0, 1), a2 + hstep, voffA);
            PG8_WAIT_V(8); PG8_WAIT_L(0); PG8_BAR; PG8_MMA(0, 0, At, B0); PG8_MMA(0, 1, At, B1); PG8_BAR; PG8_SCHED;
            PG8_LDA(At, 1, 1); PG8_STAGE(PG8_SB(1, 0), b3, voffB); PG8_STAGE(PG8_SB(1, 1), b3 + hstep, voffB); PG8_STAGE(PG8_SA(1, 0), a3, voffA);
            PG8_WAIT_V(8); PG8_WAIT_L(0); PG8_BAR; PG8_MMA(1, 0, At, B0); PG8_MMA(1, 1, At, B1); PG8_BAR; PG8_SCHED;
            } else {
            PG8_LDB(B0, 0, 0); PG8_SCHED; PG8_LDA(At, 0, 0); PG8_STAGE(PG8_SA(1, 1), a1 + hstep, voffA);
            PG8_WAIT_L(8); PG8_BAR; PG8_WAIT_L(0); PG8_MMA(0, 0, At, B0); PG8_BAR; PG8_SCHED;
            PG8_LDB(B1, 0, 1); PG8_STAGE(PG8_SB(0, 0), b2, voffB);
            PG8_BAR; PG8_WAIT_L(0); PG8_MMA(0, 1, At, B1); PG8_BAR;
            PG8_LDA(At, 0, 1); PG8_STAGE(PG8_SA(0, 0), a2, voffA);
            PG8_BAR; PG8_WAIT_L(0); PG8_MMA(1, 0, At, B0); PG8_BAR; PG8_SCHED;
            PG8_STAGE(PG8_SB(0, 1), b2 + hstep, voffB);
            PG8_WAIT_V(6); PG8_BAR; PG8_MMA(1, 1, At, B1); PG8_BAR;
            PG8_LDB(B0, 1, 0); PG8_SCHED; PG8_LDA(At, 1, 0); PG8_STAGE(PG8_SA(0, 1), a2 + hstep, voffA);
            PG8_WAIT_L(8); PG8_BAR; PG8_WAIT_L(0); PG8_MMA(0, 0, At, B0); PG8_BAR; PG8_SCHED;
            PG8_LDB(B1, 1, 1); PG8_STAGE(PG8_SB(1, 0), b3, voffB);
            PG8_BAR; PG8_WAIT_L(0); PG8_MMA(0, 1, At, B1); PG8_BAR;
            PG8_LDA(At, 1, 1); PG8_STAGE(PG8_SA(1, 0), a3, voffA);
            PG8_BAR; PG8_WAIT_L(0); PG8_MMA(1, 0, At, B0); PG8_BAR; PG8_SCHED;
            PG8_STAGE(PG8_SB(1, 1), b3 + hstep, voffB);
            PG8_WAIT_V(6); PG8_BAR; PG8_MMA(1, 1, At, B1); PG8_BAR;
            }
        }
        if constexpr (ALIGN_EPI) { if (wr == 0) PG8_BAR; }
        if constexpr (!Epi::AFTER_DRAIN) { E(acc, cur, wr, wc, fr, fq, ui); S.done(cur); }
        if (!has_next) break;
#pragma unroll
        for (int a = 0; a < 2; ++a)
#pragma unroll
            for (int b = 0; b < 2; ++b)
#pragma unroll
                for (int m = 0; m < 4; ++m)
#pragma unroll
                    for (int n = 0; n < 2; ++n) acc[a][b][m][n] = (f32x4){0.f, 0.f, 0.f, 0.f};
        cur = nxt; cA = nA; cB = nB; ++ui;
        if constexpr (ALIGN_EPI) { if (wr == 1) PG8_BAR; }
    }
    PG8_WAIT_V(0);
    if constexpr (!ALIGN_EPI) { if (wr == 0) PG8_BAR; }
    PG8_BAR;
#undef PG8_SA
#undef PG8_SB
#undef PG8_STAGE
#undef PG8_LDA
#undef PG8_LDB
#undef PG8_MMA
#undef PG8_WAIT_V
#undef PG8_WAIT_L
#undef PG8_BAR
#undef PG8_SCHED
}
}

constexpr int NWAVES = 8;
constexpr int DM = 2048, MP = 8192, MS = 512, M = MP + MS, INC = 3328, DFF = 8192, NMOD = 12288;
constexpr float EPS = 1e-6f, LOG2E = 1.4426950408889634f;
constexpr int N_PHASES = 9;
constexpr int N_LAUNCHES = MK_N_LAUNCHES;

constexpr size_t MiB = 1u << 20;
constexpr size_t WS_CTL = 0, CTL_ZERO_BYTES = 1 * MiB;
constexpr size_t WS_WIN = 2 * MiB, WS_WOUT = 16 * MiB, WS_WFF1 = 24 * MiB, WS_WFF2 = 56 * MiB;
constexpr size_t WS_MOD = 88 * MiB;
constexpr size_t WS_SSQM = 95 * MiB, WS_SSQO = 96 * MiB, WS_SSQF = 98 * MiB;
constexpr size_t WS_H = 100 * MiB;
constexpr size_t WS_Q = 134 * MiB, WS_K = 151 * MiB, WS_V = 154 * MiB, WS_GU = 157 * MiB, WS_GV = 174 * MiB;
constexpr size_t WS_MG = 191 * MiB;
constexpr size_t WS_O = 225 * MiB;
constexpr size_t WS_F1 = 134 * MiB;
constexpr size_t WS_F = 293 * MiB;
constexpr size_t WS_END = 361 * MiB;
static_assert(WS_SSQM + (size_t)M * 24 * 4 <= WS_SSQO && WS_SSQO + (size_t)M * 32 * 4 <= WS_SSQF && WS_SSQF + (size_t)M * 32 * 4 <= WS_H, "partials");
static_assert(WS_MOD + (size_t)132 * NMOD * 4 <= WS_SSQM && WS_H + (size_t)M * DM * 2 <= WS_Q && WS_Q + (size_t)M * 1024 * 2 <= WS_K && WS_K + (size_t)M * 128 * 2 <= WS_V &&
              WS_V + (size_t)M * 128 * 2 <= WS_GU && WS_GU + (size_t)M * 1024 * 2 <= WS_GV && WS_GV + (size_t)M * 1024 * 2 <= WS_MG && WS_MG + (size_t)M * DM * 2 <= WS_O &&
              WS_O + (size_t)M * DM * 4 <= WS_F && WS_F1 + (size_t)M * DFF * 2 <= WS_F && WS_F + (size_t)M * DM * 4 <= WS_END, "d_ws map");
static_assert(WS_WIN + (size_t)INC * DM * 2 <= WS_WOUT && WS_WOUT + (size_t)DM * DM * 2 <= WS_WFF1 && WS_WFF1 + (size_t)DFF * DM * 2 <= WS_WFF2 && WS_WFF2 + (size_t)DFF * DM * 2 <= WS_MOD, "weights");
constexpr int CW_BAR = 4096;

constexpr int RING_BYTES = 131072;
constexpr int X_RATIO = 131072;
constexpr int X_BKT = X_RATIO + 4096;
constexpr int X_TAB = X_BKT + 512;
constexpr int X_PTR = X_TAB + 2048;
constexpr int X_MISC = 139264;
constexpr int LDS_BYTES = 147456;

#define GAS __attribute__((address_space(1)))
#define LAS __attribute__((address_space(3)))
typedef unsigned short bf16;
typedef unsigned v4u __attribute__((ext_vector_type(4)));
typedef unsigned v2u __attribute__((ext_vector_type(2)));
typedef float f32x4 __attribute__((ext_vector_type(4)));
typedef float f32x2 __attribute__((ext_vector_type(2)));
typedef short bf16x8 __attribute__((ext_vector_type(8)));
typedef GAS unsigned gu32;
#define RLX_AGENT __ATOMIC_RELAXED, __HIP_MEMORY_SCOPE_AGENT
#define LDS_WAIT() asm volatile("s_waitcnt lgkmcnt(0)" ::: "memory")
#define VM_WAIT() asm volatile("s_waitcnt vmcnt(0)" ::: "memory")

__device__ __forceinline__ unsigned cvtpk(float lo, float hi) { return pg8::cvt_pk_bf16(lo, hi); }
__device__ __forceinline__ float bf2f(unsigned b) { return __uint_as_float(b << 16); }
__device__ __forceinline__ float bflo(unsigned w) { return __uint_as_float(w << 16); }
__device__ __forceinline__ float bfhi(unsigned w) { return __uint_as_float(w & 0xffff0000u); }
__device__ __forceinline__ bf16x8 pack8(f32x4 a, f32x4 b) { v4u w; w.x = cvtpk(a[0], a[1]); w.y = cvtpk(a[2], a[3]); w.z = cvtpk(b[0], b[1]); w.w = cvtpk(b[2], b[3]); return __builtin_bit_cast(bf16x8, w); }
__device__ __forceinline__ float wave_sum(float v) {
#pragma unroll
    for (int o = 1; o < 64; o <<= 1) v += __shfl_xor(v, o);
    return v;
}
__device__ __forceinline__ float silu_f(float x) { return x * __builtin_amdgcn_rcpf(1.0f + __builtin_amdgcn_exp2f(-LOG2E * x)); }
#define MFMA16(a, b, c) __builtin_amdgcn_mfma_f32_16x16x32_bf16((a), (b), (c), 0, 0, 0)

#define XB_TMO      128
#define XB_XCNT(j)  (256  + 64 * (j))
#define XB_XSUB(j)  (1280 + 64 * (j))
#define XB_XGEN(j)  (2304 + 64 * (j))
#define XB_TOP      3328
#define XB_TOPGEN   3392
#define XCD_BAR_WORDS 3456
#define XB_SPIN_CAP (1u << 18)
__device__ __forceinline__ unsigned xb_ld(unsigned* p)              { return __hip_atomic_load(p, __ATOMIC_RELAXED, __HIP_MEMORY_SCOPE_AGENT); }
__device__ __forceinline__ unsigned xb_add(unsigned* p, unsigned v) { return __hip_atomic_fetch_add(p, v, __ATOMIC_RELAXED, __HIP_MEMORY_SCOPE_AGENT); }
__device__ __forceinline__ unsigned xb_xcc_id() { return (unsigned)__builtin_amdgcn_s_getreg((3 << 11) | 20) & 0xFu; }
#define XB_SPIN(cond, bar) do { unsigned _sp = 0; while (cond) { __builtin_amdgcn_s_sleep(1); \
    if ((++_sp & 255u) == 0u) { if (xb_ld(&(bar)[XB_TMO])) break; if (_sp > XB_SPIN_CAP) { atomicAdd(&(bar)[XB_TMO], 1u); break; } } } } while (0)
struct XcdBarrier { unsigned* bar; unsigned x; volatile LAS unsigned* st; };
__device__ __forceinline__ XcdBarrier xcd_barrier_post(unsigned* bar, volatile LAS unsigned* st) {
    XcdBarrier b; b.bar = bar; b.x = xb_xcc_id(); b.st = st;
    if (threadIdx.x == 0) (void)xb_add(&bar[XB_XCNT(b.x)], 1u);
    return b;
}
__device__ __forceinline__ void xcd_barrier_complete(unsigned* bar, unsigned x, unsigned& nloc, unsigned& nx) {
    const unsigned G = gridDim.x * gridDim.y * gridDim.z;
    unsigned sum, cnt, mine, sp = 0u;
    for (;;) {
        sum = 0u; cnt = 0u; mine = 0u;
#pragma unroll
        for (unsigned j = 0; j < 16; ++j) { const unsigned c = xb_ld(&bar[XB_XCNT(j)]); sum += c; cnt += (c > 0u) ? 1u : 0u; mine = (j == x) ? c : mine; }
        if (sum == G) break;
        __builtin_amdgcn_s_sleep(1);
        if ((++sp & 255u) == 0u) { if (xb_ld(&bar[XB_TMO])) break; if (sp > XB_SPIN_CAP) { atomicAdd(&bar[XB_TMO], 1u); break; } }
    }
    nloc = mine > 0u ? mine : 1u; nx = cnt > 0u ? cnt : 1u;
}
__device__ __forceinline__ void xcd_barrier(const XcdBarrier& b) {
    asm volatile("s_waitcnt vmcnt(0)" ::: "memory");
    __syncthreads();
    if (threadIdx.x == 0) {
        unsigned* bar = b.bar;
        __builtin_amdgcn_s_waitcnt(0);
        unsigned nloc = b.st[0], nx = b.st[1];
        if (nloc == 0u) { xcd_barrier_complete(bar, b.x, nloc, nx); b.st[0] = nloc; b.st[1] = nx; }
        const unsigned old = xb_add(&bar[XB_XSUB(b.x)], 1u);
        const unsigned gen = old / nloc;
        if (old + 1u == (gen + 1u) * nloc) {
            __builtin_amdgcn_fence(__ATOMIC_RELEASE, "agent");
            asm volatile("s_waitcnt vmcnt(0)" ::: "memory");
            const unsigned og = xb_add(&bar[XB_TOP], 1u);
            const unsigned tg = og / nx;
            if (og + 1u == (tg + 1u) * nx) xb_add(&bar[XB_TOPGEN], 1u);
            else XB_SPIN(xb_ld(&bar[XB_TOPGEN]) == tg, bar);
            __builtin_amdgcn_fence(__ATOMIC_ACQUIRE, "agent");
            xb_add(&bar[XB_XGEN(b.x)], 1u);
            asm volatile("s_waitcnt vmcnt(0)" ::: "memory");
        } else {
            XB_SPIN(xb_ld(&bar[XB_XGEN(b.x)]) == gen, bar);
            __builtin_amdgcn_fence(__ATOMIC_ACQUIRE, "agent");
            asm volatile("s_waitcnt vmcnt(0)" ::: "memory");
        }
    }
    __syncthreads();
}

__device__ __forceinline__ void p0_transpose_item(const float* W, int K, int N, bf16* WT, const float* kscale, LAS float* scr, int item, int lane) {
    const int nblk = N / 32, kb = item / nblk, nb = item % nblk, k0 = 64 * kb, n0 = 32 * nb;
#pragma unroll 8
    for (int i = 0; i < 32; ++i) { const int kk = 2 * i + (lane >> 5); float v = W[(size_t)(k0 + kk) * N + n0 + (lane & 31)]; if (kscale) v *= kscale[k0 + kk]; scr[kk * 33 + (lane & 31)] = v; }
    LDS_WAIT(); asm volatile("" ::: "memory");
    const int c = lane & 7;
#pragma unroll
    for (int j = 0; j < 4; ++j) { const int n = (lane >> 3) + 8 * j; const LAS float* s = scr + (8 * c) * 33 + n;
        v4u o; o.x = cvtpk(s[0 * 33], s[1 * 33]); o.y = cvtpk(s[2 * 33], s[3 * 33]); o.z = cvtpk(s[4 * 33], s[5 * 33]); o.w = cvtpk(s[6 * 33], s[7 * 33]);
        *(GAS v4u*)(WT + (size_t)(n0 + n) * K + k0 + 8 * c) = o; }
    LDS_WAIT(); asm volatile("" ::: "memory");
}

__device__ __forceinline__ void adaln_phase(LAS unsigned char* lds, int vcu, int G, int tid, int wid, int lane, const float* c_prompt, const float* c_sample,
                                            const float* w_ada, const float* b_ada, float* mod) {
    const int fr = lane & 15, g = lane >> 4;
    LAS float* scr = (LAS float*)(lds + wid * 16384);
    const unsigned wvoff = (unsigned)(((lane >> 2) * NMOD + 4 * (lane & 3)) * 4);
    const unsigned coff = (unsigned)((fr * DM + 8 * g) * 4);
    const int scr_w = (lane >> 2) * 52 + 4 * (lane & 3);
    const float* c0row = (fr < 4 ? c_prompt + (size_t)fr * DM : c_sample + (size_t)(fr - 4) * DM) + 8 * g;
    for (int strip = vcu; strip < NMOD / 48; strip += G) {
        const int n0 = strip * 48;
        f32x4 acc[9][3];
#pragma unroll
        for (int rf = 0; rf < 9; ++rf)
#pragma unroll
            for (int nf = 0; nf < 3; ++nf) acc[rf][nf] = (f32x4){0.f, 0.f, 0.f, 0.f};
        for (int kb = 0; kb < 4; ++kb) {
            const int k0 = wid * 256 + kb * 64;
            const char* wb = (const char*)(w_ada + (size_t)k0 * NMOD + n0);
            f32x4 wv[12];
#pragma unroll
            for (int i = 0; i < 12; ++i) wv[i] = *(const f32x4*)(wb + (size_t)(16 * (i / 3)) * NMOD * 4 + 64 * (i % 3) + wvoff);
#pragma unroll
            for (int i = 0; i < 12; ++i) *(LAS f32x4*)(scr + scr_w + 16 * (i / 3) * 52 + 16 * (i % 3)) = wv[i];
            LDS_WAIT(); asm volatile("" ::: "memory");
#pragma unroll 1
            for (int kk = 0; kk < 2; ++kk) {
                bf16x8 bfr[3];
#pragma unroll
                for (int nf = 0; nf < 3; ++nf) { const LAS float* s = scr + (32 * kk + 8 * g) * 52 + 16 * nf + fr;
                    bfr[nf] = pack8((f32x4){s[0], s[52], s[104], s[156]}, (f32x4){s[208], s[260], s[312], s[364]}); }
                const char* cs = (const char*)(c_sample + k0 + 32 * kk);
#pragma unroll
                for (int rf = 0; rf < 9; ++rf) {
                    f32x4 a = (f32x4){0.f, 0.f, 0.f, 0.f}, b = a;
                    if (rf == 0) { a = *(const f32x4*)(c0row + k0 + 32 * kk); b = *(const f32x4*)(c0row + k0 + 32 * kk + 4); }
                    else if (rf < 8) { const char* p = cs + (size_t)(16 * rf - 4) * DM * 4 + coff; a = *(const f32x4*)p; b = *(const f32x4*)(p + 16); }
                    else if (fr < 4) { const char* p = cs + (size_t)(16 * rf - 4) * DM * 4 + coff; a = *(const f32x4*)p; b = *(const f32x4*)(p + 16); }
#pragma unroll
                    for (int e = 0; e < 4; ++e) { a[e] = silu_f(a[e]); b[e] = silu_f(b[e]); }
                    const bf16x8 af = pack8(a, b);
#pragma unroll
                    for (int nf = 0; nf < 3; ++nf) acc[rf][nf] = MFMA16(af, bfr[nf], acc[rf][nf]); }
            }
            LDS_WAIT(); asm volatile("" ::: "memory");
        }
#pragma unroll
        for (int p = 0; p < 3; ++p) {
            __syncthreads();
            LAS float* red = (LAS float*)lds + wid * 2304;
#pragma unroll
            for (int rf = 0; rf < 9; ++rf)
#pragma unroll
                for (int i = 0; i < 4; ++i) red[(16 * rf + 4 * g + i) * 16 + fr] = acc[rf][p][i];
            __syncthreads();
            for (int e = tid; e < 2304; e += 512) { const int r = e >> 4, c = e & 15; float sum = 0.f;
#pragma unroll
                for (int w = 0; w < 8; ++w) sum += ((LAS float*)lds)[w * 2304 + e];
                if (r < 132) mod[(size_t)r * NMOD + n0 + 16 * p + c] = sum + b_ada[n0 + 16 * p + c]; }
        }
        __syncthreads();
    }
}

__device__ __forceinline__ const float* x_row(const float* xp, const float* xs, int m) { return m < MP ? xp + (size_t)m * DM : xs + (size_t)(m - MP) * DM; }
__device__ __forceinline__ int mod_row(int m) { return m < MP ? (m >> 11) : 4 + ((m - MP) >> 2); }

__device__ __forceinline__ void p1_rows(int gw, int NGW, int lane, const float* xp, const float* xs, const float* mod, const float* gpre, bf16* H) {
    for (int m = gw; m < M; m += NGW) {
        const f32x4* xr = (const f32x4*)x_row(xp, xs, m) + lane;
        const float* mr = mod + (size_t)mod_row(m) * NMOD;
        f32x4 v[8]; float s = 0.f;
#pragma unroll
        for (int j = 0; j < 8; ++j) { v[j] = xr[64 * j]; s += (v[j][0] * v[j][0] + v[j][1] * v[j][1]) + (v[j][2] * v[j][2] + v[j][3] * v[j][3]); }
        const float rstd = 1.0f / sqrtf(wave_sum(s) * (1.0f / DM) + EPS);
        v2u* o8 = (v2u*)(H + (size_t)m * DM) + lane;
#pragma unroll
        for (int j = 0; j < 8; ++j) { const int k = 4 * (lane + 64 * j);
            const f32x4 gg = *(const f32x4*)(gpre + k), sh = *(const f32x4*)(mr + k), sc = *(const f32x4*)(mr + DM + k);
            const f32x4 h = v[j] * rstd * gg * (sc + 1.0f) + sh;
            o8[64 * j] = (v2u){cvtpk(h[0], h[1]), cvtpk(h[2], h[3])}; }
    }
}
__device__ __forceinline__ void p5_rows(int gw, int NGW, int lane, const float* xp, const float* xs, const float* mod, const float* O, const float* ssqo,
                                        const float* gpost, const float* gpreff, float* out, bf16* H) {
    for (int m = gw; m < M; m += NGW) {
        const f32x4* xr = (const f32x4*)x_row(xp, xs, m) + lane;
        const f32x4* orow = (const f32x4*)(O + (size_t)m * DM) + lane;
        const float* mr = mod + (size_t)mod_row(m) * NMOD;
        const float so = wave_sum(lane < 32 ? ssqo[(size_t)m * 32 + lane] : 0.f);
        const float rstdo = 1.0f / sqrtf(so * (1.0f / DM) + EPS);
        f32x4 v[8]; float s = 0.f;
#pragma unroll
        for (int j = 0; j < 8; ++j) { const int k = 4 * (lane + 64 * j);
            const f32x4 gt = *(const f32x4*)(mr + 2 * DM + k), gp = *(const f32x4*)(gpost + k);
            v[j] = xr[64 * j] + gt * (orow[64 * j] * rstdo * gp);
            s += (v[j][0] * v[j][0] + v[j][1] * v[j][1]) + (v[j][2] * v[j][2] + v[j][3] * v[j][3]); }
        const float rstd = 1.0f / sqrtf(wave_sum(s) * (1.0f / DM) + EPS);
        f32x4* xo = (f32x4*)(out + (size_t)m * DM) + lane;
        v2u* o8 = (v2u*)(H + (size_t)m * DM) + lane;
#pragma unroll
        for (int j = 0; j < 8; ++j) { const int k = 4 * (lane + 64 * j);
            xo[64 * j] = v[j];
            const f32x4 gg = *(const f32x4*)(gpreff + k), sh = *(const f32x4*)(mr + 3 * DM + k), sc = *(const f32x4*)(mr + 4 * DM + k);
            const f32x4 h = v[j] * rstd * gg * (sc + 1.0f) + sh;
            o8[64 * j] = (v2u){cvtpk(h[0], h[1]), cvtpk(h[2], h[3])}; }
    }
}
__device__ __forceinline__ void p8_rows(int gw, int NGW, int lane, const float* mod, const float* F, const float* ssqf, const float* gpostff, float* out) {
    for (int m = gw; m < M; m += NGW) {
        const f32x4* frow = (const f32x4*)(F + (size_t)m * DM) + lane;
        f32x4* xo = (f32x4*)(out + (size_t)m * DM) + lane;
        const float* mr = mod + (size_t)mod_row(m) * NMOD;
        const float sf = wave_sum(lane < 32 ? ssqf[(size_t)m * 32 + lane] : 0.f);
        const float rstdf = 1.0f / sqrtf(sf * (1.0f / DM) + EPS);
#pragma unroll
        for (int j = 0; j < 8; ++j) { const int k = 4 * (lane + 64 * j);
            const f32x4 gt = *(const f32x4*)(mr + 5 * DM + k), gp = *(const f32x4*)(gpostff + k);
            xo[64 * j] = xo[64 * j] + gt * (frow[64 * j] * rstdf * gp); }
    }
}

constexpr int AT_K = 0, AT_V = 36864, AT_LUT = 70656;
__device__ __forceinline__ void attn_prompt_unit(LAS unsigned char* lds, int b, int nb, int h, const bf16* Qb, const bf16* Kb, const bf16* Vb, bf16* MG, float* ssqm,
                                                 const float* sinks, int tid, int wid, int lane) {
    const int kvh = h >> 3, tokq = b * 2048 + nb * 128, tokk = tokq - 128;
    const LAS int* bkt = (const LAS int*)(lds + X_BKT); const LAS float* tab = (const LAS float*)(lds + X_TAB);
    __syncthreads();
#pragma unroll
    for (int i = 0; i < 4; ++i) { const int idx = tid + 512 * i, key = idx >> 3, ch = idx & 7;
        v4u v = (v4u){0u, 0u, 0u, 0u}; if (nb > 0 || key >= 128) v = *(const v4u*)(Kb + (size_t)(tokk + key) * 128 + kvh * 64 + ch * 8);
        *(LAS v4u*)(lds + AT_K + key * 144 + ch * 16) = v; }
#pragma unroll
    for (int i = 0; i < 4; ++i) { const int idx = tid + 512 * i, key = idx & 255, ch = idx >> 8;
        v4u v = (v4u){0u, 0u, 0u, 0u}; if (nb > 0 || key >= 128) v = *(const v4u*)(Vb + (size_t)(tokk + key) * 128 + kvh * 64 + ch * 8);
        LAS unsigned short* vt = (LAS unsigned short*)(lds + AT_V) + (ch * 8) * 264 + key;
        vt[0 * 264] = (unsigned short)(v.x & 0xffffu); vt[1 * 264] = (unsigned short)(v.x >> 16); vt[2 * 264] = (unsigned short)(v.y & 0xffffu); vt[3 * 264] = (unsigned short)(v.y >> 16);
        vt[4 * 264] = (unsigned short)(v.z & 0xffffu); vt[5 * 264] = (unsigned short)(v.z >> 16); vt[6 * 264] = (unsigned short)(v.w & 0xffffu); vt[7 * 264] = (unsigned short)(v.w >> 16); }
    if (tid < 128) ((LAS float*)(lds + AT_LUT))[tid] = tab[bkt[tid] * 16 + h];
    __syncthreads();
    const int fr = lane & 15, g = lane >> 4, f0 = wid < 6 ? wid : 6, qi = 16 * wid + fr;
    const bf16* qp = Qb + (size_t)(tokq + qi) * 1024 + h * 64 + 8 * g;
    const bf16x8 q0 = *(const bf16x8*)qp, q1 = *(const bf16x8*)(qp + 32);
    f32x4 s[10];
#pragma unroll
    for (int f = 0; f < 10; ++f) { const LAS unsigned char* kp = lds + AT_K + (16 * (f0 + f) + fr) * 144 + 16 * g;
        const bf16x8 k0 = *(const LAS bf16x8*)kp, k1 = *(const LAS bf16x8*)(kp + 64);
        s[f] = MFMA16(k0, q0, ((f32x4){0.f, 0.f, 0.f, 0.f})); s[f] = MFMA16(k1, q1, s[f]); }
    const LAS float* lut = (const LAS float*)(lds + AT_LUT);
    const float sk = sinks[h] * LOG2E;
    float mx = -INFINITY;
#pragma unroll
    for (int f = 0; f < 10; ++f)
#pragma unroll
        for (int i = 0; i < 4; ++i) { const int kj = 16 * (f0 + f) + 4 * g + i, dist = 128 + qi - kj; const bool valid = (dist >= 0) && (dist < 128) && (nb > 0 || kj >= 128);
            const float v = valid ? s[f][i] + lut[dist & 127] : -INFINITY; s[f][i] = v; mx = fmaxf(mx, v); }
    mx = fmaxf(mx, __shfl_xor(mx, 16)); mx = fmaxf(mx, __shfl_xor(mx, 32)); mx = fmaxf(mx, sk);
    float l = 0.f;
#pragma unroll
    for (int f = 0; f < 10; ++f)
#pragma unroll
        for (int i = 0; i < 4; ++i) { const float p = __builtin_amdgcn_exp2f(s[f][i] - mx); s[f][i] = p; l += p; }
    l += __shfl_xor(l, 16); l += __shfl_xor(l, 32); l += __builtin_amdgcn_exp2f(sk - mx);
    const float rl = 1.0f / l;
    f32x4 o[4];
#pragma unroll
    for (int df = 0; df < 4; ++df) o[df] = (f32x4){0.f, 0.f, 0.f, 0.f};
#pragma unroll
    for (int si = 0; si < 5; ++si) { const bf16x8 pb = pack8(s[2 * si], s[2 * si + 1]); const int key0 = 16 * (f0 + 2 * si);
#pragma unroll
        for (int df = 0; df < 4; ++df) { const LAS unsigned char* vp = lds + AT_V + ((16 * df + fr) * 264 + key0 + 4 * g) * 2;
            const v2u lo = *(const LAS v2u*)vp, hi = *(const LAS v2u*)(vp + 32);
            const bf16x8 va = __builtin_bit_cast(bf16x8, ((v4u){lo.x, lo.y, hi.x, hi.y}));
            o[df] = MFMA16(va, pb, o[df]); } }
    float ss = 0.f; bf16* op = MG + (size_t)(tokq + qi) * DM + h * 64 + 4 * g;
#pragma unroll
    for (int df = 0; df < 4; ++df) { const f32x4 v = o[df] * rl; ss += (v[0] * v[0] + v[1] * v[1]) + (v[2] * v[2] + v[3] * v[3]);
        *(v2u*)(op + 16 * df) = (v2u){cvtpk(v[0], v[1]), cvtpk(v[2], v[3])}; }
    ss += __shfl_xor(ss, 16); ss += __shfl_xor(ss, 32);
    if (g == 0) ssqm[(size_t)(tokq + qi) * 24 + h] = ss;
}

constexpr int SA_K = 0, SA_V = 41472, SA_END = 84480;
__device__ __forceinline__ void attn_sample_unit(LAS unsigned char* lds, int db, const bf16* Qb, const bf16* Kb, const bf16* Vb, const float* cache_k, const float* cache_v,
                                                 bf16* MG, float* ssqm, const float* sinks, int tid, int wid, int lane) {
    const LAS int* bkt = (const LAS int*)(lds + X_BKT); const LAS float* tab = (const LAS float*)(lds + X_TAB);
    const int tok0 = MP + db * 4;
    __syncthreads();
    for (int i = tid; i < SA_END / 16; i += 512) *(LAS v4u*)(lds + i * 16) = (v4u){0u, 0u, 0u, 0u};
    __syncthreads();
#pragma unroll
    for (int i = 0; i < 8; ++i) { const int idx = tid + 512 * i, j = idx >> 5, kvh = (idx >> 4) & 1, c4 = idx & 15;
        const f32x4 kv = *(const f32x4*)(cache_k + (size_t)db * 16384 + (size_t)idx * 4), vv = *(const f32x4*)(cache_v + (size_t)db * 16384 + (size_t)idx * 4);
        *(LAS v2u*)(lds + SA_K + (kvh * 144 + j) * 144 + 8 * c4) = (v2u){cvtpk(kv[0], kv[1]), cvtpk(kv[2], kv[3])};
        const unsigned w0 = cvtpk(vv[0], vv[1]), w1 = cvtpk(vv[2], vv[3]);
        LAS unsigned short* vt = (LAS unsigned short*)(lds + SA_V) + (kvh * 64 + 4 * c4) * 168 + j;
        vt[0] = (unsigned short)(w0 & 0xffffu); vt[168] = (unsigned short)(w0 >> 16); vt[336] = (unsigned short)(w1 & 0xffffu); vt[504] = (unsigned short)(w1 >> 16); }
    if (tid < 64) { const int t = tid >> 4, kvh = (tid >> 3) & 1, ch = tid & 7;
        const v4u kv = *(const v4u*)(Kb + (size_t)(tok0 + t) * 128 + kvh * 64 + 8 * ch), vv = *(const v4u*)(Vb + (size_t)(tok0 + t) * 128 + kvh * 64 + 8 * ch);
        *(LAS v4u*)(lds + SA_K + (kvh * 144 + 128 + t) * 144 + 16 * ch) = kv;
        LAS unsigned short* vt = (LAS unsigned short*)(lds + SA_V) + (kvh * 64 + 8 * ch) * 168 + 128 + t;
        vt[0 * 168] = (unsigned short)(vv.x & 0xffffu); vt[1 * 168] = (unsigned short)(vv.x >> 16); vt[2 * 168] = (unsigned short)(vv.y & 0xffffu); vt[3 * 168] = (unsigned short)(vv.y >> 16);
        vt[4 * 168] = (unsigned short)(vv.z & 0xffffu); vt[5 * 168] = (unsigned short)(vv.z >> 16); vt[6 * 168] = (unsigned short)(vv.w & 0xffffu); vt[7 * 168] = (unsigned short)(vv.w >> 16); }
    __syncthreads();
    if (wid < 4) {
        const int fr = lane & 15, g = lane >> 4, kvh = wid >> 1, hh = 4 * wid + (fr >> 2), t = fr & 3;
        const bf16* qp = Qb + (size_t)(tok0 + t) * 1024 + hh * 64 + 8 * g;
        const bf16x8 q0 = *(const bf16x8*)qp, q1 = *(const bf16x8*)(qp + 32);
        f32x4 s[10];
#pragma unroll
        for (int f = 0; f < 9; ++f) { const LAS unsigned char* kp = lds + SA_K + (kvh * 144 + 16 * f + fr) * 144 + 16 * g;
            const bf16x8 k0 = *(const LAS bf16x8*)kp, k1 = *(const LAS bf16x8*)(kp + 64);
            s[f] = MFMA16(k0, q0, ((f32x4){0.f, 0.f, 0.f, 0.f})); s[f] = MFMA16(k1, q1, s[f]); }
        s[9] = (f32x4){0.f, 0.f, 0.f, 0.f};
        const float sk = sinks[hh] * LOG2E;
        float mx = -INFINITY;
#pragma unroll
        for (int f = 0; f < 9; ++f)
#pragma unroll
            for (int i = 0; i < 4; ++i) { const int j = 16 * f + 4 * g + i, dist = 128 + t - j; const bool valid = (dist >= 0) && (dist < 128);
                const float v = valid ? s[f][i] + tab[bkt[dist & 127] * 16 + hh] : -INFINITY; s[f][i] = v; mx = fmaxf(mx, v); }
        mx = fmaxf(mx, __shfl_xor(mx, 16)); mx = fmaxf(mx, __shfl_xor(mx, 32)); mx = fmaxf(mx, sk);
        float l = 0.f;
#pragma unroll
        for (int f = 0; f < 9; ++f)
#pragma unroll
            for (int i = 0; i < 4; ++i) { const float p = __builtin_amdgcn_exp2f(s[f][i] - mx); s[f][i] = p; l += p; }
        l += __shfl_xor(l, 16); l += __shfl_xor(l, 32); l += __builtin_amdgcn_exp2f(sk - mx);
        const float rl = 1.0f / l;
        f32x4 o[4];
#pragma unroll
        for (int df = 0; df < 4; ++df) o[df] = (f32x4){0.f, 0.f, 0.f, 0.f};
#pragma unroll
        for (int si = 0; si < 5; ++si) { const bf16x8 pb = pack8(s[2 * si], s[2 * si + 1]);
#pragma unroll
            for (int df = 0; df < 4; ++df) { const LAS unsigned char* vp = lds + SA_V + ((kvh * 64 + 16 * df + fr) * 168 + 32 * si + 4 * g) * 2;
                const v2u lo = *(const LAS v2u*)vp, hi = *(const LAS v2u*)(vp + 32);
                const bf16x8 va = __builtin_bit_cast(bf16x8, ((v4u){lo.x, lo.y, hi.x, hi.y}));
                o[df] = MFMA16(va, pb, o[df]); } }
        float ss = 0.f; bf16* op = MG + (size_t)(tok0 + t) * DM + hh * 64 + 4 * g;
#pragma unroll
        for (int df = 0; df < 4; ++df) { const f32x4 v = o[df] * rl; ss += (v[0] * v[0] + v[1] * v[1]) + (v[2] * v[2] + v[3] * v[3]);
            *(v2u*)(op + 16 * df) = (v2u){cvtpk(v[0], v[1]), cvtpk(v[2], v[3])}; }
        ss += __shfl_xor(ss, 16); ss += __shfl_xor(ss, 32);
        if (g == 0) ssqm[(size_t)(tok0 + t) * 24 + hh] = ss;
    }
}

constexpr int GM_W = 0, GM_V = 34816, GM_RED = 69632;
__device__ __forceinline__ void gmlp_prompt_unit(LAS unsigned char* lds, int b, int n, int h, const bf16* GU, const bf16* GV, const float* w_s, const float* b_s, const float* vgain,
                                                 bf16* MG, float* ssqm, int tid, int wid, int lane) {
    const int tok0 = b * 2048 + n * 128;
    __syncthreads();
#pragma unroll
    for (int ii = 0; ii < 8; ++ii) { const int idx = tid + 512 * ii, i = idx >> 5, j4 = idx & 31; f32x4 w = *(const f32x4*)(w_s + ((size_t)h * 128 + i) * 128 + 4 * j4);
#pragma unroll
        for (int e = 0; e < 4; ++e) if (4 * j4 + e > i) w[e] = 0.f;
        *(LAS v2u*)(lds + GM_W + i * 272 + 8 * j4) = (v2u){cvtpk(w[0], w[1]), cvtpk(w[2], w[3])}; }
    const int j = tid & 127, chq = tid >> 7;
    v4u vr[4]; float sq = 0.f;
#pragma unroll
    for (int ii = 0; ii < 4; ++ii) { const int ch = chq + 4 * ii; vr[ii] = *(const v4u*)(GV + (size_t)(tok0 + j) * 1024 + h * 128 + 8 * ch);
#pragma unroll
        for (int e = 0; e < 4; ++e) { const float a = bflo(vr[ii][e]), c = bfhi(vr[ii][e]); sq += a * a + c * c; } }
    ((LAS float*)(lds + GM_RED))[chq * 128 + j] = sq;
    __syncthreads();
    { const LAS float* red = (const LAS float*)(lds + GM_RED); const float tot = (red[j] + red[128 + j]) + (red[256 + j] + red[384 + j]);
      const float rstd = 1.0f / sqrtf(tot * (1.0f / 128.0f) + EPS);
      LAS unsigned short* vt = (LAS unsigned short*)(lds + GM_V);
#pragma unroll
      for (int ii = 0; ii < 4; ++ii) { const int ch = chq + 4 * ii; const f32x4 g0 = *(const f32x4*)(vgain + h * 128 + 8 * ch), g1 = *(const f32x4*)(vgain + h * 128 + 8 * ch + 4);
#pragma unroll
          for (int e = 0; e < 4; ++e) { const float ga = e < 2 ? g0[2 * e] : g1[2 * e - 4], gb = e < 2 ? g0[2 * e + 1] : g1[2 * e - 3];
              const unsigned w = cvtpk(bflo(vr[ii][e]) * rstd * ga, bfhi(vr[ii][e]) * rstd * gb);
              vt[(8 * ch + 2 * e) * 136 + j] = (unsigned short)(w & 0xffffu); vt[(8 * ch + 2 * e + 1) * 136 + j] = (unsigned short)(w >> 16); } } }
    __syncthreads();
    const int fr = lane & 15, g = lane >> 4, ns = (wid >> 1) + 1;
    f32x4 acc[8];
#pragma unroll
    for (int cf = 0; cf < 8; ++cf) acc[cf] = (f32x4){0.f, 0.f, 0.f, 0.f};
    for (int s = 0; s < ns; ++s) { const bf16x8 bw = *(const LAS bf16x8*)(lds + GM_W + (16 * wid + fr) * 272 + (32 * s + 8 * g) * 2);
#pragma unroll
        for (int cf = 0; cf < 8; ++cf) { const bf16x8 av = *(const LAS bf16x8*)(lds + GM_V + (16 * cf + fr) * 272 + (32 * s + 8 * g) * 2); acc[cf] = MFMA16(av, bw, acc[cf]); } }
    const int i = 16 * wid + fr, tok = tok0 + i; const float bs = b_s[h * 128 + i]; float ss = 0.f;
    const bf16* up = GU + (size_t)tok * 1024 + h * 128 + 4 * g; bf16* op = MG + (size_t)tok * DM + 1024 + h * 128 + 4 * g;
#pragma unroll
    for (int cf = 0; cf < 8; ++cf) { const v2u uu = *(const v2u*)(up + 16 * cf);
        f32x4 v; v[0] = bflo(uu.x) * (acc[cf][0] + bs); v[1] = bfhi(uu.x) * (acc[cf][1] + bs); v[2] = bflo(uu.y) * (acc[cf][2] + bs); v[3] = bfhi(uu.y) * (acc[cf][3] + bs);
        ss += (v[0] * v[0] + v[1] * v[1]) + (v[2] * v[2] + v[3] * v[3]);
        *(v2u*)(op + 16 * cf) = (v2u){cvtpk(v[0], v[1]), cvtpk(v[2], v[3])}; }
    ss += __shfl_xor(ss, 16); ss += __shfl_xor(ss, 32);
    if (g == 0) ssqm[(size_t)tok * 24 + 16 + h] = ss;
}

__device__ __forceinline__ void gmlp_sample_wave(int db, int h, const bf16* GU, const bf16* GV, const float* w_s, const float* b_s, const float* vgain, bf16* MG, float* ssqm, float* out, int lane) {
    const int tok0 = MP + db * 4, c = 2 * lane;
    const f32x2 gn = *(const f32x2*)(vgain + h * 128 + c);
    float vn[4][2];
#pragma unroll
    for (int t = 0; t < 4; ++t) { const unsigned w = *(const unsigned*)(GV + (size_t)(tok0 + t) * 1024 + h * 128 + c); const float a = bflo(w), b2 = bfhi(w);
        const float rstd = 1.0f / sqrtf(wave_sum(a * a + b2 * b2) * (1.0f / 128.0f) + EPS);
        vn[t][0] = a * rstd * gn[0]; vn[t][1] = b2 * rstd * gn[1];
        *(f32x2*)(out + pg8::OGV + ((size_t)(db * 4 + t) * 8 + h) * 128 + c) = (f32x2){vn[t][0], vn[t][1]}; }
#pragma unroll
    for (int i = 0; i < 4; ++i) { float m0 = b_s[h * 128 + i], m1 = m0;
#pragma unroll
        for (int jj = 0; jj <= i; ++jj) { const float w = w_s[((size_t)h * 128 + i) * 128 + jj]; m0 += w * vn[jj][0]; m1 += w * vn[jj][1]; }
        const unsigned uw = *(const unsigned*)(GU + (size_t)(tok0 + i) * 1024 + h * 128 + c);
        const float o0 = bflo(uw) * m0, o1 = bfhi(uw) * m1;
        *(unsigned*)(MG + (size_t)(tok0 + i) * DM + 1024 + h * 128 + c) = cvtpk(o0, o1);
        const float ss = wave_sum(o0 * o0 + o1 * o1);
        if (lane == 0) ssqm[(size_t)(tok0 + i) * 24 + 16 + h] = ss; }
}

__device__ __forceinline__ const float* in_ptr(LAS unsigned char* lds, int i) {
    const unsigned long long v = ((const LAS unsigned long long*)(lds + X_PTR))[i];
    const unsigned lo = __builtin_amdgcn_readfirstlane((unsigned)v), hi = __builtin_amdgcn_readfirstlane((unsigned)(v >> 32));
    return (const float*)(const GAS float*)(((unsigned long long)hi << 32) | lo);
}
struct Args { const float* in[23]; float* out; unsigned char* ws; int ph_lo, ph_hi; };
__global__ void __launch_bounds__(NWAVES * 64, 2) mk_fwd(Args args) {
    extern __shared__ __attribute__((aligned(16))) unsigned char lds_raw[];
    LAS unsigned char* lds = (LAS unsigned char*)lds_raw;
    const int tid = threadIdx.x, lane = tid & 63, wid = __builtin_amdgcn_readfirstlane(tid >> 6);
    const int G = gridDim.x, bx = blockIdx.x, vcu = (G % 8 == 0) ? (bx % 8) * (G / 8) + bx / 8 : bx;
    const int gw = vcu * NWAVES + wid, NGW = G * NWAVES;
    unsigned char* ws = args.ws;
    float* out = args.out;
    bf16* Win_t = (bf16*)(ws + WS_WIN); bf16* Wout_t = (bf16*)(ws + WS_WOUT); bf16* Wff1_t = (bf16*)(ws + WS_WFF1); bf16* Wff2_t = (bf16*)(ws + WS_WFF2);
    float* mod = (float*)(ws + WS_MOD); float* ssqm = (float*)(ws + WS_SSQM); float* ssqo = (float*)(ws + WS_SSQO); float* ssqf = (float*)(ws + WS_SSQF);
    bf16* H = (bf16*)(ws + WS_H); bf16* Qb = (bf16*)(ws + WS_Q); bf16* Kb = (bf16*)(ws + WS_K); bf16* Vb = (bf16*)(ws + WS_V); bf16* GU = (bf16*)(ws + WS_GU); bf16* GV = (bf16*)(ws + WS_GV);
    bf16* MG = (bf16*)(ws + WS_MG); float* Ob = (float*)(ws + WS_O); bf16* F1 = (bf16*)(ws + WS_F1); float* Fb = (float*)(ws + WS_F);

    for (int u = tid; u < (LDS_BYTES - X_MISC) / 4; u += NWAVES * 64) ((LAS unsigned*)(lds + X_MISC))[u] = 0u;
    if (tid < 128) { const int n = tid; int bk = n; if (n >= 16) { bk = 16 + (int)(logf((float)n / 16.0f) / 2.0794415416798357f * 16.0f); bk = bk < 31 ? bk : 31; } ((LAS int*)(lds + X_BKT))[tid] = bk; }
    ((LAS float*)(lds + X_TAB))[tid] = args.in[6][tid] * LOG2E;
    if (tid < 23) ((LAS unsigned long long*)(lds + X_PTR))[tid] = (unsigned long long)args.in[tid];
    __syncthreads();
#define INP(i) in_ptr(lds, (i))
#if !MK_CG_SYNC
    XcdBarrier bar = xcd_barrier_post((unsigned*)(ws + WS_CTL) + CW_BAR, (volatile LAS unsigned*)(lds + X_MISC));
#define GRID_BAR(seam) do { if ((seam) == 0) cg::this_grid().sync(); else xcd_barrier(bar); } while (0)
#else
#define GRID_BAR(seam) cg::this_grid().sync()
#endif
    const int lo = args.ph_lo, hi = args.ph_hi;
#ifndef PH_MASK
#define PH_MASK 0x1ff
#endif
#define IN(k) ((((PH_MASK) >> (k)) & 1) && lo <= (k) && (k) < hi)
#define BOTH(k) (IN(k) && IN((k) + 1))

    if (IN(0)) {
        adaln_phase(lds, vcu, G, tid, wid, lane, INP(4), INP(5), INP(7), INP(8), mod);
        LAS float* scr = (LAS float*)(lds + wid * 16384);
        constexpr int I_IN = (DM / 64) * (INC / 32), I_OUT = (DM / 64) * (DM / 32), I_F1 = (DM / 64) * (DFF / 32), I_F2 = (DFF / 64) * (DM / 32);
        constexpr int NITEMS = I_IN + I_OUT + I_F1 + I_F2;
        for (int it = gw; it < NITEMS; it += NGW) {
            int r = it;
            if (r < I_IN) { p0_transpose_item(INP(10), DM, INC, Win_t, nullptr, scr, r, lane); continue; } r -= I_IN;
            if (r < I_OUT) { const int kb = r / (DM / 32); p0_transpose_item(INP(17), DM, DM, Wout_t, kb < 16 ? INP(15) : INP(16) - 1024, scr, r, lane); continue; } r -= I_OUT;
            if (r < I_F1) { p0_transpose_item(INP(20), DM, DFF, Wff1_t, nullptr, scr, r, lane); continue; } r -= I_F1;
            p0_transpose_item(INP(21), DFF, DM, Wff2_t, nullptr, scr, r, lane);
        }
        if (BOTH(0)) GRID_BAR(0);
    }
    if (IN(1)) { p1_rows(gw, NGW, lane, INP(0), INP(1), mod, INP(9), H); if (BOTH(1)) GRID_BAR(1); }
    if (IN(2)) {
        pg8::Gemm g{H, Win_t, M, INC, DM}; pg8::StaticOrder S; S.init(M, INC, G, bx);
        pg8::EpiInProj E{Qb, Kb, Vb, GU, GV, out};
        pg8::gemm_phase<pg8::EpiInProj, pg8::StaticOrder, true, true>(lds, g, S, E);
        if (BOTH(2)) GRID_BAR(2);
    }
    if (IN(3)) {
        constexpr int N_AP = 1024, N_GP = 512, N_SA = 128, N_SG = 128;
        for (int r = vcu; r < N_AP; r += G) attn_prompt_unit(lds, r >> 8, (r >> 4) & 15, r & 15, Qb, Kb, Vb, MG, ssqm, INP(11), tid, wid, lane);
        for (int r = vcu; r < N_GP; r += G) gmlp_prompt_unit(lds, r >> 7, (r >> 3) & 15, r & 7, GU, GV, INP(13), INP(14), INP(12), MG, ssqm, tid, wid, lane);
        for (int r = vcu; r < N_SA; r += G) attn_sample_unit(lds, r, Qb, Kb, Vb, INP(2), INP(3), MG, ssqm, INP(11), tid, wid, lane);
        for (int r = (vcu + G - (G >> 1)) % G; r < N_SG; r += G) { const int wu = r * 8 + wid; gmlp_sample_wave(wu >> 3, wu & 7, GU, GV, INP(13), INP(14), INP(12), MG, ssqm, out, lane); }
        __syncthreads();
        if (BOTH(3)) GRID_BAR(3);
    }
    if (IN(4)) {
        pg8::Gemm g{MG, Wout_t, M, DM, DM}; pg8::StaticOrder S; S.init(M, DM, G, bx);
        pg8::EpiF32Ssq<true> E{Ob, ssqo, ssqm, (LAS float*)(lds + X_RATIO)};
        pg8::gemm_phase<pg8::EpiF32Ssq<true>, pg8::StaticOrder, true, true>(lds, g, S, E);
        if (BOTH(4)) GRID_BAR(4);
    }
    if (IN(5)) { p5_rows(gw, NGW, lane, INP(0), INP(1), mod, Ob, ssqo, INP(18), INP(19), out, H); if (BOTH(5)) GRID_BAR(5); }
    if (IN(6)) {
        pg8::Gemm g{H, Wff1_t, M, DFF, DM}; pg8::StaticOrder S; S.init(M, DFF, G, bx);
        pg8::EpiRelu2 E{F1, DFF};
        pg8::gemm_phase<pg8::EpiRelu2, pg8::StaticOrder, true, true>(lds, g, S, E);
        if (BOTH(6)) GRID_BAR(6);
    }
    if (IN(7)) {
        pg8::Gemm g{F1, Wff2_t, M, DM, DFF}; pg8::StaticOrder S; S.init(M, DM, G, bx);
        pg8::EpiF32Ssq<false> E{Fb, ssqf, nullptr, (LAS float*)(lds + X_RATIO)};
        pg8::gemm_phase<pg8::EpiF32Ssq<false>, pg8::StaticOrder, true, true>(lds, g, S, E);
        if (BOTH(7)) GRID_BAR(7);
    }
    if (IN(8)) { p8_rows(gw, NGW, lane, mod, Fb, ssqf, INP(22), out); }
#undef IN
#undef BOTH
}

extern "C" void kernel_launch(void* const* d_in, const int* in_sizes, int n_in, void* d_out, int out_size, void* d_ws, size_t ws_size, hipStream_t stream) {
    static int grid = 0;
    if (grid == 0) {
        if (n_in != 23 || out_size != pg8::OUT_TOTAL || ws_size < WS_END) { fprintf(stderr, "kernel_launch: unexpected shapes: n_in %d out %d ws %zu (need >= %zu)\n", n_in, out_size, ws_size, (size_t)WS_END); grid = -1; return; }
        int dev = 0, cus = 0, per_cu = 0;
        if (hipGetDevice(&dev) != hipSuccess || hipDeviceGetAttribute(&cus, hipDeviceAttributeMultiprocessorCount, dev) != hipSuccess) { grid = -1; return; }
        if (hipFuncSetAttribute((const void*)mk_fwd, hipFuncAttributeMaxDynamicSharedMemorySize, LDS_BYTES) != hipSuccess) { fprintf(stderr, "kernel_launch: hipFuncSetAttribute failed\n"); grid = -1; return; }
        if (hipOccupancyMaxActiveBlocksPerMultiprocessor(&per_cu, (const void*)mk_fwd, NWAVES * 64, LDS_BYTES) != hipSuccess || per_cu < 1) { fprintf(stderr, "kernel_launch: occupancy query says %d\n", per_cu); (void)hipGetLastError(); grid = -1; return; }
        grid = cus;
    }
    if (grid < 0) return;
    (void)hipMemsetAsync((char*)d_ws + WS_CTL, 0, CTL_ZERO_BYTES, stream);
    Args a{};
    for (int i = 0; i < 23; ++i) a.in[i] = (const float*)d_in[i];
    a.out = (float*)d_out; a.ws = (unsigned char*)d_ws;
    if (N_LAUNCHES == 1) {
        a.ph_lo = 0; a.ph_hi = N_PHASES;
        void* kargs[] = {&a};
        hipError_t e = hipLaunchCooperativeKernel((const void*)mk_fwd, dim3(grid), dim3(NWAVES * 64), kargs, LDS_BYTES, stream);
        if (e != hipSuccess) fprintf(stderr, "kernel_launch: cooperative launch failed: %s (grid %d)\n", hipGetErrorString(e), grid);
    } else {
        for (int p = 0; p < N_PHASES; ++p) { a.ph_lo = p; a.ph_hi = p + 1;
            hipLaunchKernelGGL(mk_fwd, dim3(grid), dim3(NWAVES * 64), LDS_BYTES, stream, a); }
    }
}
```

```cpp
#include <hip/hip_runtime.h>
#include <hip/hip_cooperative_groups.h>
#include <cstdio>
#include <cstdint>
#include <cmath>
namespace cg = cooperative_groups;

#ifndef MK_N_LAUNCHES
#define MK_N_LAUNCHES 1
#endif
#ifndef MK_CG_SYNC
#define MK_CG_SYNC 0
#endif

namespace pg8 {
#define PG8_LAS __attribute__((address_space(3)))
typedef unsigned short bf16_t;
typedef short bf16x8 __attribute__((ext_vector_type(8)));
typedef float f32x4 __attribute__((ext_vector_type(4)));
typedef unsigned u32x4 __attribute__((ext_vector_type(4)));
typedef unsigned u32x2 __attribute__((ext_vector_type(2)));
constexpr int BM = 256, BK = 64, HALF = 128, HTB = HALF * BK * 2, STAGE_BYTES = 8 * HTB, NXCD = 8, WGM = 8;

__host__ __device__ __forceinline__ int lds_byte(int r, int c) { const int st = (r >> 4) * 2 + (c >> 5), rr = r & 15, cc = c & 31, ob = rr * 64 + cc * 2; return st * 1024 + (ob ^ (((ob >> 9) & 1) << 5)); }
__host__ __device__ __forceinline__ void stage_rc(int b, int& R, int& C) { const int st = b / 1024, sb = b % 1024, swz = sb ^ (((sb >> 9) & 1) << 5); R = (st >> 1) * 16 + swz / 64; C = (st & 1) * 32 + (swz % 64) / 2; }
__host__ __device__ __forceinline__ int perm32(int rho) { const int n = rho >> 4, i = rho & 15; return 8 * (i >> 2) + 4 * n + (i & 3); }

struct Unit { int pm, pn, kt0, nkt, slice; };
struct Gemm { const bf16_t* A; const bf16_t* Bt; int M, N, K; };

struct StaticOrder {
    int nM, nN, nwg, G, c, ntf;
    __host__ __device__ __forceinline__ void init(int M, int N, int K, int G_, int c_) { nM = M / BM; nN = N / BM; nwg = nM * nN; G = G_; c = c_; ntf = K / BK; }
    __host__ __device__ __forceinline__ void unit_of(int L, Unit& u) const {
        int wgid = L; { const int q = nwg / NXCD, r = nwg % NXCD, xcd = wgid % NXCD, off = wgid / NXCD; wgid = (xcd < r ? xcd * (q + 1) : r * (q + 1) + (xcd - r) * q) + off; }
        const int nig = WGM * nN, gid = wgid / nig, fm = gid * WGM, gsz = (nM - fm) < WGM ? (nM - fm) : WGM;
        u.pm = fm + ((wgid % nig) % gsz); u.pn = (wgid % nig) / gsz; u.kt0 = 0; u.nkt = ntf; u.slice = -1;
    }
    __host__ __device__ __forceinline__ bool next(int i, Unit& u) const { const long L = (long)i * G + c; if (L >= nwg) return false; unit_of((int)L, u); return true; }
    __device__ __forceinline__ void a_ready(const Unit&) const {}
    __device__ __forceinline__ void done(const Unit&) const {}
};
constexpr int NSL = 16;
struct SplitOrder {
    StaticOrder full; int G, c, ntf;
    __host__ __device__ __forceinline__ void init(int K, int G_, int c_) { full.init(8192, 2048, K, G_, c_); G = G_; c = c_; ntf = K / BK; }
    __host__ __device__ __forceinline__ bool next(int i, Unit& u) const {
        const long L = (long)i * G + c; if (L >= 512) return false;
        const bool isfull = L < 256;
        Unit f; full.unit_of(isfull ? (int)L : 0, f);
        const int j = (int)L - 256, tile = j / NSL, sl = j % NSL, nsk = ntf / NSL;
        u.pm = isfull ? f.pm : 32 + (tile >> 3); u.pn = isfull ? f.pn : (tile & 7); u.nkt = isfull ? ntf : nsk; u.kt0 = isfull ? 0 : sl * nsk; u.slice = isfull ? -1 : sl; return true;
    }
    __device__ __forceinline__ void a_ready(const Unit&) const {}
    __device__ __forceinline__ void done(const Unit&) const {}
};

__device__ __forceinline__ unsigned cvt_pk_bf16(float lo, float hi) { unsigned r; asm volatile("v_cvt_pk_bf16_f32 %0, %1, %2" : "=v"(r) : "v"(lo), "v"(hi)); return r; }

__device__ __forceinline__ float gelu_tanh(float x) {
    const float u = x * (0.7978845608028654f + 0.035677408136300125f * x * x);
    const float e = __builtin_amdgcn_exp2f(-2.885390081777927f * u);
    return x * __builtin_amdgcn_rcpf(1.0f + e);
}

constexpr int OY = 0, OKP = 17825792, OVP = 17891328, OKS = 17956864, OVS = 18022400, OGV = 18087936, OUT_TOTAL = 18612224;
constexpr float QSCALE = 0.125f * 1.4426950408889634f;

struct EpiInProj {
    static constexpr bool PERM = true, AFTER_DRAIN = false, MID = false;
    bf16_t *Q, *Kb, *Vb, *GU, *GV; float* out;
    __device__ __forceinline__ void unit_start(const Unit&, int, int) const {}
    __device__ __forceinline__ void mid(f32x4 (&)[2][2][4][2], int, int, int) const {}
    __device__ __forceinline__ void operator()(const f32x4 (&acc)[2][2][4][2], const Unit& u, int wr, int wc, int fr, int fq, int) const {
        const int row0 = u.pm * BM + wr * 64 + fr, cl = wc * 32 + 8 * fq;
        if (u.pn < 4) {
#pragma unroll
            for (int ai = 0; ai < 2; ++ai)
#pragma unroll
                for (int m = 0; m < 4; ++m) { bf16_t* rowp = Q + (size_t)(row0 + ai * HALF + m * 16) * 1024 + u.pn * 256 + cl;
#pragma unroll
                    for (int bj = 0; bj < 2; ++bj) { const f32x4 v0 = acc[ai][bj][m][0] * QSCALE, v1 = acc[ai][bj][m][1] * QSCALE;
                        u32x4 w; w.x = cvt_pk_bf16(v0[0], v0[1]); w.y = cvt_pk_bf16(v0[2], v0[3]); w.z = cvt_pk_bf16(v1[0], v1[1]); w.w = cvt_pk_bf16(v1[2], v1[3]);
                        *(u32x4*)(rowp + bj * HALF) = w; } }
        } else if (u.pn == 4) {
#pragma unroll
            for (int ai = 0; ai < 2; ++ai)
#pragma unroll
                for (int m = 0; m < 4; ++m) { const int row = row0 + ai * HALF + m * 16;
#pragma unroll
                    for (int bj = 0; bj < 2; ++bj) { const f32x4 v0 = acc[ai][bj][m][0], v1 = acc[ai][bj][m][1];
                        u32x4 w; w.x = cvt_pk_bf16(v0[0], v0[1]); w.y = cvt_pk_bf16(v0[2], v0[3]); w.z = cvt_pk_bf16(v1[0], v1[1]); w.w = cvt_pk_bf16(v1[2], v1[3]);
                        bf16_t* base = bj == 0 ? Kb : Vb;
                        *(u32x4*)(base + (size_t)row * 128 + cl) = w;
                        float* o = nullptr;
                        if (row < 8192) { const int t = row & 2047; if (t >= 1920) o = out + (bj == 0 ? OKP : OVP) + ((row >> 11) * 128 + (t - 1920)) * 128 + cl; }
                        else o = out + (bj == 0 ? OKS : OVS) + (row - 8192) * 128 + cl;
                        if (o) { *(f32x4*)o = v0; *(f32x4*)(o + 4) = v1; } } }
        } else {
            bf16_t* base = u.pn < 9 ? GU : GV; const int coff = (u.pn < 9 ? u.pn - 5 : u.pn - 9) * 256 + cl;
#pragma unroll
            for (int ai = 0; ai < 2; ++ai)
#pragma unroll
                for (int m = 0; m < 4; ++m) { bf16_t* rowp = base + (size_t)(row0 + ai * HALF + m * 16) * 1024 + coff;
#pragma unroll
                    for (int bj = 0; bj < 2; ++bj) { const f32x4 v0 = acc[ai][bj][m][0], v1 = acc[ai][bj][m][1];
                        u32x4 w; w.x = cvt_pk_bf16(gelu_tanh(v0[0]), gelu_tanh(v0[1])); w.y = cvt_pk_bf16(gelu_tanh(v0[2]), gelu_tanh(v0[3]));
                        w.z = cvt_pk_bf16(gelu_tanh(v1[0]), gelu_tanh(v1[1])); w.w = cvt_pk_bf16(gelu_tanh(v1[2]), gelu_tanh(v1[3]));
                        *(u32x4*)(rowp + bj * HALF) = w; } }
        }
    }
};

struct EpiRelu2 {
    static constexpr bool PERM = true, AFTER_DRAIN = false, MID = false;
    bf16_t* O; int ldc;
    __device__ __forceinline__ void unit_start(const Unit&, int, int) const {}
    __device__ __forceinline__ void mid(f32x4 (&)[2][2][4][2], int, int, int) const {}
    __device__ __forceinline__ void operator()(const f32x4 (&acc)[2][2][4][2], const Unit& u, int wr, int wc, int fr, int fq, int) const {
        const int row0 = u.pm * BM + wr * 64 + fr, col0 = u.pn * BM + wc * 32 + 8 * fq;
#pragma unroll
        for (int ai = 0; ai < 2; ++ai)
#pragma unroll
            for (int m = 0; m < 4; ++m) { bf16_t* rowp = O + (size_t)(row0 + ai * HALF + m * 16) * ldc + col0;
#pragma unroll
                for (int bj = 0; bj < 2; ++bj) { f32x4 v0 = acc[ai][bj][m][0], v1 = acc[ai][bj][m][1];
#pragma unroll
                    for (int e = 0; e < 4; ++e) { const float a = fmaxf(v0[e], 0.f), b = fmaxf(v1[e], 0.f); v0[e] = a * a; v1[e] = b * b; }
                    u32x4 w; w.x = cvt_pk_bf16(v0[0], v0[1]); w.y = cvt_pk_bf16(v0[2], v0[3]); w.z = cvt_pk_bf16(v1[0], v1[1]); w.w = cvt_pk_bf16(v1[2], v1[3]);
                    *(u32x4*)(rowp + bj * HALF) = w; } }
    }
};

template <bool SCALE> struct EpiF32Ssq {
    static constexpr bool PERM = false, AFTER_DRAIN = false, MID = SCALE;
    float* O; float* ssq; const float* ssqm; PG8_LAS float* xr;
    float* slab;
    __device__ __forceinline__ void unit_start(const Unit& u, int ui, int tid) const {
        if (SCALE) { if (tid < 256) { const float* p = ssqm + (size_t)(u.pm * BM + tid) * 24; float sa = 0.f, sg = 0.f;
#pragma unroll
                for (int i = 0; i < 4; ++i) { const f32x4 v = *(const f32x4*)(p + 4 * i); sa += (v[0] + v[1]) + (v[2] + v[3]); }
#pragma unroll
                for (int i = 4; i < 6; ++i) { const f32x4 v = *(const f32x4*)(p + 4 * i); sg += (v[0] + v[1]) + (v[2] + v[3]); }
                const float ra = 1.0f / sqrtf(sa * (1.0f / 1024.0f) + 1e-6f), rg = 1.0f / sqrtf(sg * (1.0f / 1024.0f) + 1e-6f);
                xr[(ui & 1) * 512 + tid] = ra / rg; xr[(ui & 1) * 512 + 256 + tid] = (u.slice >= 0 && u.slice < NSL / 2) ? ra : rg; } }
    }
    __device__ __forceinline__ void mid(f32x4 (&acc)[2][2][4][2], int ui, int wr, int fr) const {
        if (SCALE) {
#pragma unroll
            for (int ai = 0; ai < 2; ++ai)
#pragma unroll
                for (int m = 0; m < 4; ++m) { const float r = xr[(ui & 1) * 512 + ai * HALF + wr * 64 + m * 16 + fr];
#pragma unroll
                    for (int bj = 0; bj < 2; ++bj)
#pragma unroll
                        for (int n = 0; n < 2; ++n) acc[ai][bj][m][n] = acc[ai][bj][m][n] * r; } }
    }
    __device__ __forceinline__ void operator()(const f32x4 (&acc)[2][2][4][2], const Unit& u, int wr, int wc, int fr, int fq, int ui) const {
        const int col0 = u.pn * BM + wc * 32 + 4 * fq;
        const bool part = u.slice >= 0;
        float* base = (part ? slab + ((size_t)u.slice * 512 + (size_t)(u.pm - 32) * BM) * 2048 : O + (size_t)u.pm * BM * 2048) + (size_t)(wr * 64 + fr) * 2048 + col0;
        float* sq = ssq + (size_t)(u.pm * BM + wr * 64 + fr) * 32 + u.pn * 4 + wc;
#pragma unroll
        for (int ai = 0; ai < 2; ++ai)
#pragma unroll
            for (int m = 0; m < 4; ++m) { const int rl = ai * HALF + wr * 64 + m * 16 + fr;
                const float rg = SCALE ? xr[(ui & 1) * 512 + 256 + rl] : 1.0f; float s = 0.f;
#pragma unroll
                for (int bj = 0; bj < 2; ++bj)
#pragma unroll
                    for (int n = 0; n < 2; ++n) { const f32x4 v = acc[ai][bj][m][n] * rg; s += (v[0] * v[0] + v[1] * v[1]) + (v[2] * v[2] + v[3] * v[3]);
                        *(f32x4*)(base + (size_t)(ai * HALF + m * 16) * 2048 + bj * HALF + n * 16) = v; }
                s += __shfl_xor(s, 16); s += __shfl_xor(s, 32);
                if (!part && fq == 0) sq[(ai * HALF + m * 16) * 32] = s; }
    }
};

template <class Epi, class Sched, bool ALIGN_EPI = false, bool SP2 = false>
__device__ __forceinline__ void gemm_phase(PG8_LAS unsigned char* lds, const Gemm g, const Sched& S, const Epi& E) {
    const int tid = threadIdx.x, wid = __builtin_amdgcn_readfirstlane(tid >> 6), lane = tid & 63, wr = wid >> 2, wc = wid & 3, fr = lane & 15, fq = lane >> 4;
    const int K = g.K;
    unsigned voffA[2], voffB[2];
#pragma unroll
    for (int i = 0; i < 2; ++i) { int R, C; stage_rc(tid * 16 + i * 8192, R, C); const int Rb = Epi::PERM ? ((R & ~31) + perm32(R & 31)) : R;
        voffA[i] = (unsigned)(R * K + C) * 2u; voffB[i] = (unsigned)(Rb * K + C) * 2u; }
    const size_t kstep = (size_t)(BK * 2);
    const size_t hstep = (size_t)HALF * K * 2;
    const size_t tstep = 2 * hstep;
    const unsigned ldsw = (unsigned)wid * 1024u;
    const int aoff = lds_byte(wr * 64 + fr, fq * 8), boff = lds_byte(wc * 32 + fr, fq * 8);
#define PG8_SA(b, h) (((b) * 2 + (h)) * HTB)
#define PG8_SB(b, h) ((4 + (b) * 2 + (h)) * HTB)
#define PG8_STAGE(bufoff, gbase, voff) do { _Pragma("unroll") for (int _i = 0; _i < 2; ++_i) \
        __builtin_amdgcn_global_load_lds((const unsigned*)((const char*)(gbase) + (voff)[_i]), (PG8_LAS unsigned*)(lds + (bufoff) + ldsw + _i * 8192), 16, 0, 0); } while (0)
#define PG8_LDA(dst, b, h) do { _Pragma("unroll") for (int m = 0; m < 4; ++m) _Pragma("unroll") for (int k = 0; k < 2; ++k) dst[m][k] = *(const PG8_LAS bf16x8*)(lds + PG8_SA(b, h) + aoff + m * 2048 + k * 1024); } while (0)
#define PG8_LDB(dst, b, h) do { _Pragma("unroll") for (int n = 0; n < 2; ++n) _Pragma("unroll") for (int k = 0; k < 2; ++k) dst[n][k] = *(const PG8_LAS bf16x8*)(lds + PG8_SB(b, h) + boff + n * 2048 + k * 1024); } while (0)
#define PG8_MMA(ai, bj, At, Bt) do { __builtin_amdgcn_s_setprio(1); _Pragma("unroll") for (int m = 0; m < 4; ++m) _Pragma("unroll") for (int n = 0; n < 2; ++n) _Pragma("unroll") for (int k = 0; k < 2; ++k) \
        acc[ai][bj][m][n] = __builtin_amdgcn_mfma_f32_16x16x32_bf16(Bt[n][k], At[m][k], acc[ai][bj][m][n], 0, 0, 0); __builtin_amdgcn_s_setprio(0); } while (0)
#define PG8_WAIT_V(n) asm volatile("s_waitcnt vmcnt(" #n ")" ::: "memory")
#define PG8_WAIT_L(n) asm volatile("s_waitcnt lgkmcnt(" #n ")" ::: "memory")
#define PG8_BAR __builtin_amdgcn_s_barrier()
#define PG8_SCHED __builtin_amdgcn_sched_barrier(0)
    Unit cur, nxt; int ui = 0;
    if (!S.next(0, cur)) return;
    f32x4 acc[2][2][4][2];
#pragma unroll
    for (int a = 0; a < 2; ++a)
#pragma unroll
        for (int b = 0; b < 2; ++b)
#pragma unroll
            for (int m = 0; m < 4; ++m)
#pragma unroll
                for (int n = 0; n < 2; ++n) acc[a][b][m][n] = (f32x4){0.f, 0.f, 0.f, 0.f};
    bf16x8 At[4][2], B0[2][2], B1[2][2];
    const char* cA = (const char*)g.A + (size_t)cur.pm * tstep + (size_t)cur.kt0 * kstep; const char* cB = (const char*)g.Bt + (size_t)cur.pn * tstep + (size_t)cur.kt0 * kstep;
    S.a_ready(cur);
    if constexpr (SP2) {
        PG8_STAGE(PG8_SB(0, 0), cB, voffB); PG8_STAGE(PG8_SB(0, 1), cB + hstep, voffB); PG8_STAGE(PG8_SA(0, 0), cA, voffA); PG8_STAGE(PG8_SA(0, 1), cA + hstep, voffA);
        if (wr == 1) PG8_BAR;
        PG8_WAIT_V(2); PG8_BAR;
        PG8_STAGE(PG8_SB(1, 0), cB + kstep, voffB); PG8_STAGE(PG8_SA(1, 0), cA + kstep, voffA); PG8_STAGE(PG8_SB(1, 1), cB + hstep + kstep, voffB);
        PG8_WAIT_V(6); PG8_BAR;
    } else {
        PG8_STAGE(PG8_SB(0, 0), cB, voffB); PG8_STAGE(PG8_SA(0, 0), cA, voffA); PG8_STAGE(PG8_SB(0, 1), cB + hstep, voffB); PG8_STAGE(PG8_SA(0, 1), cA + hstep, voffA);
        if (wr == 1) PG8_BAR;
        PG8_WAIT_V(4); PG8_BAR;
        PG8_STAGE(PG8_SB(1, 0), cB + kstep, voffB); PG8_STAGE(PG8_SA(1, 0), cA + kstep, voffA); PG8_STAGE(PG8_SB(1, 1), cB + hstep + kstep, voffB);
        PG8_WAIT_V(6); PG8_BAR;
    }
    for (;;) {
        const bool has_next = S.next(ui + 1, nxt);
        const char* nA = has_next ? (const char*)g.A + (size_t)nxt.pm * tstep + (size_t)nxt.kt0 * kstep : cA; const char* nB = has_next ? (const char*)g.Bt + (size_t)nxt.pn * tstep + (size_t)nxt.kt0 * kstep : cB;
        const int nt = cur.nkt;
        if constexpr (Epi::MID) E.unit_start(cur, ui, tid);
        for (int t = 0; t < nt; t += 2) {
            const bool last = (t == nt - 2);
            const char* a1 = cA + (size_t)(t + 1) * kstep;
            const char* a2 = last ? nA : cA + (size_t)(t + 2) * kstep; const char* b2 = last ? nB : cB + (size_t)(t + 2) * kstep;
            const char* a3 = a2 + kstep; const char* b3 = b2 + kstep;
            if (last && has_next) S.a_ready(nxt);
            if constexpr (Epi::MID) { if (cur.slice < 0 && t == (nt >> 1)) E.mid(acc, ui, wr, fr); }
            if constexpr (SP2) {
            PG8_LDB(B0, 0, 0); PG8_LDB(B1, 0, 1); PG8_SCHED; PG8_LDA(At, 0, 0); PG8_STAGE(PG8_SA(1, 1), a1 + hstep, voffA);
            PG8_WAIT_V(8); PG8_WAIT_L(0); PG8_BAR; PG8_MMA(0, 0, At, B0); PG8_MMA(0, 1, At, B1); PG8_BAR; PG8_SCHED;
            PG8_LDA(At, 0, 1); PG8_STAGE(PG8_SB(0, 0), b2, voffB); PG8_STAGE(PG8_SB(0, 1), b2 + hstep, voffB); PG8_STAGE(PG8_SA(0, 0), a2, voffA);
            PG8_WAIT_V(8); PG8_WAIT_L(0); PG8_BAR; PG8_MMA(1, 0, At, B0); PG8_MMA(1, 1, At, B1); PG8_BAR; PG8_SCHED;
            PG8_LDB(B0, 1, 0); PG8_LDB(B1, 1, 1); PG8_SCHED; PG8_LDA(At, 1, 0); PG8_STAGE(PG8_SA(0, 1), a2 + hstep, voffA);
            PG8_WAIT_V(8); PG8_WAIT_L(0); PG8_BAR; PG8_MMA(0, 0, At, B0); PG8_MMA(0, 1, At, B1); PG8_BAR; PG8_SCHED;
            PG8_LDA(At, 1, 1); PG8_STAGE(PG8_SB(1, 0), b3, voffB); PG8_STAGE(PG8_SB(1, 1), b3 + hstep, voffB); PG8_STAGE(PG8_SA(1, 0), a3, voffA);
            PG8_WAIT_V(8); PG8_WAIT_L(0); PG8_BAR; PG8_MMA(1, 0, At, B0); PG8_MMA(1, 1, At, B1); PG8_BAR; PG8_SCHED;
            } else {
            PG8_LDB(B0, 0, 0); PG8_SCHED; PG8_LDA(At, 0, 0); PG8_STAGE(PG8_SA(1, 1), a1 + hstep, voffA);
            PG8_WAIT_L(8); PG8_BAR; PG8_WAIT_L(0); PG8_MMA(0, 0, At, B0); PG8_BAR; PG8_SCHED;
            PG8_LDB(B1, 0, 1); PG8_STAGE(PG8_SB(0, 0), b2, voffB);
            PG8_BAR; PG8_WAIT_L(0); PG8_MMA(0, 1, At, B1); PG8_BAR;
            PG8_LDA(At, 0, 1); PG8_STAGE(PG8_SA(0, 0), a2, voffA);
            PG8_BAR; PG8_WAIT_L(0); PG8_MMA(1, 0, At, B0); PG8_BAR; PG8_SCHED;
            PG8_STAGE(PG8_SB(0, 1), b2 + hstep, voffB);
            PG8_WAIT_V(6); PG8_BAR; PG8_MMA(1, 1, At, B1); PG8_BAR;
            PG8_LDB(B0, 1, 0); PG8_SCHED; PG8_LDA(At, 1, 0); PG8_STAGE(PG8_SA(0, 1), a2 + hstep, voffA);
            PG8_WAIT_L(8); PG8_BAR; PG8_WAIT_L(0); PG8_MMA(0, 0, At, B0); PG8_BAR; PG8_SCHED;
            PG8_LDB(B1, 1, 1); PG8_STAGE(PG8_SB(1, 0), b3, voffB);
            PG8_BAR; PG8_WAIT_L(0); PG8_MMA(0, 1, At, B1); PG8_BAR;
            PG8_LDA(At, 1, 1); PG8_STAGE(PG8_SA(1, 0), a3, voffA);
            PG8_BAR; PG8_WAIT_L(0); PG8_MMA(1, 0, At, B0); PG8_BAR; PG8_SCHED;
            PG8_STAGE(PG8_SB(1, 1), b3 + hstep, voffB);
            PG8_WAIT_V(6); PG8_BAR; PG8_MMA(1, 1, At, B1); PG8_BAR;
            }
        }
        if constexpr (ALIGN_EPI) { if (wr == 0) PG8_BAR; }
        if constexpr (!Epi::AFTER_DRAIN) { E(acc, cur, wr, wc, fr, fq, ui); S.done(cur); }
        if (!has_next) break;
#pragma unroll
        for (int a = 0; a < 2; ++a)
#pragma unroll
            for (int b = 0; b < 2; ++b)
#pragma unroll
                for (int m = 0; m < 4; ++m)
#pragma unroll
                    for (int n = 0; n < 2; ++n) acc[a][b][m][n] = (f32x4){0.f, 0.f, 0.f, 0.f};
        cur = nxt; cA = nA; cB = nB; ++ui;
        if constexpr (ALIGN_EPI) { if (wr == 1) PG8_BAR; }
    }
    PG8_WAIT_V(0);
    if constexpr (!ALIGN_EPI) { if (wr == 0) PG8_BAR; }
    PG8_BAR;
#undef PG8_SA
#undef PG8_SB
#undef PG8_STAGE
#undef PG8_LDA
#undef PG8_LDB
#undef PG8_MMA
#undef PG8_WAIT_V
#undef PG8_WAIT_L
#undef PG8_BAR
#undef PG8_SCHED
}
}

constexpr int NWAVES = 8;
constexpr int DM = 2048, MP = 8192, MS = 512, M = MP + MS, INC = 3328, DFF = 8192, NMOD = 12288;
constexpr float EPS = 1e-6f, LOG2E = 1.4426950408889634f;
constexpr int N_PHASES = 9;
constexpr int N_LAUNCHES = MK_N_LAUNCHES;

constexpr size_t MiB = 1u << 20;
constexpr size_t WS_CTL = 0, CTL_ZERO_BYTES = 1 * MiB;
constexpr size_t WS_WIN = 2 * MiB, WS_WOUT = 16 * MiB, WS_WFF1 = 24 * MiB, WS_WFF2 = 90 * MiB;
constexpr size_t WS_H = 56 * MiB;
constexpr size_t WS_MOD = 122 * MiB;
constexpr size_t WS_SSQM = 129 * MiB, WS_SSQO = 130 * MiB, WS_SSQF = 132 * MiB;
constexpr size_t WS_Q = 134 * MiB, WS_K = 151 * MiB, WS_V = 154 * MiB, WS_GU = 157 * MiB, WS_GV = 174 * MiB;
constexpr size_t WS_MG = 202 * MiB;
constexpr size_t WS_O = 134 * MiB;
constexpr size_t WS_F1 = 134 * MiB;
constexpr size_t WS_F = 270 * MiB;
constexpr size_t WS_SLAB4 = 270 * MiB;
constexpr size_t WS_SLAB7 = 2 * MiB;
constexpr size_t WS_END = 338 * MiB;
constexpr size_t SLAB_BYTES = (size_t)16 * 512 * 2048 * 4;
static_assert(WS_SSQM + (size_t)M * 24 * 4 <= WS_SSQO && WS_SSQO + (size_t)M * 32 * 4 <= WS_SSQF && WS_SSQF + (size_t)M * 32 * 4 <= WS_Q, "partials");
static_assert(WS_MOD + (size_t)132 * NMOD * 4 <= WS_SSQM && WS_H + (size_t)M * DM * 2 <= WS_WFF2 && WS_Q + (size_t)M * 1024 * 2 <= WS_K && WS_K + (size_t)M * 128 * 2 <= WS_V &&
              WS_V + (size_t)M * 128 * 2 <= WS_GU && WS_GU + (size_t)M * 1024 * 2 <= WS_GV && WS_GV + (size_t)M * 1024 * 2 <= WS_MG && WS_O + (size_t)M * DM * 4 <= WS_MG &&
              WS_MG + (size_t)M * DM * 2 <= WS_F && WS_F1 + (size_t)M * DFF * 2 <= WS_F && WS_F + (size_t)M * DM * 4 <= WS_END && WS_SLAB4 + SLAB_BYTES <= WS_END &&
              WS_SLAB7 + SLAB_BYTES <= WS_WFF2, "d_ws map");
static_assert(WS_WIN + (size_t)INC * DM * 2 <= WS_WOUT && WS_WOUT + (size_t)DM * DM * 2 <= WS_WFF1 && WS_WFF1 + (size_t)DFF * DM * 2 <= WS_H && WS_WFF2 + (size_t)DFF * DM * 2 <= WS_MOD, "weights");
constexpr int CW_BAR = 4096;

constexpr int RING_BYTES = 131072;
constexpr int X_RATIO = 131072;
constexpr int X_BKT = X_RATIO + 4096;
constexpr int X_TAB = X_BKT + 512;
constexpr int X_PTR = X_TAB + 2048;
constexpr int X_MISC = 139264;
constexpr int LDS_BYTES = 147456;

#define GAS __attribute__((address_space(1)))
#define LAS __attribute__((address_space(3)))
typedef unsigned short bf16;
typedef unsigned v4u __attribute__((ext_vector_type(4)));
typedef unsigned v2u __attribute__((ext_vector_type(2)));
typedef float f32x4 __attribute__((ext_vector_type(4)));
typedef float f32x2 __attribute__((ext_vector_type(2)));
typedef short bf16x8 __attribute__((ext_vector_type(8)));
typedef GAS unsigned gu32;
#define RLX_AGENT __ATOMIC_RELAXED, __HIP_MEMORY_SCOPE_AGENT
#define LDS_WAIT() asm volatile("s_waitcnt lgkmcnt(0)" ::: "memory")
#define VM_WAIT() asm volatile("s_waitcnt vmcnt(0)" ::: "memory")

__device__ __forceinline__ unsigned cvtpk(float lo, float hi) { return pg8::cvt_pk_bf16(lo, hi); }
__device__ __forceinline__ float bf2f(unsigned b) { return __uint_as_float(b << 16); }
__device__ __forceinline__ float bflo(unsigned w) { return __uint_as_float(w << 16); }
__device__ __forceinline__ float bfhi(unsigned w) { return __uint_as_float(w & 0xffff0000u); }
__device__ __forceinline__ bf16x8 pack8(f32x4 a, f32x4 b) { v4u w; w.x = cvtpk(a[0], a[1]); w.y = cvtpk(a[2], a[3]); w.z = cvtpk(b[0], b[1]); w.w = cvtpk(b[2], b[3]); return __builtin_bit_cast(bf16x8, w); }
__device__ __forceinline__ float wave_sum(float v) {
#pragma unroll
    for (int o = 1; o < 64; o <<= 1) v += __shfl_xor(v, o);
    return v;
}
__device__ __forceinline__ float silu_f(float x) { return x * __builtin_amdgcn_rcpf(1.0f + __builtin_amdgcn_exp2f(-LOG2E * x)); }
#define MFMA16(a, b, c) __builtin_amdgcn_mfma_f32_16x16x32_bf16((a), (b), (c), 0, 0, 0)

#define XB_TMO      128
#define XB_XCNT(j)  (256  + 64 * (j))
#define XB_XSUB(j)  (1280 + 64 * (j))
#define XB_XGEN(j)  (2304 + 64 * (j))
#define XB_TOP      3328
#define XB_TOPGEN   3392
#define XCD_BAR_WORDS 3456
#define XB_SPIN_CAP (1u << 18)
__device__ __forceinline__ unsigned xb_ld(unsigned* p)              { return __hip_atomic_load(p, __ATOMIC_RELAXED, __HIP_MEMORY_SCOPE_AGENT); }
__device__ __forceinline__ unsigned xb_add(unsigned* p, unsigned v) { return __hip_atomic_fetch_add(p, v, __ATOMIC_RELAXED, __HIP_MEMORY_SCOPE_AGENT); }
__device__ __forceinline__ unsigned xb_xcc_id() { return (unsigned)__builtin_amdgcn_s_getreg((3 << 11) | 20) & 0xFu; }
#define XB_SPIN(cond, bar) do { unsigned _sp = 0; while (cond) { __builtin_amdgcn_s_sleep(1); \
    if ((++_sp & 255u) == 0u) { if (xb_ld(&(bar)[XB_TMO])) break; if (_sp > XB_SPIN_CAP) { atomicAdd(&(bar)[XB_TMO], 1u); break; } } } } while (0)
struct XcdBarrier { unsigned* bar; unsigned x; volatile LAS unsigned* st; };
__device__ __forceinline__ XcdBarrier xcd_barrier_post(unsigned* bar, volatile LAS unsigned* st) {
    XcdBarrier b; b.bar = bar; b.x = xb_xcc_id(); b.st = st;
    if (threadIdx.x == 0) (void)xb_add(&bar[XB_XCNT(b.x)], 1u);
    return b;
}
__device__ __forceinline__ void xcd_barrier_complete(unsigned* bar, unsigned x, unsigned& nloc, unsigned& nx) {
    const unsigned G = gridDim.x * gridDim.y * gridDim.z;
    unsigned sum, cnt, mine, sp = 0u;
    for (;;) {
        sum = 0u; cnt = 0u; mine = 0u;
#pragma unroll
        for (unsigned j = 0; j < 16; ++j) { const unsigned c = xb_ld(&bar[XB_XCNT(j)]); sum += c; cnt += (c > 0u) ? 1u : 0u; mine = (j == x) ? c : mine; }
        if (sum == G) break;
        __builtin_amdgcn_s_sleep(1);
        if ((++sp & 255u) == 0u) { if (xb_ld(&bar[XB_TMO])) break; if (sp > XB_SPIN_CAP) { atomicAdd(&bar[XB_TMO], 1u); break; } }
    }
    nloc = mine > 0u ? mine : 1u; nx = cnt > 0u ? cnt : 1u;
}
__device__ __forceinline__ void xcd_barrier(const XcdBarrier& b) {
    asm volatile("s_waitcnt vmcnt(0)" ::: "memory");
    __syncthreads();
    if (threadIdx.x == 0) {
        unsigned* bar = b.bar;
        __builtin_amdgcn_s_waitcnt(0);
        unsigned nloc = b.st[0], nx = b.st[1];
        if (nloc == 0u) { xcd_barrier_complete(bar, b.x, nloc, nx); b.st[0] = nloc; b.st[1] = nx; }
        const unsigned old = xb_add(&bar[XB_XSUB(b.x)], 1u);
        const unsigned gen = old / nloc;
        if (old + 1u == (gen + 1u) * nloc) {
            __builtin_amdgcn_fence(__ATOMIC_RELEASE, "agent");
            asm volatile("s_waitcnt vmcnt(0)" ::: "memory");
            const unsigned og = xb_add(&bar[XB_TOP], 1u);
            const unsigned tg = og / nx;
            if (og + 1u == (tg + 1u) * nx) xb_add(&bar[XB_TOPGEN], 1u);
            else XB_SPIN(xb_ld(&bar[XB_TOPGEN]) == tg, bar);
            __builtin_amdgcn_fence(__ATOMIC_ACQUIRE, "agent");
            xb_add(&bar[XB_XGEN(b.x)], 1u);
            asm volatile("s_waitcnt vmcnt(0)" ::: "memory");
        } else {
            XB_SPIN(xb_ld(&bar[XB_XGEN(b.x)]) == gen, bar);
            __builtin_amdgcn_fence(__ATOMIC_ACQUIRE, "agent");
            asm volatile("s_waitcnt vmcnt(0)" ::: "memory");
        }
    }
    __syncthreads();
}

__device__ __forceinline__ void p0_transpose_item(const float* W, int K, int N, bf16* WT, const float* kscale, LAS float* scr, int item, int lane) {
    const int nblk = N / 32, kb = item / nblk, nb = item % nblk, k0 = 64 * kb, n0 = 32 * nb;
#pragma unroll 8
    for (int i = 0; i < 32; ++i) { const int kk = 2 * i + (lane >> 5); float v = W[(size_t)(k0 + kk) * N + n0 + (lane & 31)]; if (kscale) v *= kscale[k0 + kk]; scr[kk * 33 + (lane & 31)] = v; }
    LDS_WAIT(); asm volatile("" ::: "memory");
    const int c = lane & 7;
#pragma unroll
    for (int j = 0; j < 4; ++j) { const int n = (lane >> 3) + 8 * j; const LAS float* s = scr + (8 * c) * 33 + n;
        v4u o; o.x = cvtpk(s[0 * 33], s[1 * 33]); o.y = cvtpk(s[2 * 33], s[3 * 33]); o.z = cvtpk(s[4 * 33], s[5 * 33]); o.w = cvtpk(s[6 * 33], s[7 * 33]);
        *(GAS v4u*)(WT + (size_t)(n0 + n) * K + k0 + 8 * c) = o; }
    LDS_WAIT(); asm volatile("" ::: "memory");
}

__device__ __forceinline__ void adaln_phase(LAS unsigned char* lds, int vcu, int G, int tid, int wid, int lane, const float* c_prompt, const float* c_sample,
                                            const float* w_ada, const float* b_ada, float* mod) {
    const int fr = lane & 15, g = lane >> 4;
    LAS float* scr = (LAS float*)(lds + wid * 16384);
    const unsigned wvoff = (unsigned)(((lane >> 2) * NMOD + 4 * (lane & 3)) * 4);
    const unsigned coff = (unsigned)((fr * DM + 8 * g) * 4);
    const int scr_w = (lane >> 2) * 52 + 4 * (lane & 3);
    const float* c0row = (fr < 4 ? c_prompt + (size_t)fr * DM : c_sample + (size_t)(fr - 4) * DM) + 8 * g;
    for (int strip = vcu; strip < NMOD / 48; strip += G) {
        const int n0 = strip * 48;
        f32x4 acc[9][3];
#pragma unroll
        for (int rf = 0; rf < 9; ++rf)
#pragma unroll
            for (int nf = 0; nf < 3; ++nf) acc[rf][nf] = (f32x4){0.f, 0.f, 0.f, 0.f};
        for (int kb = 0; kb < 4; ++kb) {
            const int k0 = wid * 256 + kb * 64;
            const char* wb = (const char*)(w_ada + (size_t)k0 * NMOD + n0);
            f32x4 wv[12];
#pragma unroll
            for (int i = 0; i < 12; ++i) wv[i] = *(const f32x4*)(wb + (size_t)(16 * (i / 3)) * NMOD * 4 + 64 * (i % 3) + wvoff);
#pragma unroll
            for (int i = 0; i < 12; ++i) *(LAS f32x4*)(scr + scr_w + 16 * (i / 3) * 52 + 16 * (i % 3)) = wv[i];
            LDS_WAIT(); asm volatile("" ::: "memory");
#pragma unroll 1
            for (int kk = 0; kk < 2; ++kk) {
                bf16x8 bfr[3];
#pragma unroll
                for (int nf = 0; nf < 3; ++nf) { const LAS float* s = scr + (32 * kk + 8 * g) * 52 + 16 * nf + fr;
                    bfr[nf] = pack8((f32x4){s[0], s[52], s[104], s[156]}, (f32x4){s[208], s[260], s[312], s[364]}); }
                const char* cs = (const char*)(c_sample + k0 + 32 * kk);
#pragma unroll
                for (int rf = 0; rf < 9; ++rf) {
                    f32x4 a = (f32x4){0.f, 0.f, 0.f, 0.f}, b = a;
                    if (rf == 0) { a = *(const f32x4*)(c0row + k0 + 32 * kk); b = *(const f32x4*)(c0row + k0 + 32 * kk + 4); }
                    else if (rf < 8) { const char* p = cs + (size_t)(16 * rf - 4) * DM * 4 + coff; a = *(const f32x4*)p; b = *(const f32x4*)(p + 16); }
                    else if (fr < 4) { const char* p = cs + (size_t)(16 * rf - 4) * DM * 4 + coff; a = *(const f32x4*)p; b = *(const f32x4*)(p + 16); }
#pragma unroll
                    for (int e = 0; e < 4; ++e) { a[e] = silu_f(a[e]); b[e] = silu_f(b[e]); }
                    const bf16x8 af = pack8(a, b);
#pragma unroll
                    for (int nf = 0; nf < 3; ++nf) acc[rf][nf] = MFMA16(af, bfr[nf], acc[rf][nf]); }
            }
            LDS_WAIT(); asm volatile("" ::: "memory");
        }
#pragma unroll
        for (int p = 0; p < 3; ++p) {
            __syncthreads();
            LAS float* red = (LAS float*)lds + wid * 2304;
#pragma unroll
            for (int rf = 0; rf < 9; ++rf)
#pragma unroll
                for (int i = 0; i < 4; ++i) red[(16 * rf + 4 * g + i) * 16 + fr] = acc[rf][p][i];
            __syncthreads();
            for (int e = tid; e < 2304; e += 512) { const int r = e >> 4, c = e & 15; float sum = 0.f;
#pragma unroll
                for (int w = 0; w < 8; ++w) sum += ((LAS float*)lds)[w * 2304 + e];
                if (r < 132) mod[(size_t)r * NMOD + n0 + 16 * p + c] = sum + b_ada[n0 + 16 * p + c]; }
        }
        __syncthreads();
    }
}

__device__ __forceinline__ const float* x_row(const float* xp, const float* xs, int m) { return m < MP ? xp + (size_t)m * DM : xs + (size_t)(m - MP) * DM; }
__device__ __forceinline__ int mod_row(int m) { return m < MP ? (m >> 11) : 4 + ((m - MP) >> 2); }

__device__ __forceinline__ void p1_rows(int gw, int NGW, int lane, const float* xp, const float* xs, const float* mod, const float* gpre, bf16* H) {
    for (int m = gw; m < M; m += NGW) {
        const f32x4* xr = (const f32x4*)x_row(xp, xs, m) + lane;
        const float* mr = mod + (size_t)mod_row(m) * NMOD;
        f32x4 v[8]; float s = 0.f;
#pragma unroll
        for (int j = 0; j < 8; ++j) { v[j] = xr[64 * j]; s += (v[j][0] * v[j][0] + v[j][1] * v[j][1]) + (v[j][2] * v[j][2] + v[j][3] * v[j][3]); }
        const float rstd = 1.0f / sqrtf(wave_sum(s) * (1.0f / DM) + EPS);
        v2u* o8 = (v2u*)(H + (size_t)m * DM) + lane;
#pragma unroll
        for (int j = 0; j < 8; ++j) { const int k = 4 * (lane + 64 * j);
            const f32x4 gg = *(const f32x4*)(gpre + k), sh = *(const f32x4*)(mr + k), sc = *(const f32x4*)(mr + DM + k);
            const f32x4 h = v[j] * rstd * gg * (sc + 1.0f) + sh;
            o8[64 * j] = (v2u){cvtpk(h[0], h[1]), cvtpk(h[2], h[3])}; }
    }
}
__device__ __forceinline__ float gemm_row(int m, int lane, const float* O, const float* ssq, const float* slab, f32x4 (&o)[8]) {
    float s;
    if (m < MP) { const f32x4* orow = (const f32x4*)(O + (size_t)m * DM) + lane;
#pragma unroll
        for (int j = 0; j < 8; ++j) o[j] = orow[64 * j];
        s = lane < 32 ? ssq[(size_t)m * 32 + lane] : 0.f;
    } else { const f32x4* srow = (const f32x4*)(slab + (size_t)(m - MP) * DM) + lane;
#pragma unroll
        for (int j = 0; j < 8; ++j) o[j] = srow[64 * j];
#pragma unroll 1
        for (int sl = 1; sl < pg8::NSL; ++sl) { const f32x4* p = srow + (size_t)sl * (512 * DM / 4);
#pragma unroll
            for (int j = 0; j < 8; ++j) o[j] = o[j] + p[64 * j]; }
        s = 0.f;
#pragma unroll
        for (int j = 0; j < 8; ++j) s += (o[j][0] * o[j][0] + o[j][1] * o[j][1]) + (o[j][2] * o[j][2] + o[j][3] * o[j][3]);
    }
    return wave_sum(s);
}
__device__ __forceinline__ void p5_rows(int gw, int NGW, int lane, const float* xp, const float* xs, const float* mod, const float* O, const float* ssqo, const float* slab,
                                        const float* gpost, const float* gpreff, float* out, bf16* H) {
    for (int m = gw; m < M; m += NGW) {
        const f32x4* xr = (const f32x4*)x_row(xp, xs, m) + lane;
        const float* mr = mod + (size_t)mod_row(m) * NMOD;
        f32x4 v[8];
        const float rstdo = 1.0f / sqrtf(gemm_row(m, lane, O, ssqo, slab, v) * (1.0f / DM) + EPS);
        float s = 0.f;
#pragma unroll
        for (int j = 0; j < 8; ++j) { const int k = 4 * (lane + 64 * j);
            const f32x4 gt = *(const f32x4*)(mr + 2 * DM + k), gp = *(const f32x4*)(gpost + k);
            v[j] = xr[64 * j] + gt * (v[j] * rstdo * gp);
            s += (v[j][0] * v[j][0] + v[j][1] * v[j][1]) + (v[j][2] * v[j][2] + v[j][3] * v[j][3]); }
        const float rstd = 1.0f / sqrtf(wave_sum(s) * (1.0f / DM) + EPS);
        f32x4* xo = (f32x4*)(out + (size_t)m * DM) + lane;
        v2u* o8 = (v2u*)(H + (size_t)m * DM) + lane;
#pragma unroll
        for (int j = 0; j < 8; ++j) { const int k = 4 * (lane + 64 * j);
            xo[64 * j] = v[j];
            const f32x4 gg = *(const f32x4*)(gpreff + k), sh = *(const f32x4*)(mr + 3 * DM + k), sc = *(const f32x4*)(mr + 4 * DM + k);
            const f32x4 h = v[j] * rstd * gg * (sc + 1.0f) + sh;
            o8[64 * j] = (v2u){cvtpk(h[0], h[1]), cvtpk(h[2], h[3])}; }
    }
}
__device__ __forceinline__ void p8_rows(int gw, int NGW, int lane, const float* mod, const float* F, const float* ssqf, const float* slab, const float* gpostff, float* out) {
    for (int m = gw; m < M; m += NGW) {
        f32x4* xo = (f32x4*)(out + (size_t)m * DM) + lane;
        const float* mr = mod + (size_t)mod_row(m) * NMOD;
        f32x4 v[8];
        const float rstdf = 1.0f / sqrtf(gemm_row(m, lane, F, ssqf, slab, v) * (1.0f / DM) + EPS);
#pragma unroll
        for (int j = 0; j < 8; ++j) { const int k = 4 * (lane + 64 * j);
            const f32x4 gt = *(const f32x4*)(mr + 5 * DM + k), gp = *(const f32x4*)(gpostff + k);
            xo[64 * j] = xo[64 * j] + gt * (v[j] * rstdf * gp); }
    }
}

constexpr int AT_K = 0, AT_V = 36864, AT_LUT = 70656;
__device__ __forceinline__ void attn_prompt_unit(LAS unsigned char* lds, int b, int nb, int h, const bf16* Qb, const bf16* Kb, const bf16* Vb, bf16* MG, float* ssqm,
                                                 const float* sinks, int tid, int wid, int lane) {
    const int kvh = h >> 3, tokq = b * 2048 + nb * 128, tokk = tokq - 128;
    const LAS int* bkt = (const LAS int*)(lds + X_BKT); const LAS float* tab = (const LAS float*)(lds + X_TAB);
    __syncthreads();
#pragma unroll
    for (int i = 0; i < 4; ++i) { const int idx = tid + 512 * i, key = idx >> 3, ch = idx & 7;
        v4u v = (v4u){0u, 0u, 0u, 0u}; if (nb > 0 || key >= 128) v = *(const v4u*)(Kb + (size_t)(tokk + key) * 128 + kvh * 64 + ch * 8);
        *(LAS v4u*)(lds + AT_K + key * 144 + ch * 16) = v; }
#pragma unroll
    for (int i = 0; i < 4; ++i) { const int idx = tid + 512 * i, key = idx & 255, ch = idx >> 8;
        v4u v = (v4u){0u, 0u, 0u, 0u}; if (nb > 0 || key >= 128) v = *(const v4u*)(Vb + (size_t)(tokk + key) * 128 + kvh * 64 + ch * 8);
        LAS unsigned short* vt = (LAS unsigned short*)(lds + AT_V) + (ch * 8) * 264 + key;
        vt[0 * 264] = (unsigned short)(v.x & 0xffffu); vt[1 * 264] = (unsigned short)(v.x >> 16); vt[2 * 264] = (unsigned short)(v.y & 0xffffu); vt[3 * 264] = (unsigned short)(v.y >> 16);
        vt[4 * 264] = (unsigned short)(v.z & 0xffffu); vt[5 * 264] = (unsigned short)(v.z >> 16); vt[6 * 264] = (unsigned short)(v.w & 0xffffu); vt[7 * 264] = (unsigned short)(v.w >> 16); }
    if (tid < 128) ((LAS float*)(lds + AT_LUT))[tid] = tab[bkt[tid] * 16 + h];
    __syncthreads();
    const int fr = lane & 15, g = lane >> 4, f0 = wid < 6 ? wid : 6, qi = 16 * wid + fr;
    const bf16* qp = Qb + (size_t)(tokq + qi) * 1024 + h * 64 + 8 * g;
    const bf16x8 q0 = *(const bf16x8*)qp, q1 = *(const bf16x8*)(qp + 32);
    f32x4 s[10];
#pragma unroll
    for (int f = 0; f < 10; ++f) { const LAS unsigned char* kp = lds + AT_K + (16 * (f0 + f) + fr) * 144 + 16 * g;
        const bf16x8 k0 = *(const LAS bf16x8*)kp, k1 = *(const LAS bf16x8*)(kp + 64);
        s[f] = MFMA16(k0, q0, ((f32x4){0.f, 0.f, 0.f, 0.f})); s[f] = MFMA16(k1, q1, s[f]); }
    const LAS float* lut = (const LAS float*)(lds + AT_LUT);
    const float sk = sinks[h] * LOG2E;
    float mx = -INFINITY;
#pragma unroll
    for (int f = 0; f < 10; ++f)
#pragma unroll
        for (int i = 0; i < 4; ++i) { const int kj = 16 * (f0 + f) + 4 * g + i, dist = 128 + qi - kj; const bool valid = (dist >= 0) && (dist < 128) && (nb > 0 || kj >= 128);
            const float v = valid ? s[f][i] + lut[dist & 127] : -INFINITY; s[f][i] = v; mx = fmaxf(mx, v); }
    mx = fmaxf(mx, __shfl_xor(mx, 16)); mx = fmaxf(mx, __shfl_xor(mx, 32)); mx = fmaxf(mx, sk);
    float l = 0.f;
#pragma unroll
    for (int f = 0; f < 10; ++f)
#pragma unroll
        for (int i = 0; i < 4; ++i) { const float p = __builtin_amdgcn_exp2f(s[f][i] - mx); s[f][i] = p; l += p; }
    l += __shfl_xor(l, 16); l += __shfl_xor(l, 32); l += __builtin_amdgcn_exp2f(sk - mx);
    const float rl = 1.0f / l;
    f32x4 o[4];
#pragma unroll
    for (int df = 0; df < 4; ++df) o[df] = (f32x4){0.f, 0.f, 0.f, 0.f};
#pragma unroll
    for (int si = 0; si < 5; ++si) { const bf16x8 pb = pack8(s[2 * si], s[2 * si + 1]); const int key0 = 16 * (f0 + 2 * si);
#pragma unroll
        for (int df = 0; df < 4; ++df) { const LAS unsigned char* vp = lds + AT_V + ((16 * df + fr) * 264 + key0 + 4 * g) * 2;
            const v2u lo = *(const LAS v2u*)vp, hi = *(const LAS v2u*)(vp + 32);
            const bf16x8 va = __builtin_bit_cast(bf16x8, ((v4u){lo.x, lo.y, hi.x, hi.y}));
            o[df] = MFMA16(va, pb, o[df]); } }
    float ss = 0.f; bf16* op = MG + (size_t)(tokq + qi) * DM + h * 64 + 4 * g;
#pragma unroll
    for (int df = 0; df < 4; ++df) { const f32x4 v = o[df] * rl; ss += (v[0] * v[0] + v[1] * v[1]) + (v[2] * v[2] + v[3] * v[3]);
        *(v2u*)(op + 16 * df) = (v2u){cvtpk(v[0], v[1]), cvtpk(v[2], v[3])}; }
    ss += __shfl_xor(ss, 16); ss += __shfl_xor(ss, 32);
    if (g == 0) ssqm[(size_t)(tokq + qi) * 24 + h] = ss;
}

constexpr int SA_K = 0, SA_V = 41472, SA_END = 84480;
__device__ __forceinline__ void attn_sample_unit(LAS unsigned char* lds, int db, const bf16* Qb, const bf16* Kb, const bf16* Vb, const float* cache_k, const float* cache_v,
                                                 bf16* MG, float* ssqm, const float* sinks, int tid, int wid, int lane) {
    const LAS int* bkt = (const LAS int*)(lds + X_BKT); const LAS float* tab = (const LAS float*)(lds + X_TAB);
    const int tok0 = MP + db * 4;
    __syncthreads();
    for (int i = tid; i < SA_END / 16; i += 512) *(LAS v4u*)(lds + i * 16) = (v4u){0u, 0u, 0u, 0u};
    __syncthreads();
#pragma unroll
    for (int i = 0; i < 8; ++i) { const int idx = tid + 512 * i, j = idx >> 5, kvh = (idx >> 4) & 1, c4 = idx & 15;
        const f32x4 kv = *(const f32x4*)(cache_k + (size_t)db * 16384 + (size_t)idx * 4), vv = *(const f32x4*)(cache_v + (size_t)db * 16384 + (size_t)idx * 4);
        *(LAS v2u*)(lds + SA_K + (kvh * 144 + j) * 144 + 8 * c4) = (v2u){cvtpk(kv[0], kv[1]), cvtpk(kv[2], kv[3])};
        const unsigned w0 = cvtpk(vv[0], vv[1]), w1 = cvtpk(vv[2], vv[3]);
        LAS unsigned short* vt = (LAS unsigned short*)(lds + SA_V) + (kvh * 64 + 4 * c4) * 168 + j;
        vt[0] = (unsigned short)(w0 & 0xffffu); vt[168] = (unsigned short)(w0 >> 16); vt[336] = (unsigned short)(w1 & 0xffffu); vt[504] = (unsigned short)(w1 >> 16); }
    if (tid < 64) { const int t = tid >> 4, kvh = (tid >> 3) & 1, ch = tid & 7;
        const v4u kv = *(const v4u*)(Kb + (size_t)(tok0 + t) * 128 + kvh * 64 + 8 * ch), vv = *(const v4u*)(Vb + (size_t)(tok0 + t) * 128 + kvh * 64 + 8 * ch);
        *(LAS v4u*)(lds + SA_K + (kvh * 144 + 128 + t) * 144 + 16 * ch) = kv;
        LAS unsigned short* vt = (LAS unsigned short*)(lds + SA_V) + (kvh * 64 + 8 * ch) * 168 + 128 + t;
        vt[0 * 168] = (unsigned short)(vv.x & 0xffffu); vt[1 * 168] = (unsigned short)(vv.x >> 16); vt[2 * 168] = (unsigned short)(vv.y & 0xffffu); vt[3 * 168] = (unsigned short)(vv.y >> 16);
        vt[4 * 168] = (unsigned short)(vv.z & 0xffffu); vt[5 * 168] = (unsigned short)(vv.z >> 16); vt[6 * 168] = (unsigned short)(vv.w & 0xffffu); vt[7 * 168] = (unsigned short)(vv.w >> 16); }
    __syncthreads();
    if (wid < 4) {
        const int fr = lane & 15, g = lane >> 4, kvh = wid >> 1, hh = 4 * wid + (fr >> 2), t = fr & 3;
        const bf16* qp = Qb + (size_t)(tok0 + t) * 1024 + hh * 64 + 8 * g;
        const bf16x8 q0 = *(const bf16x8*)qp, q1 = *(const bf16x8*)(qp + 32);
        f32x4 s[10];
#pragma unroll
        for (int f = 0; f < 9; ++f) { const LAS unsigned char* kp = lds + SA_K + (kvh * 144 + 16 * f + fr) * 144 + 16 * g;
            const bf16x8 k0 = *(const LAS bf16x8*)kp, k1 = *(const LAS bf16x8*)(kp + 64);
            s[f] = MFMA16(k0, q0, ((f32x4){0.f, 0.f, 0.f, 0.f})); s[f] = MFMA16(k1, q1, s[f]); }
        s[9] = (f32x4){0.f, 0.f, 0.f, 0.f};
        const float sk = sinks[hh] * LOG2E;
        float mx = -INFINITY;
#pragma unroll
        for (int f = 0; f < 9; ++f)
#pragma unroll
            for (int i = 0; i < 4; ++i) { const int j = 16 * f + 4 * g + i, dist = 128 + t - j; const bool valid = (dist >= 0) && (dist < 128);
                const float v = valid ? s[f][i] + tab[bkt[dist & 127] * 16 + hh] : -INFINITY; s[f][i] = v; mx = fmaxf(mx, v); }
        mx = fmaxf(mx, __shfl_xor(mx, 16)); mx = fmaxf(mx, __shfl_xor(mx, 32)); mx = fmaxf(mx, sk);
        float l = 0.f;
#pragma unroll
        for (int f = 0; f < 9; ++f)
#pragma unroll
            for (int i = 0; i < 4; ++i) { const float p = __builtin_amdgcn_exp2f(s[f][i] - mx); s[f][i] = p; l += p; }
        l += __shfl_xor(l, 16); l += __shfl_xor(l, 32); l += __builtin_amdgcn_exp2f(sk - mx);
        const float rl = 1.0f / l;
        f32x4 o[4];
#pragma unroll
        for (int df = 0; df < 4; ++df) o[df] = (f32x4){0.f, 0.f, 0.f, 0.f};
#pragma unroll
        for (int si = 0; si < 5; ++si) { const bf16x8 pb = pack8(s[2 * si], s[2 * si + 1]);
#pragma unroll
            for (int df = 0; df < 4; ++df) { const LAS unsigned char* vp = lds + SA_V + ((kvh * 64 + 16 * df + fr) * 168 + 32 * si + 4 * g) * 2;
                const v2u lo = *(const LAS v2u*)vp, hi = *(const LAS v2u*)(vp + 32);
                const bf16x8 va = __builtin_bit_cast(bf16x8, ((v4u){lo.x, lo.y, hi.x, hi.y}));
                o[df] = MFMA16(va, pb, o[df]); } }
        float ss = 0.f; bf16* op = MG + (size_t)(tok0 + t) * DM + hh * 64 + 4 * g;
#pragma unroll
        for (int df = 0; df < 4; ++df) { const f32x4 v = o[df] * rl; ss += (v[0] * v[0] + v[1] * v[1]) + (v[2] * v[2] + v[3] * v[3]);
            *(v2u*)(op + 16 * df) = (v2u){cvtpk(v[0], v[1]), cvtpk(v[2], v[3])}; }
        ss += __shfl_xor(ss, 16); ss += __shfl_xor(ss, 32);
        if (g == 0) ssqm[(size_t)(tok0 + t) * 24 + hh] = ss;
    }
}

constexpr int GM_W = 0, GM_V = 34816, GM_RED = 69632;
__device__ __forceinline__ void gmlp_prompt_unit(LAS unsigned char* lds, int b, int n, int h, const bf16* GU, const bf16* GV, const float* w_s, const float* b_s, const float* vgain,
                                                 bf16* MG, float* ssqm, int tid, int wid, int lane) {
    const int tok0 = b * 2048 + n * 128;
    __syncthreads();
#pragma unroll
    for (int ii = 0; ii < 8; ++ii) { const int idx = tid + 512 * ii, i = idx >> 5, j4 = idx & 31; f32x4 w = *(const f32x4*)(w_s + ((size_t)h * 128 + i) * 128 + 4 * j4);
#pragma unroll
        for (int e = 0; e < 4; ++e) if (4 * j4 + e > i) w[e] = 0.f;
        *(LAS v2u*)(lds + GM_W + i * 272 + 8 * j4) = (v2u){cvtpk(w[0], w[1]), cvtpk(w[2], w[3])}; }
    const int j = tid & 127, chq = tid >> 7;
    v4u vr[4]; float sq = 0.f;
#pragma unroll
    for (int ii = 0; ii < 4; ++ii) { const int ch = chq + 4 * ii; vr[ii] = *(const v4u*)(GV + (size_t)(tok0 + j) * 1024 + h * 128 + 8 * ch);
#pragma unroll
        for (int e = 0; e < 4; ++e) { const float a = bflo(vr[ii][e]), c = bfhi(vr[ii][e]); sq += a * a + c * c; } }
    ((LAS float*)(lds + GM_RED))[chq * 128 + j] = sq;
    __syncthreads();
    { const LAS float* red = (const LAS float*)(lds + GM_RED); const float tot = (red[j] + red[128 + j]) + (red[256 + j] + red[384 + j]);
      const float rstd = 1.0f / sqrtf(tot * (1.0f / 128.0f) + EPS);
      LAS unsigned short* vt = (LAS unsigned short*)(lds + GM_V);
#pragma unroll
      for (int ii = 0; ii < 4; ++ii) { const int ch = chq + 4 * ii; const f32x4 g0 = *(const f32x4*)(vgain + h * 128 + 8 * ch), g1 = *(const f32x4*)(vgain + h * 128 + 8 * ch + 4);
#pragma unroll
          for (int e = 0; e < 4; ++e) { const float ga = e < 2 ? g0[2 * e] : g1[2 * e - 4], gb = e < 2 ? g0[2 * e + 1] : g1[2 * e - 3];
              const unsigned w = cvtpk(bflo(vr[ii][e]) * rstd * ga, bfhi(vr[ii][e]) * rstd * gb);
              vt[(8 * ch + 2 * e) * 136 + j] = (unsigned short)(w & 0xffffu); vt[(8 * ch + 2 * e + 1) * 136 + j] = (unsigned short)(w >> 16); } } }
    __syncthreads();
    const int fr = lane & 15, g = lane >> 4, ns = (wid >> 1) + 1;
    f32x4 acc[8];
#pragma unroll
    for (int cf = 0; cf < 8; ++cf) acc[cf] = (f32x4){0.f, 0.f, 0.f, 0.f};
    for (int s = 0; s < ns; ++s) { const bf16x8 bw = *(const LAS bf16x8*)(lds + GM_W + (16 * wid + fr) * 272 + (32 * s + 8 * g) * 2);
#pragma unroll
        for (int cf = 0; cf < 8; ++cf) { const bf16x8 av = *(const LAS bf16x8*)(lds + GM_V + (16 * cf + fr) * 272 + (32 * s + 8 * g) * 2); acc[cf] = MFMA16(av, bw, acc[cf]); } }
    const int i = 16 * wid + fr, tok = tok0 + i; const float bs = b_s[h * 128 + i]; float ss = 0.f;
    const bf16* up = GU + (size_t)tok * 1024 + h * 128 + 4 * g; bf16* op = MG + (size_t)tok * DM + 1024 + h * 128 + 4 * g;
#pragma unroll
    for (int cf = 0; cf < 8; ++cf) { const v2u uu = *(const v2u*)(up + 16 * cf);
        f32x4 v; v[0] = bflo(uu.x) * (acc[cf][0] + bs); v[1] = bfhi(uu.x) * (acc[cf][1] + bs); v[2] = bflo(uu.y) * (acc[cf][2] + bs); v[3] = bfhi(uu.y) * (acc[cf][3] + bs);
        ss += (v[0] * v[0] + v[1] * v[1]) + (v[2] * v[2] + v[3] * v[3]);
        *(v2u*)(op + 16 * cf) = (v2u){cvtpk(v[0], v[1]), cvtpk(v[2], v[3])}; }
    ss += __shfl_xor(ss, 16); ss += __shfl_xor(ss, 32);
    if (g == 0) ssqm[(size_t)tok * 24 + 16 + h] = ss;
}

__device__ __forceinline__ void gmlp_sample_wave(int db, int h, const bf16* GU, const bf16* GV, const float* w_s, const float* b_s, const float* vgain, bf16* MG, float* ssqm, float* out, int lane) {
    const int tok0 = MP + db * 4, c = 2 * lane;
    const f32x2 gn = *(const f32x2*)(vgain + h * 128 + c);
    float vn[4][2];
#pragma unroll
    for (int t = 0; t < 4; ++t) { const unsigned w = *(const unsigned*)(GV + (size_t)(tok0 + t) * 1024 + h * 128 + c); const float a = bflo(w), b2 = bfhi(w);
        const float rstd = 1.0f / sqrtf(wave_sum(a * a + b2 * b2) * (1.0f / 128.0f) + EPS);
        vn[t][0] = a * rstd * gn[0]; vn[t][1] = b2 * rstd * gn[1];
        *(f32x2*)(out + pg8::OGV + ((size_t)(db * 4 + t) * 8 + h) * 128 + c) = (f32x2){vn[t][0], vn[t][1]}; }
#pragma unroll
    for (int i = 0; i < 4; ++i) { float m0 = b_s[h * 128 + i], m1 = m0;
#pragma unroll
        for (int jj = 0; jj <= i; ++jj) { const float w = w_s[((size_t)h * 128 + i) * 128 + jj]; m0 += w * vn[jj][0]; m1 += w * vn[jj][1]; }
        const unsigned uw = *(const unsigned*)(GU + (size_t)(tok0 + i) * 1024 + h * 128 + c);
        const float o0 = bflo(uw) * m0, o1 = bfhi(uw) * m1;
        *(unsigned*)(MG + (size_t)(tok0 + i) * DM + 1024 + h * 128 + c) = cvtpk(o0, o1);
        const float ss = wave_sum(o0 * o0 + o1 * o1);
        if (lane == 0) ssqm[(size_t)(tok0 + i) * 24 + 16 + h] = ss; }
}

__device__ __forceinline__ const float* in_ptr(LAS unsigned char* lds, int i) {
    const unsigned long long v = ((const LAS unsigned long long*)(lds + X_PTR))[i];
    const unsigned lo = __builtin_amdgcn_readfirstlane((unsigned)v), hi = __builtin_amdgcn_readfirstlane((unsigned)(v >> 32));
    return (const float*)(const GAS float*)(((unsigned long long)hi << 32) | lo);
}
struct Args { const float* in[23]; float* out; unsigned char* ws; int ph_lo, ph_hi; };
__global__ void __launch_bounds__(NWAVES * 64, 2) mk_fwd(Args args) {
    extern __shared__ __attribute__((aligned(16))) unsigned char lds_raw[];
    LAS unsigned char* lds = (LAS unsigned char*)lds_raw;
    const int tid = threadIdx.x, lane = tid & 63, wid = __builtin_amdgcn_readfirstlane(tid >> 6);
    const int G = gridDim.x, bx = blockIdx.x, vcu = (G % 8 == 0) ? (bx % 8) * (G / 8) + bx / 8 : bx;
    const int gw = vcu * NWAVES + wid, NGW = G * NWAVES;
    unsigned char* ws = args.ws;
    float* out = args.out;
    bf16* Win_t = (bf16*)(ws + WS_WIN); bf16* Wout_t = (bf16*)(ws + WS_WOUT); bf16* Wff1_t = (bf16*)(ws + WS_WFF1); bf16* Wff2_t = (bf16*)(ws + WS_WFF2);
    float* mod = (float*)(ws + WS_MOD); float* ssqm = (float*)(ws + WS_SSQM); float* ssqo = (float*)(ws + WS_SSQO); float* ssqf = (float*)(ws + WS_SSQF);
    bf16* H = (bf16*)(ws + WS_H); bf16* Qb = (bf16*)(ws + WS_Q); bf16* Kb = (bf16*)(ws + WS_K); bf16* Vb = (bf16*)(ws + WS_V); bf16* GU = (bf16*)(ws + WS_GU); bf16* GV = (bf16*)(ws + WS_GV);
    bf16* MG = (bf16*)(ws + WS_MG); float* Ob = (float*)(ws + WS_O); bf16* F1 = (bf16*)(ws + WS_F1); float* Fb = (float*)(ws + WS_F);

    for (int u = tid; u < (LDS_BYTES - X_MISC) / 4; u += NWAVES * 64) ((LAS unsigned*)(lds + X_MISC))[u] = 0u;
    if (tid < 128) { const int n = tid; int bk = n; if (n >= 16) { bk = 16 + (int)(logf((float)n / 16.0f) / 2.0794415416798357f * 16.0f); bk = bk < 31 ? bk : 31; } ((LAS int*)(lds + X_BKT))[tid] = bk; }
    ((LAS float*)(lds + X_TAB))[tid] = args.in[6][tid] * LOG2E;
    if (tid < 23) ((LAS unsigned long long*)(lds + X_PTR))[tid] = (unsigned long long)args.in[tid];
    __syncthreads();
#define INP(i) in_ptr(lds, (i))
#if !MK_CG_SYNC
    XcdBarrier bar = xcd_barrier_post((unsigned*)(ws + WS_CTL) + CW_BAR, (volatile LAS unsigned*)(lds + X_MISC));
#define GRID_BAR(seam) do { if ((seam) == 0) cg::this_grid().sync(); else xcd_barrier(bar); } while (0)
#else
#define GRID_BAR(seam) cg::this_grid().sync()
#endif
    const int lo = args.ph_lo, hi = args.ph_hi;
#ifndef PH_MASK
#define PH_MASK 0x1ff
#endif
#define IN(k) ((((PH_MASK) >> (k)) & 1) && lo <= (k) && (k) < hi)
#define BOTH(k) (IN(k) && IN((k) + 1))

    if (IN(0)) {
        adaln_phase(lds, vcu, G, tid, wid, lane, INP(4), INP(5), INP(7), INP(8), mod);
        LAS float* scr = (LAS float*)(lds + wid * 16384);
        constexpr int I_IN = (DM / 64) * (INC / 32), I_OUT = (DM / 64) * (DM / 32), I_F1 = (DM / 64) * (DFF / 32), I_F2 = (DFF / 64) * (DM / 32);
        constexpr int NITEMS = I_IN + I_OUT + I_F1 + I_F2;
        for (int it = gw; it < NITEMS; it += NGW) {
            int r = it;
            if (r < I_IN) { p0_transpose_item(INP(10), DM, INC, Win_t, nullptr, scr, r, lane); continue; } r -= I_IN;
            if (r < I_OUT) { const int kb = r / (DM / 32); p0_transpose_item(INP(17), DM, DM, Wout_t, kb < 16 ? INP(15) : INP(16) - 1024, scr, r, lane); continue; } r -= I_OUT;
            if (r < I_F1) { p0_transpose_item(INP(20), DM, DFF, Wff1_t, nullptr, scr, r, lane); continue; } r -= I_F1;
            p0_transpose_item(INP(21), DFF, DM, Wff2_t, nullptr, scr, r, lane);
        }
        if (BOTH(0)) GRID_BAR(0);
    }
    if (IN(1)) { p1_rows(gw, NGW, lane, INP(0), INP(1), mod, INP(9), H); if (BOTH(1)) GRID_BAR(1); }
    if (IN(2)) {
        pg8::Gemm g{H, Win_t, M, INC, DM}; pg8::StaticOrder S; S.init(M, INC, DM, G, bx);
        pg8::EpiInProj E{Qb, Kb, Vb, GU, GV, out};
        pg8::gemm_phase<pg8::EpiInProj, pg8::StaticOrder, true, true>(lds, g, S, E);
        if (BOTH(2)) GRID_BAR(2);
    }
    if (IN(3)) {
        constexpr int N_AP = 1024, N_GP = 512, N_SA = 128, N_SG = 128;
        for (int r = vcu; r < N_AP; r += G) attn_prompt_unit(lds, r >> 8, (r >> 4) & 15, r & 15, Qb, Kb, Vb, MG, ssqm, INP(11), tid, wid, lane);
        for (int r = vcu; r < N_GP; r += G) gmlp_prompt_unit(lds, r >> 7, (r >> 3) & 15, r & 7, GU, GV, INP(13), INP(14), INP(12), MG, ssqm, tid, wid, lane);
        for (int r = vcu; r < N_SA; r += G) attn_sample_unit(lds, r, Qb, Kb, Vb, INP(2), INP(3), MG, ssqm, INP(11), tid, wid, lane);
        for (int r = (vcu + G - (G >> 1)) % G; r < N_SG; r += G) { const int wu = r * 8 + wid; gmlp_sample_wave(wu >> 3, wu & 7, GU, GV, INP(13), INP(14), INP(12), MG, ssqm, out, lane); }
        __syncthreads();
        if (BOTH(3)) GRID_BAR(3);
    }
    if (IN(4)) {
        pg8::Gemm g{MG, Wout_t, M, DM, DM}; pg8::SplitOrder S; S.init(DM, G, bx);
        pg8::EpiF32Ssq<true> E{Ob, ssqo, ssqm, (LAS float*)(lds + X_RATIO), (float*)(ws + WS_SLAB4)};
        pg8::gemm_phase<pg8::EpiF32Ssq<true>, pg8::SplitOrder, true, true>(lds, g, S, E);
        if (BOTH(4)) GRID_BAR(4);
    }
    if (IN(5)) { p5_rows(gw, NGW, lane, INP(0), INP(1), mod, Ob, ssqo, (const float*)(ws + WS_SLAB4), INP(18), INP(19), out, H); if (BOTH(5)) GRID_BAR(5); }
    if (IN(6)) {
        pg8::Gemm g{H, Wff1_t, M, DFF, DM}; pg8::StaticOrder S; S.init(M, DFF, DM, G, bx);
        pg8::EpiRelu2 E{F1, DFF};
        pg8::gemm_phase<pg8::EpiRelu2, pg8::StaticOrder, true, true>(lds, g, S, E);
        if (BOTH(6)) GRID_BAR(6);
    }
    if (IN(7)) {
        pg8::Gemm g{F1, Wff2_t, M, DM, DFF}; pg8::SplitOrder S; S.init(DFF, G, bx);
        pg8::EpiF32Ssq<false> E{Fb, ssqf, nullptr, (LAS float*)(lds + X_RATIO), (float*)(ws + WS_SLAB7)};
        pg8::gemm_phase<pg8::EpiF32Ssq<false>, pg8::SplitOrder, true, true>(lds, g, S, E);
        if (BOTH(7)) GRID_BAR(7);
    }
    if (IN(8)) { p8_rows(gw, NGW, lane, mod, Fb, ssqf, (const float*)(ws + WS_SLAB7), INP(22), out); }
#undef IN
#undef BOTH
}

extern "C" void kernel_launch(void* const* d_in, const int* in_sizes, int n_in, void* d_out, int out_size, void* d_ws, size_t ws_size, hipStream_t stream) {
    static int grid = 0;
    if (grid == 0) {
        if (n_in != 23 || out_size != pg8::OUT_TOTAL || ws_size < WS_END) { fprintf(stderr, "kernel_launch: unexpected shapes: n_in %d out %d ws %zu (need >= %zu)\n", n_in, out_size, ws_size, (size_t)WS_END); grid = -1; return; }
        int dev = 0, cus = 0, per_cu = 0;
        if (hipGetDevice(&dev) != hipSuccess || hipDeviceGetAttribute(&cus, hipDeviceAttributeMultiprocessorCount, dev) != hipSuccess) { grid = -1; return; }
        if (hipFuncSetAttribute((const void*)mk_fwd, hipFuncAttributeMaxDynamicSharedMemorySize, LDS_BYTES) != hipSuccess) { fprintf(stderr, "kernel_launch: hipFuncSetAttribute failed\n"); grid = -1; return; }
        if (hipOccupancyMaxActiveBlocksPerMultiprocessor(&per_cu, (const void*)mk_fwd, NWAVES * 64, LDS_BYTES) != hipSuccess || per_cu < 1) { fprintf(stderr, "kernel_launch: occupancy query says %d\n", per_cu); (void)hipGetLastError(); grid = -1; return; }
        grid = cus;
    }
    if (grid < 0) return;
    (void)hipMemsetAsync((char*)d_ws + WS_CTL, 0, CTL_ZERO_BYTES, stream);
    Args a{};
    for (int i = 0; i < 23; ++i) a.in[i] = (const float*)d_in[i];
    a.out = (float*)d_out; a.ws = (unsigned char*)d_ws;
    if (N_LAUNCHES == 1) {
        a.ph_lo = 0; a.ph_hi = N_PHASES;
        void* kargs[] = {&a};
        hipError_t e = hipLaunchCooperativeKernel((const void*)mk_fwd, dim3(grid), dim3(NWAVES * 64), kargs, LDS_BYTES, stream);
        if (e != hipSuccess) fprintf(stderr, "kernel_launch: cooperative launch failed: %s (grid %d)\n", hipGetErrorString(e), grid);
    } else {
        for (int p = 0; p < N_PHASES; ++p) { a.ph_lo = p; a.ph_hi = p + 1;
            hipLaunchKernelGGL(mk_fwd, dim3(grid), dim3(NWAVES * 64), LDS_BYTES, stream, a); }
    }
}
```

```cpp
#include <hip/hip_runtime.h>
#include <hip/hip_cooperative_groups.h>
#include <cstdio>
#include <cstdint>
#include <cmath>
namespace cg = cooperative_groups;

#ifndef MK_N_LAUNCHES
#define MK_N_LAUNCHES 1
#endif
#ifndef MK_CG_SYNC
#define MK_CG_SYNC 0
#endif

namespace pg8 {
#define PG8_LAS __attribute__((address_space(3)))
typedef unsigned short bf16_t;
typedef short bf16x8 __attribute__((ext_vector_type(8)));
typedef float f32x4 __attribute__((ext_vector_type(4)));
typedef unsigned u32x4 __attribute__((ext_vector_type(4)));
typedef unsigned u32x2 __attribute__((ext_vector_type(2)));
constexpr int BM = 256, BK = 64, HALF = 128, HTB = HALF * BK * 2, STAGE_BYTES = 8 * HTB, NXCD = 8, WGM = 8;

__host__ __device__ __forceinline__ int lds_byte(int r, int c) { const int st = (r >> 4) * 2 + (c >> 5), rr = r & 15, cc = c & 31, ob = rr * 64 + cc * 2; return st * 1024 + (ob ^ (((ob >> 9) & 1) << 5)); }
__host__ __device__ __forceinline__ void stage_rc(int b, int& R, int& C) { const int st = b / 1024, sb = b % 1024, swz = sb ^ (((sb >> 9) & 1) << 5); R = (st >> 1) * 16 + swz / 64; C = (st & 1) * 32 + (swz % 64) / 2; }
__host__ __device__ __forceinline__ int perm32(int rho) { const int n = rho >> 4, i = rho & 15; return 8 * (i >> 2) + 4 * n + (i & 3); }

struct Unit { int pm, pn, kt0, nkt, slice; };
struct Gemm { const bf16_t* A; const bf16_t* Bt; int M, N, K; };

struct StaticOrder {
    int nM, nN, nwg, G, c, ntf;
    __host__ __device__ __forceinline__ void init(int M, int N, int K, int G_, int c_) { nM = M / BM; nN = N / BM; nwg = nM * nN; G = G_; c = c_; ntf = K / BK; }
    __host__ __device__ __forceinline__ void unit_of(int L, Unit& u) const {
        int wgid = L; { const int q = nwg / NXCD, r = nwg % NXCD, xcd = wgid % NXCD, off = wgid / NXCD; wgid = (xcd < r ? xcd * (q + 1) : r * (q + 1) + (xcd - r) * q) + off; }
        const int nig = WGM * nN, gid = wgid / nig, fm = gid * WGM, gsz = (nM - fm) < WGM ? (nM - fm) : WGM;
        u.pm = fm + ((wgid % nig) % gsz); u.pn = (wgid % nig) / gsz; u.kt0 = 0; u.nkt = ntf; u.slice = -1;
    }
    __host__ __device__ __forceinline__ bool next(int i, Unit& u) const { const long L = (long)i * G + c; if (L >= nwg) return false; unit_of((int)L, u); return true; }
    __device__ __forceinline__ void a_ready(const Unit&) const {}
    __device__ __forceinline__ void done(const Unit&) const {}
};
constexpr int NSL = 16;
struct SplitOrder {
    StaticOrder full; int G, c, ntf;
    __host__ __device__ __forceinline__ void init(int K, int G_, int c_) { full.init(8192, 2048, K, G_, c_); G = G_; c = c_; ntf = K / BK; }
    __host__ __device__ __forceinline__ bool next(int i, Unit& u) const {
        const long L = (long)i * G + c; if (L >= 512) return false;
        const bool isfull = L < 256;
        Unit f; full.unit_of(isfull ? (int)L : 0, f);
        const int j = (int)L - 256, tile = j / NSL, sl = j % NSL, nsk = ntf / NSL;
        u.pm = isfull ? f.pm : 32 + (tile >> 3); u.pn = isfull ? f.pn : (tile & 7); u.nkt = isfull ? ntf : nsk; u.kt0 = isfull ? 0 : sl * nsk; u.slice = isfull ? -1 : sl; return true;
    }
    __device__ __forceinline__ void a_ready(const Unit&) const {}
    __device__ __forceinline__ void done(const Unit&) const {}
};

__device__ __forceinline__ unsigned cvt_pk_bf16(float lo, float hi) { unsigned r; asm volatile("v_cvt_pk_bf16_f32 %0, %1, %2" : "=v"(r) : "v"(lo), "v"(hi)); return r; }

__device__ __forceinline__ float gelu_tanh(float x) {
    const float u = x * (0.7978845608028654f + 0.035677408136300125f * x * x);
    const float e = __builtin_amdgcn_exp2f(-2.885390081777927f * u);
    return x * __builtin_amdgcn_rcpf(1.0f + e);
}

constexpr int OY = 0, OKP = 17825792, OVP = 17891328, OKS = 17956864, OVS = 18022400, OGV = 18087936, OUT_TOTAL = 18612224;
constexpr float QSCALE = 0.125f * 1.4426950408889634f;

struct EpiInProj {
    static constexpr bool PERM = true, AFTER_DRAIN = false, MID = false;
    bf16_t *Q, *Kb, *Vb, *GU, *GV; float* out;
    __device__ __forceinline__ void unit_start(const Unit&, int, int) const {}
    __device__ __forceinline__ void mid(f32x4 (&)[2][2][4][2], int, int, int) const {}
    __device__ __forceinline__ void operator()(const f32x4 (&acc)[2][2][4][2], const Unit& u, int wr, int wc, int fr, int fq, int) const {
        const int row0 = u.pm * BM + wr * 64 + fr, cl = wc * 32 + 8 * fq;
        if (u.pn < 4) {
#pragma unroll
            for (int ai = 0; ai < 2; ++ai)
#pragma unroll
                for (int m = 0; m < 4; ++m) { bf16_t* rowp = Q + (size_t)(row0 + ai * HALF + m * 16) * 1024 + u.pn * 256 + cl;
#pragma unroll
                    for (int bj = 0; bj < 2; ++bj) { const f32x4 v0 = acc[ai][bj][m][0] * QSCALE, v1 = acc[ai][bj][m][1] * QSCALE;
                        u32x4 w; w.x = cvt_pk_bf16(v0[0], v0[1]); w.y = cvt_pk_bf16(v0[2], v0[3]); w.z = cvt_pk_bf16(v1[0], v1[1]); w.w = cvt_pk_bf16(v1[2], v1[3]);
                        *(u32x4*)(rowp + bj * HALF) = w; } }
        } else if (u.pn == 4) {
#pragma unroll
            for (int ai = 0; ai < 2; ++ai)
#pragma unroll
                for (int m = 0; m < 4; ++m) { const int row = row0 + ai * HALF + m * 16;
#pragma unroll
                    for (int bj = 0; bj < 2; ++bj) { const f32x4 v0 = acc[ai][bj][m][0], v1 = acc[ai][bj][m][1];
                        u32x4 w; w.x = cvt_pk_bf16(v0[0], v0[1]); w.y = cvt_pk_bf16(v0[2], v0[3]); w.z = cvt_pk_bf16(v1[0], v1[1]); w.w = cvt_pk_bf16(v1[2], v1[3]);
                        bf16_t* base = bj == 0 ? Kb : Vb;
                        *(u32x4*)(base + (size_t)row * 128 + cl) = w;
                        float* o = nullptr;
                        if (row < 8192) { const int t = row & 2047; if (t >= 1920) o = out + (bj == 0 ? OKP : OVP) + ((row >> 11) * 128 + (t - 1920)) * 128 + cl; }
                        else o = out + (bj == 0 ? OKS : OVS) + (row - 8192) * 128 + cl;
                        if (o) { *(f32x4*)o = v0; *(f32x4*)(o + 4) = v1; } } }
        } else {
            bf16_t* base = u.pn < 9 ? GU : GV; const int coff = (u.pn < 9 ? u.pn - 5 : u.pn - 9) * 256 + cl;
#pragma unroll
            for (int ai = 0; ai < 2; ++ai)
#pragma unroll
                for (int m = 0; m < 4; ++m) { bf16_t* rowp = base + (size_t)(row0 + ai * HALF + m * 16) * 1024 + coff;
#pragma unroll
                    for (int bj = 0; bj < 2; ++bj) { const f32x4 v0 = acc[ai][bj][m][0], v1 = acc[ai][bj][m][1];
                        u32x4 w; w.x = cvt_pk_bf16(gelu_tanh(v0[0]), gelu_tanh(v0[1])); w.y = cvt_pk_bf16(gelu_tanh(v0[2]), gelu_tanh(v0[3]));
                        w.z = cvt_pk_bf16(gelu_tanh(v1[0]), gelu_tanh(v1[1])); w.w = cvt_pk_bf16(gelu_tanh(v1[2]), gelu_tanh(v1[3]));
                        *(u32x4*)(rowp + bj * HALF) = w; } }
        }
    }
};

struct EpiRelu2 {
    static constexpr bool PERM = true, AFTER_DRAIN = false, MID = false;
    bf16_t* O; int ldc;
    __device__ __forceinline__ void unit_start(const Unit&, int, int) const {}
    __device__ __forceinline__ void mid(f32x4 (&)[2][2][4][2], int, int, int) const {}
    __device__ __forceinline__ void operator()(const f32x4 (&acc)[2][2][4][2], const Unit& u, int wr, int wc, int fr, int fq, int) const {
        const int row0 = u.pm * BM + wr * 64 + fr, col0 = u.pn * BM + wc * 32 + 8 * fq;
#pragma unroll
        for (int ai = 0; ai < 2; ++ai)
#pragma unroll
            for (int m = 0; m < 4; ++m) { bf16_t* rowp = O + (size_t)(row0 + ai * HALF + m * 16) * ldc + col0;
#pragma unroll
                for (int bj = 0; bj < 2; ++bj) { f32x4 v0 = acc[ai][bj][m][0], v1 = acc[ai][bj][m][1];
#pragma unroll
                    for (int e = 0; e < 4; ++e) { const float a = fmaxf(v0[e], 0.f), b = fmaxf(v1[e], 0.f); v0[e] = a * a; v1[e] = b * b; }
                    u32x4 w; w.x = cvt_pk_bf16(v0[0], v0[1]); w.y = cvt_pk_bf16(v0[2], v0[3]); w.z = cvt_pk_bf16(v1[0], v1[1]); w.w = cvt_pk_bf16(v1[2], v1[3]);
                    *(u32x4*)(rowp + bj * HALF) = w; } }
    }
};

template <bool SCALE> struct EpiF32Ssq {
    static constexpr bool PERM = false, AFTER_DRAIN = false, MID = SCALE;
    float* O; float* ssq; const float* ssqm; PG8_LAS float* xr;
    float* slab;
    __device__ __forceinline__ void unit_start(const Unit& u, int ui, int tid) const {
        if (SCALE) { if (tid < 256) { const float* p = ssqm + (size_t)(u.pm * BM + tid) * 24; float sa = 0.f, sg = 0.f;
#pragma unroll
                for (int i = 0; i < 4; ++i) { const f32x4 v = *(const f32x4*)(p + 4 * i); sa += (v[0] + v[1]) + (v[2] + v[3]); }
#pragma unroll
                for (int i = 4; i < 6; ++i) { const f32x4 v = *(const f32x4*)(p + 4 * i); sg += (v[0] + v[1]) + (v[2] + v[3]); }
                const float ra = 1.0f / sqrtf(sa * (1.0f / 1024.0f) + 1e-6f), rg = 1.0f / sqrtf(sg * (1.0f / 1024.0f) + 1e-6f);
                xr[(ui & 1) * 512 + tid] = ra / rg; xr[(ui & 1) * 512 + 256 + tid] = (u.slice >= 0 && u.slice < NSL / 2) ? ra : rg; } }
    }
    __device__ __forceinline__ void mid(f32x4 (&acc)[2][2][4][2], int ui, int wr, int fr) const {
        if (SCALE) {
#pragma unroll
            for (int ai = 0; ai < 2; ++ai)
#pragma unroll
                for (int m = 0; m < 4; ++m) { const float r = xr[(ui & 1) * 512 + ai * HALF + wr * 64 + m * 16 + fr];
#pragma unroll
                    for (int bj = 0; bj < 2; ++bj)
#pragma unroll
                        for (int n = 0; n < 2; ++n) acc[ai][bj][m][n] = acc[ai][bj][m][n] * r; } }
    }
    __device__ __forceinline__ void operator()(const f32x4 (&acc)[2][2][4][2], const Unit& u, int wr, int wc, int fr, int fq, int ui) const {
        const int col0 = u.pn * BM + wc * 32 + 4 * fq;
        const bool part = u.slice >= 0;
        float* base = (part ? slab + ((size_t)u.slice * 512 + (size_t)(u.pm - 32) * BM) * 2048 : O + (size_t)u.pm * BM * 2048) + (size_t)(wr * 64 + fr) * 2048 + col0;
        float* sq = ssq + (size_t)(u.pm * BM + wr * 64 + fr) * 32 + u.pn * 4 + wc;
#pragma unroll
        for (int ai = 0; ai < 2; ++ai)
#pragma unroll
            for (int m = 0; m < 4; ++m) { const int rl = ai * HALF + wr * 64 + m * 16 + fr;
                const float rg = SCALE ? xr[(ui & 1) * 512 + 256 + rl] : 1.0f; float s = 0.f;
#pragma unroll
                for (int bj = 0; bj < 2; ++bj)
#pragma unroll
                    for (int n = 0; n < 2; ++n) { const f32x4 v = acc[ai][bj][m][n] * rg; s += (v[0] * v[0] + v[1] * v[1]) + (v[2] * v[2] + v[3] * v[3]);
                        *(f32x4*)(base + (size_t)(ai * HALF + m * 16) * 2048 + bj * HALF + n * 16) = v; }
                s += __shfl_xor(s, 16); s += __shfl_xor(s, 32);
                if (!part && fq == 0) sq[(ai * HALF + m * 16) * 32] = s; }
    }
};

template <class Epi, class Sched, bool ALIGN_EPI = false, bool SP2 = false>
__device__ __forceinline__ void gemm_phase(PG8_LAS unsigned char* lds, const Gemm g, const Sched& S, const Epi& E) {
    const int tid = threadIdx.x, wid = __builtin_amdgcn_readfirstlane(tid >> 6), lane = tid & 63, wr = wid >> 2, wc = wid & 3, fr = lane & 15, fq = lane >> 4;
    const int K = g.K;
    unsigned voffA[2], voffB[2];
#pragma unroll
    for (int i = 0; i < 2; ++i) { int R, C; stage_rc(tid * 16 + i * 8192, R, C); const int Rb = Epi::PERM ? ((R & ~31) + perm32(R & 31)) : R;
        voffA[i] = (unsigned)(R * K + C) * 2u; voffB[i] = (unsigned)(Rb * K + C) * 2u; }
    const size_t kstep = (size_t)(BK * 2);
    const size_t hstep = (size_t)HALF * K * 2;
    const size_t tstep = 2 * hstep;
    const unsigned ldsw = (unsigned)wid * 1024u;
    const int aoff = lds_byte(wr * 64 + fr, fq * 8), boff = lds_byte(wc * 32 + fr, fq * 8);
#define PG8_SA(b, h) (((b) * 2 + (h)) * HTB)
#define PG8_SB(b, h) ((4 + (b) * 2 + (h)) * HTB)
#define PG8_STAGE(bufoff, gbase, voff) do { _Pragma("unroll") for (int _i = 0; _i < 2; ++_i) \
        __builtin_amdgcn_global_load_lds((const unsigned*)((const char*)(gbase) + (voff)[_i]), (PG8_LAS unsigned*)(lds + (bufoff) + ldsw + _i * 8192), 16, 0, 0); } while (0)
#define PG8_LDA(dst, b, h) do { _Pragma("unroll") for (int m = 0; m < 4; ++m) _Pragma("unroll") for (int k = 0; k < 2; ++k) dst[m][k] = *(const PG8_LAS bf16x8*)(lds + PG8_SA(b, h) + aoff + m * 2048 + k * 1024); } while (0)
#define PG8_LDB(dst, b, h) do { _Pragma("unroll") for (int n = 0; n < 2; ++n) _Pragma("unroll") for (int k = 0; k < 2; ++k) dst[n][k] = *(const PG8_LAS bf16x8*)(lds + PG8_SB(b, h) + boff + n * 2048 + k * 1024); } while (0)
#define PG8_MMA(ai, bj, At, Bt) do { __builtin_amdgcn_s_setprio(1); _Pragma("unroll") for (int m = 0; m < 4; ++m) _Pragma("unroll") for (int n = 0; n < 2; ++n) _Pragma("unroll") for (int k = 0; k < 2; ++k) \
        acc[ai][bj][m][n] = __builtin_amdgcn_mfma_f32_16x16x32_bf16(Bt[n][k], At[m][k], acc[ai][bj][m][n], 0, 0, 0); __builtin_amdgcn_s_setprio(0); } while (0)
#define PG8_WAIT_V(n) asm volatile("s_waitcnt vmcnt(" #n ")" ::: "memory")
#define PG8_WAIT_L(n) asm volatile("s_waitcnt lgkmcnt(" #n ")" ::: "memory")
#define PG8_BAR __builtin_amdgcn_s_barrier()
#define PG8_SCHED __builtin_amdgcn_sched_barrier(0)
    Unit cur, nxt; int ui = 0;
    if (!S.next(0, cur)) return;
    f32x4 acc[2][2][4][2];
#pragma unroll
    for (int a = 0; a < 2; ++a)
#pragma unroll
        for (int b = 0; b < 2; ++b)
#pragma unroll
            for (int m = 0; m < 4; ++m)
#pragma unroll
                for (int n = 0; n < 2; ++n) acc[a][b][m][n] = (f32x4){0.f, 0.f, 0.f, 0.f};
    bf16x8 At[4][2], B0[2][2], B1[2][2];
    const char* cA = (const char*)g.A + (size_t)cur.pm * tstep + (size_t)cur.kt0 * kstep; const char* cB = (const char*)g.Bt + (size_t)cur.pn * tstep + (size_t)cur.kt0 * kstep;
    S.a_ready(cur);
    if constexpr (SP2) {
        PG8_STAGE(PG8_SB(0, 0), cB, voffB); PG8_STAGE(PG8_SB(0, 1), cB + hstep, voffB); PG8_STAGE(PG8_SA(0, 0), cA, voffA); PG8_STAGE(PG8_SA(0, 1), cA + hstep, voffA);
        if (wr == 1) PG8_BAR;
        PG8_WAIT_V(2); PG8_BAR;
        PG8_STAGE(PG8_SB(1, 0), cB + kstep, voffB); PG8_STAGE(PG8_SA(1, 0), cA + kstep, voffA); PG8_STAGE(PG8_SB(1, 1), cB + hstep + kstep, voffB);
        PG8_WAIT_V(6); PG8_BAR;
    } else {
        PG8_STAGE(PG8_SB(0, 0), cB, voffB); PG8_STAGE(PG8_SA(0, 0), cA, voffA); PG8_STAGE(PG8_SB(0, 1), cB + hstep, voffB); PG8_STAGE(PG8_SA(0, 1), cA + hstep, voffA);
        if (wr == 1) PG8_BAR;
        PG8_WAIT_V(4); PG8_BAR;
        PG8_STAGE(PG8_SB(1, 0), cB + kstep, voffB); PG8_STAGE(PG8_SA(1, 0), cA + kstep, voffA); PG8_STAGE(PG8_SB(1, 1), cB + hstep + kstep, voffB);
        PG8_WAIT_V(6); PG8_BAR;
    }
    for (;;) {
        const bool has_next = S.next(ui + 1, nxt);
        const char* nA = has_next ? (const char*)g.A + (size_t)nxt.pm * tstep + (size_t)nxt.kt0 * kstep : cA; const char* nB = has_next ? (const char*)g.Bt + (size_t)nxt.pn * tstep + (size_t)nxt.kt0 * kstep : cB;
        const int nt = cur.nkt;
        if constexpr (Epi::MID) E.unit_start(cur, ui, tid);
        for (int t = 0; t < nt; t += 2) {
            const bool last = (t == nt - 2);
            const char* a1 = cA + (size_t)(t + 1) * kstep;
            const char* a2 = last ? nA : cA + (size_t)(t + 2) * kstep; const char* b2 = last ? nB : cB + (size_t)(t + 2) * kstep;
            const char* a3 = a2 + kstep; const char* b3 = b2 + kstep;
            if (last && has_next) S.a_ready(nxt);
            if constexpr (Epi::MID) { if (cur.slice < 0 && t == (nt >> 1)) E.mid(acc, ui, wr, fr); }
            if constexpr (SP2) {
            PG8_LDB(B0, 0, 0); PG8_LDB(B1, 0, 1); PG8_SCHED; PG8_LDA(At, 0, 0); PG8_STAGE(PG8_SA(1, 1), a1 + hstep, voffA);
            PG8_WAIT_V(8); PG8_WAIT_L(0); PG8_BAR; PG8_MMA(0, 0, At, B0); PG8_MMA(0, 1, At, B1); PG8_BAR; PG8_SCHED;
            PG8_LDA(At, 0, 1); PG8_STAGE(PG8_SB(0, 0), b2, voffB); PG8_STAGE(PG8_SB(0, 1), b2 + hstep, voffB); PG8_STAGE(PG8_SA(0, 0), a2, voffA);
            PG8_WAIT_V(8); PG8_WAIT_L(0); PG8_BAR; PG8_MMA(1, 0, At, B0); PG8_MMA(1, 1, At, B1); PG8_BAR; PG8_SCHED;
            PG8_LDB(B0, 1, 0); PG8_LDB(B1, 1, 1); PG8_SCHED; PG8_LDA(At, 1, 0); PG8_STAGE(PG8_SA(0, 1), a2 + hstep, voffA);
            PG8_WAIT_V(8); PG8_WAIT_L(0); PG8_BAR; PG8_MMA(0, 0, At, B0); PG8_MMA(0, 1, At, B1); PG8_BAR; PG8_SCHED;
            PG8_LDA(At, 1, 1); PG8_STAGE(PG8_SB(1, 0), b3, voffB); PG8_STAGE(PG8_SB(1, 1), b3 + hstep, voffB); PG8_STAGE(PG8_SA(1, 0), a3, voffA);
            PG8_WAIT_V(8); PG8_WAIT_L(0); PG8_BAR; PG8_MMA(1, 0, At, B0); PG8_MMA(1, 1, At, B1); PG8_BAR; PG8_SCHED;
            } else {
            PG8_LDB(B0, 0, 0); PG8_SCHED; PG8_LDA(At, 0, 0); PG8_STAGE(PG8_SA(1, 1), a1 + hstep, voffA);
            PG8_WAIT_L(8); PG8_BAR; PG8_WAIT_L(0); PG8_MMA(0, 0, At, B0); PG8_BAR; PG8_SCHED;
            PG8_LDB(B1, 0, 1); PG8_STAGE(PG8_SB(0, 0), b2, voffB);
            PG8_BAR; PG8_WAIT_L(0); PG8_MMA(0, 1, At, B1); PG8_BAR;
            PG8_LDA(At, 0, 1); PG8_STAGE(PG8_SA(0, 0), a2, voffA);
            PG8_BAR; PG8_WAIT_L(0); PG8_MMA(1, 0, At, B0); PG8_BAR; PG8_SCHED;
            PG8_STAGE(PG8_SB(0, 1), b2 + hstep, voffB);
            PG8_WAIT_V(6); PG8_BAR; PG8_MMA(1, 1, At, B1); PG8_BAR;
            PG8_LDB(B0, 1, 0); PG8_SCHED; PG8_LDA(At, 1, 0); PG8_STAGE(PG8_SA(0, 1), a2 + hstep, voffA);
            PG8_WAIT_L(8); PG8_BAR; PG8_WAIT_L(0); PG8_MMA(0, 0, At, B0); PG8_BAR; PG8_SCHED;
            PG8_LDB(B1, 1, 1); PG8_STAGE(PG8_SB(1, 0), b3, voffB);
            PG8_BAR; PG8_WAIT_L(0); PG8_MMA(0, 1, At, B1); PG8_BAR;
            PG8_LDA(At, 1, 1); PG8_STAGE(PG8_SA(1, 0), a3, voffA);
            PG8_BAR; PG8_WAIT_L(0); PG8_MMA(1, 0, At, B0); PG8_BAR; PG8_SCHED;
            PG8_STAGE(PG8_SB(1, 1), b3 + hstep, voffB);
            PG8_WAIT_V(6); PG8_BAR; PG8_MMA(1, 1, At, B1); PG8_BAR;
            }
        }
        if constexpr (ALIGN_EPI) { if (wr == 0) PG8_BAR; }
        if constexpr (!Epi::AFTER_DRAIN) { E(acc, cur, wr, wc, fr, fq, ui); S.done(cur); }
        if (!has_next) break;
#pragma unroll
        for (int a = 0; a < 2; ++a)
#pragma unroll
            for (int b = 0; b < 2; ++b)
#pragma unroll
                for (int m = 0; m < 4; ++m)
#pragma unroll
                    for (int n = 0; n < 2; ++n) acc[a][b][m][n] = (f32x4){0.f, 0.f, 0.f, 0.f};
        cur = nxt; cA = nA; cB = nB; ++ui;
        if constexpr (ALIGN_EPI) { if (wr == 1) PG8_BAR; }
    }
    PG8_WAIT_V(0);
    if constexpr (!ALIGN_EPI) { if (wr == 0) PG8_BAR; }
    PG8_BAR;
#undef PG8_SA
#undef PG8_SB
#undef PG8_STAGE
#undef PG8_LDA
#undef PG8_LDB
#undef PG8_MMA
#undef PG8_WAIT_V
#undef PG8_WAIT_L
#undef PG8_BAR
#undef PG8_SCHED
}
}

constexpr int NWAVES = 8;
constexpr int DM = 2048, MP = 8192, MS = 512, M = MP + MS, INC = 3328, DFF = 8192, NMOD = 12288;
constexpr float EPS = 1e-6f, LOG2E = 1.4426950408889634f;
constexpr int N_PHASES = 9;
constexpr int N_LAUNCHES = MK_N_LAUNCHES;

constexpr size_t MiB = 1u << 20;
constexpr size_t WS_CTL = 0, CTL_ZERO_BYTES = 1 * MiB;
constexpr size_t WS_WIN = 2 * MiB, WS_WOUT = 16 * MiB, WS_WFF1 = 24 * MiB, WS_WFF2 = 90 * MiB;
constexpr size_t WS_H = 56 * MiB;
constexpr size_t WS_MOD = 122 * MiB;
constexpr size_t WS_SSQM = 129 * MiB, WS_SSQO = 130 * MiB, WS_SSQF = 132 * MiB;
constexpr size_t WS_Q = 134 * MiB, WS_K = 151 * MiB, WS_V = 154 * MiB, WS_GU = 157 * MiB, WS_GV = 174 * MiB;
constexpr size_t WS_MG = 202 * MiB;
constexpr size_t WS_O = 134 * MiB;
constexpr size_t WS_F1 = 134 * MiB;
constexpr size_t WS_F = 270 * MiB;
constexpr size_t WS_SLAB4 = 270 * MiB;
constexpr size_t WS_SLAB7 = 2 * MiB;
constexpr size_t WS_END = 338 * MiB;
constexpr size_t SLAB_BYTES = (size_t)16 * 512 * 2048 * 4;
static_assert(WS_SSQM + (size_t)M * 24 * 4 <= WS_SSQO && WS_SSQO + (size_t)M * 32 * 4 <= WS_SSQF && WS_SSQF + (size_t)M * 32 * 4 <= WS_Q, "partials");
static_assert(WS_MOD + (size_t)132 * NMOD * 4 <= WS_SSQM && WS_H + (size_t)M * DM * 2 <= WS_WFF2 && WS_Q + (size_t)M * 1024 * 2 <= WS_K && WS_K + (size_t)M * 128 * 2 <= WS_V &&
              WS_V + (size_t)M * 128 * 2 <= WS_GU && WS_GU + (size_t)M * 1024 * 2 <= WS_GV && WS_GV + (size_t)M * 1024 * 2 <= WS_MG && WS_O + (size_t)M * DM * 4 <= WS_MG &&
              WS_MG + (size_t)M * DM * 2 <= WS_F && WS_F1 + (size_t)M * DFF * 2 <= WS_F && WS_F + (size_t)M * DM * 4 <= WS_END && WS_SLAB4 + SLAB_BYTES <= WS_END &&
              WS_SLAB7 + SLAB_BYTES <= WS_WFF2, "d_ws map");
static_assert(WS_WIN + (size_t)INC * DM * 2 <= WS_WOUT && WS_WOUT + (size_t)DM * DM * 2 <= WS_WFF1 && WS_WFF1 + (size_t)DFF * DM * 2 <= WS_H && WS_WFF2 + (size_t)DFF * DM * 2 <= WS_MOD, "weights");
constexpr int CW_BAR = 4096, CW_SCNT = 64;
constexpr size_t WS_S = 1 * MiB;

constexpr int RING_BYTES = 131072;
constexpr int X_RATIO = 131072;
constexpr int X_BKT = X_RATIO + 4096;
constexpr int X_TAB = X_BKT + 512;
constexpr int X_PTR = X_TAB + 2048;
constexpr int X_MISC = 139264;
constexpr int LDS_BYTES = 147456;

#define GAS __attribute__((address_space(1)))
#define LAS __attribute__((address_space(3)))
typedef unsigned short bf16;
typedef unsigned v4u __attribute__((ext_vector_type(4)));
typedef unsigned v2u __attribute__((ext_vector_type(2)));
typedef float f32x4 __attribute__((ext_vector_type(4)));
typedef float f32x2 __attribute__((ext_vector_type(2)));
typedef short bf16x8 __attribute__((ext_vector_type(8)));
typedef GAS unsigned gu32;
#define RLX_AGENT __ATOMIC_RELAXED, __HIP_MEMORY_SCOPE_AGENT
#define LDS_WAIT() asm volatile("s_waitcnt lgkmcnt(0)" ::: "memory")
#define VM_WAIT() asm volatile("s_waitcnt vmcnt(0)" ::: "memory")

__device__ __forceinline__ unsigned cvtpk(float lo, float hi) { return pg8::cvt_pk_bf16(lo, hi); }
__device__ __forceinline__ float bf2f(unsigned b) { return __uint_as_float(b << 16); }
__device__ __forceinline__ float bflo(unsigned w) { return __uint_as_float(w << 16); }
__device__ __forceinline__ float bfhi(unsigned w) { return __uint_as_float(w & 0xffff0000u); }
__device__ __forceinline__ bf16x8 pack8(f32x4 a, f32x4 b) { v4u w; w.x = cvtpk(a[0], a[1]); w.y = cvtpk(a[2], a[3]); w.z = cvtpk(b[0], b[1]); w.w = cvtpk(b[2], b[3]); return __builtin_bit_cast(bf16x8, w); }
__device__ __forceinline__ float wave_sum(float v) {
#pragma unroll
    for (int o = 1; o < 64; o <<= 1) v += __shfl_xor(v, o);
    return v;
}
__device__ __forceinline__ float silu_f(float x) { return x * __builtin_amdgcn_rcpf(1.0f + __builtin_amdgcn_exp2f(-LOG2E * x)); }
#define MFMA16(a, b, c) __builtin_amdgcn_mfma_f32_16x16x32_bf16((a), (b), (c), 0, 0, 0)

#define XB_TMO      128
#define XB_XCNT(j)  (256  + 64 * (j))
#define XB_XSUB(j)  (1280 + 64 * (j))
#define XB_XGEN(j)  (2304 + 64 * (j))
#define XB_TOP      3328
#define XB_TOPGEN   3392
#define XCD_BAR_WORDS 3456
#define XB_SPIN_CAP (1u << 18)
__device__ __forceinline__ unsigned xb_ld(unsigned* p)              { return __hip_atomic_load(p, __ATOMIC_RELAXED, __HIP_MEMORY_SCOPE_AGENT); }
__device__ __forceinline__ unsigned xb_add(unsigned* p, unsigned v) { return __hip_atomic_fetch_add(p, v, __ATOMIC_RELAXED, __HIP_MEMORY_SCOPE_AGENT); }
__device__ __forceinline__ unsigned xb_xcc_id() { return (unsigned)__builtin_amdgcn_s_getreg((3 << 11) | 20) & 0xFu; }
#define XB_SPIN(cond, bar) do { unsigned _sp = 0; while (cond) { __builtin_amdgcn_s_sleep(1); \
    if ((++_sp & 255u) == 0u) { if (xb_ld(&(bar)[XB_TMO])) break; if (_sp > XB_SPIN_CAP) { atomicAdd(&(bar)[XB_TMO], 1u); break; } } } } while (0)
struct XcdBarrier { unsigned* bar; unsigned x; volatile LAS unsigned* st; };
__device__ __forceinline__ XcdBarrier xcd_barrier_post(unsigned* bar, volatile LAS unsigned* st) {
    XcdBarrier b; b.bar = bar; b.x = xb_xcc_id(); b.st = st;
    if (threadIdx.x == 0) (void)xb_add(&bar[XB_XCNT(b.x)], 1u);
    return b;
}
__device__ __forceinline__ void xcd_barrier_complete(unsigned* bar, unsigned x, unsigned& nloc, unsigned& nx) {
    const unsigned G = gridDim.x * gridDim.y * gridDim.z;
    unsigned sum, cnt, mine, sp = 0u;
    for (;;) {
        sum = 0u; cnt = 0u; mine = 0u;
#pragma unroll
        for (unsigned j = 0; j < 16; ++j) { const unsigned c = xb_ld(&bar[XB_XCNT(j)]); sum += c; cnt += (c > 0u) ? 1u : 0u; mine = (j == x) ? c : mine; }
        if (sum == G) break;
        __builtin_amdgcn_s_sleep(1);
        if ((++sp & 255u) == 0u) { if (xb_ld(&bar[XB_TMO])) break; if (sp > XB_SPIN_CAP) { atomicAdd(&bar[XB_TMO], 1u); break; } }
    }
    nloc = mine > 0u ? mine : 1u; nx = cnt > 0u ? cnt : 1u;
}
__device__ __forceinline__ void xcd_barrier(const XcdBarrier& b) {
    asm volatile("s_waitcnt vmcnt(0)" ::: "memory");
    __syncthreads();
    if (threadIdx.x == 0) {
        unsigned* bar = b.bar;
        __builtin_amdgcn_s_waitcnt(0);
        unsigned nloc = b.st[0], nx = b.st[1];
        if (nloc == 0u) { xcd_barrier_complete(bar, b.x, nloc, nx); b.st[0] = nloc; b.st[1] = nx; }
        const unsigned old = xb_add(&bar[XB_XSUB(b.x)], 1u);
        const unsigned gen = old / nloc;
        if (old + 1u == (gen + 1u) * nloc) {
            __builtin_amdgcn_fence(__ATOMIC_RELEASE, "agent");
            asm volatile("s_waitcnt vmcnt(0)" ::: "memory");
            const unsigned og = xb_add(&bar[XB_TOP], 1u);
            const unsigned tg = og / nx;
            if (og + 1u == (tg + 1u) * nx) xb_add(&bar[XB_TOPGEN], 1u);
            else XB_SPIN(xb_ld(&bar[XB_TOPGEN]) == tg, bar);
            __builtin_amdgcn_fence(__ATOMIC_ACQUIRE, "agent");
            xb_add(&bar[XB_XGEN(b.x)], 1u);
            asm volatile("s_waitcnt vmcnt(0)" ::: "memory");
        } else {
            XB_SPIN(xb_ld(&bar[XB_XGEN(b.x)]) == gen, bar);
            __builtin_amdgcn_fence(__ATOMIC_ACQUIRE, "agent");
            asm volatile("s_waitcnt vmcnt(0)" ::: "memory");
        }
    }
    __syncthreads();
}

__device__ __forceinline__ void p0_transpose_item(const float* W, int K, int N, bf16* WT, const float* kscale, LAS float* scr, int item, int lane) {
    const int nblk = N / 32, kb = item / nblk, nb = item % nblk, k0 = 64 * kb, n0 = 32 * nb;
    float tv[32];
    const float* wp = W + (size_t)(k0 + (lane >> 5)) * N + n0 + (lane & 31);
#pragma unroll
    for (int i = 0; i < 32; ++i) tv[i] = wp[(size_t)(2 * i) * N];
    if (kscale) {
#pragma unroll
        for (int i = 0; i < 32; ++i) tv[i] *= kscale[k0 + 2 * i + (lane >> 5)]; }
#pragma unroll
    for (int i = 0; i < 32; ++i) scr[(2 * i + (lane >> 5)) * 33 + (lane & 31)] = tv[i];
    LDS_WAIT(); asm volatile("" ::: "memory");
    const int c = lane & 7;
#pragma unroll
    for (int j = 0; j < 4; ++j) { const int n = (lane >> 3) + 8 * j; const LAS float* s = scr + (8 * c) * 33 + n;
        v4u o; o.x = cvtpk(s[0 * 33], s[1 * 33]); o.y = cvtpk(s[2 * 33], s[3 * 33]); o.z = cvtpk(s[4 * 33], s[5 * 33]); o.w = cvtpk(s[6 * 33], s[7 * 33]);
        *(GAS v4u*)(WT + (size_t)(n0 + n) * K + k0 + 8 * c) = o; }
    LDS_WAIT(); asm volatile("" ::: "memory");
}

__device__ __forceinline__ void silu_publish(int G, int bx, int tid, const float* c_prompt, const float* c_sample, bf16* S, unsigned* cnt) {
    for (int grp = bx * 512 + tid; grp < 144 * 256; grp += G * 512) { const int row = grp >> 8, k8 = (grp & 255) * 8;
        v4u w = (v4u){0u, 0u, 0u, 0u};
        if (row < 132) { const float* cp = (row < 4 ? c_prompt + (size_t)row * DM : c_sample + (size_t)(row - 4) * DM) + k8;
            const f32x4 a = *(const f32x4*)cp, b = *(const f32x4*)(cp + 4);
            w.x = cvtpk(silu_f(a[0]), silu_f(a[1])); w.y = cvtpk(silu_f(a[2]), silu_f(a[3])); w.z = cvtpk(silu_f(b[0]), silu_f(b[1])); w.w = cvtpk(silu_f(b[2]), silu_f(b[3])); }
        *(v4u*)(S + (size_t)row * DM + k8) = w; }
    asm volatile("s_waitcnt vmcnt(0)" ::: "memory");
    __syncthreads();
    if (tid == 0) { __builtin_amdgcn_fence(__ATOMIC_RELEASE, "agent"); asm volatile("s_waitcnt vmcnt(0)" ::: "memory"); __hip_atomic_fetch_add(cnt, 1u, __ATOMIC_RELAXED, __HIP_MEMORY_SCOPE_AGENT); }
}
__device__ __forceinline__ void silu_wait(int G, int tid, unsigned* cnt) {
    if (tid == 0) { unsigned sp = 0;
        while (__hip_atomic_load(cnt, __ATOMIC_RELAXED, __HIP_MEMORY_SCOPE_AGENT) < (unsigned)G) { __builtin_amdgcn_s_sleep(2); if (++sp > (1u << 22)) break; }
        __builtin_amdgcn_fence(__ATOMIC_ACQUIRE, "agent"); asm volatile("s_waitcnt vmcnt(0)" ::: "memory"); }
    __syncthreads();
}
__device__ __forceinline__ void adaln_phase(LAS unsigned char* lds, int vcu, int G, int tid, int wid, int lane, const bf16* S, const float* w_ada, const float* b_ada, float* mod) {
    const int fr = lane & 15, g = lane >> 4;
    LAS float* scr = (LAS float*)(lds + wid * 16384);
    const unsigned wvoff = (unsigned)(((lane >> 2) * NMOD + 4 * (lane & 3)) * 4);
    const unsigned soff = (unsigned)((fr * DM + 8 * g) * 2);
    const int scr_w = (lane >> 2) * 52 + 4 * (lane & 3);
    for (int strip = vcu; strip < NMOD / 48; strip += G) {
        const int n0 = strip * 48;
        f32x4 acc[9][3];
#pragma unroll
        for (int rf = 0; rf < 9; ++rf)
#pragma unroll
            for (int nf = 0; nf < 3; ++nf) acc[rf][nf] = (f32x4){0.f, 0.f, 0.f, 0.f};
        f32x4 wv[6];
        { const char* wb = (const char*)(w_ada + (size_t)(wid * 256) * NMOD + n0);
#pragma unroll
          for (int i = 0; i < 6; ++i) wv[i] = *(const f32x4*)(wb + (size_t)(16 * (i / 3)) * NMOD * 4 + 64 * (i % 3) + wvoff); }
#pragma unroll 1
        for (int kb = 0; kb < 8; ++kb) {
            const int k0 = wid * 256 + kb * 32;
            bf16x8 af[9];
            { const char* sb = (const char*)(S + k0) + soff;
#pragma unroll
              for (int rf = 0; rf < 9; ++rf) af[rf] = *(const bf16x8*)(sb + (size_t)(16 * rf) * DM * 2); }
#pragma unroll
            for (int i = 0; i < 6; ++i) *(LAS f32x4*)(scr + scr_w + 16 * (i / 3) * 52 + 16 * (i % 3)) = wv[i];
            asm volatile("" ::: "memory");
            if (kb < 7) { const char* wb = (const char*)(w_ada + (size_t)(k0 + 32) * NMOD + n0);
#pragma unroll
                for (int i = 0; i < 6; ++i) wv[i] = *(const f32x4*)(wb + (size_t)(16 * (i / 3)) * NMOD * 4 + 64 * (i % 3) + wvoff); }
            LDS_WAIT(); asm volatile("" ::: "memory");
            bf16x8 bfr[3];
#pragma unroll
            for (int nf = 0; nf < 3; ++nf) { const LAS float* s = scr + (8 * g) * 52 + 16 * nf + fr;
                bfr[nf] = pack8((f32x4){s[0], s[52], s[104], s[156]}, (f32x4){s[208], s[260], s[312], s[364]}); }
#pragma unroll
            for (int rf = 0; rf < 9; ++rf)
#pragma unroll
                for (int nf = 0; nf < 3; ++nf) acc[rf][nf] = MFMA16(af[rf], bfr[nf], acc[rf][nf]);
            LDS_WAIT(); asm volatile("" ::: "memory");
        }
#pragma unroll
        for (int p = 0; p < 3; ++p) {
            __syncthreads();
            LAS float* red = (LAS float*)lds + wid * 2304;
#pragma unroll
            for (int rf = 0; rf < 9; ++rf)
#pragma unroll
                for (int i = 0; i < 4; ++i) red[(16 * rf + 4 * g + i) * 16 + fr] = acc[rf][p][i];
            __syncthreads();
            for (int e = tid; e < 2304; e += 512) { const int r = e >> 4, c = e & 15; float sum = 0.f;
#pragma unroll
                for (int w = 0; w < 8; ++w) sum += ((LAS float*)lds)[w * 2304 + e];
                if (r < 132) mod[(size_t)r * NMOD + n0 + 16 * p + c] = sum + b_ada[n0 + 16 * p + c]; }
        }
        __syncthreads();
    }
}

__device__ __forceinline__ const float* x_row(const float* xp, const float* xs, int m) { return m < MP ? xp + (size_t)m * DM : xs + (size_t)(m - MP) * DM; }
__device__ __forceinline__ int mod_row(int m) { return m < MP ? (m >> 11) : 4 + ((m - MP) >> 2); }

__device__ __forceinline__ float ssq8(const f32x4 (&v)[8]) { float s = 0.f;
#pragma unroll
    for (int j = 0; j < 8; ++j) s += (v[j][0] * v[j][0] + v[j][1] * v[j][1]) + (v[j][2] * v[j][2] + v[j][3] * v[j][3]);
    return s; }
__device__ __forceinline__ float ssq2(const f32x4 (&v)[2]) { return ((v[0][0] * v[0][0] + v[0][1] * v[0][1]) + (v[0][2] * v[0][2] + v[0][3] * v[0][3])) + ((v[1][0] * v[1][0] + v[1][1] * v[1][1]) + (v[1][2] * v[1][2] + v[1][3] * v[1][3])); }
__device__ __forceinline__ float quad_sum(LAS float* red, float v, int wid, int lane) {
    v = wave_sum(v); if (lane == 0) red[wid] = v; __syncthreads();
    const int b = wid & 4; const float t = (red[b] + red[b + 1]) + (red[b + 2] + red[b + 3]); __syncthreads(); return t;
}
__device__ __forceinline__ void p1_rows(LAS unsigned char* lds, int vcu, int G, int gw, int NGW, int wid, int lane, const float* xp, const float* xs, const float* mod, const float* gpre, bf16* H) {
    f32x4 v[8], nx[8];
    if (gw < MP) { const f32x4* xr = (const f32x4*)(xp + (size_t)gw * DM) + lane;
#pragma unroll
        for (int j = 0; j < 8; ++j) nx[j] = xr[64 * j]; }
    for (int m = gw; m < MP; m += NGW) {
#pragma unroll
        for (int j = 0; j < 8; ++j) v[j] = nx[j];
        if (m + NGW < MP) { const f32x4* xr = (const f32x4*)(xp + (size_t)(m + NGW) * DM) + lane;
#pragma unroll
            for (int j = 0; j < 8; ++j) nx[j] = xr[64 * j]; }
        const float* mr = mod + (size_t)(m >> 11) * NMOD;
        const float rstd = 1.0f / sqrtf(wave_sum(ssq8(v)) * (1.0f / DM) + EPS);
        v2u* o8 = (v2u*)(H + (size_t)m * DM) + lane;
#pragma unroll
        for (int j = 0; j < 8; ++j) { const int k = 4 * (lane + 64 * j);
            const f32x4 gg = *(const f32x4*)(gpre + k), sh = *(const f32x4*)(mr + k), sc = *(const f32x4*)(mr + DM + k);
            const f32x4 h = v[j] * rstd * gg * (sc + 1.0f) + sh;
            o8[64 * j] = (v2u){cvtpk(h[0], h[1]), cvtpk(h[2], h[3])}; }
    }
    LAS float* red = (LAS float*)lds;
    for (int pr = vcu; pr < MS / 2; pr += G) {
        const int r = 2 * pr + (wid >> 2), m = MP + r, c0 = (wid & 3) * 512 + 4 * lane;
        const float* mr = mod + (size_t)(4 + (r >> 2)) * NMOD;
        f32x4 x[2];
#pragma unroll
        for (int j = 0; j < 2; ++j) x[j] = *(const f32x4*)(xs + (size_t)r * DM + c0 + 256 * j);
        const float rstd = 1.0f / sqrtf(quad_sum(red, ssq2(x), wid, lane) * (1.0f / DM) + EPS);
#pragma unroll
        for (int j = 0; j < 2; ++j) { const int k = c0 + 256 * j;
            const f32x4 gg = *(const f32x4*)(gpre + k), sh = *(const f32x4*)(mr + k), sc = *(const f32x4*)(mr + DM + k);
            const f32x4 h = x[j] * rstd * gg * (sc + 1.0f) + sh;
            *(v2u*)(H + (size_t)m * DM + k) = (v2u){cvtpk(h[0], h[1]), cvtpk(h[2], h[3])}; }
    }
}
__device__ __forceinline__ void p5_rows(LAS unsigned char* lds, int vcu, int G, int gw, int NGW, int wid, int lane, const float* xp, const float* xs, const float* mod, const float* O,
                                        const float* ssqo, const float* slab, const float* gpost, const float* gpreff, float* out, bf16* H) {
    f32x4 v[8], o[8], nx[8], no[8]; float nq = 0.f;
    if (gw < MP) { const f32x4* xr = (const f32x4*)(xp + (size_t)gw * DM) + lane; const f32x4* orow = (const f32x4*)(O + (size_t)gw * DM) + lane;
#pragma unroll
        for (int j = 0; j < 8; ++j) { nx[j] = xr[64 * j]; no[j] = orow[64 * j]; }
        nq = lane < 32 ? ssqo[(size_t)gw * 32 + lane] : 0.f; }
    for (int m = gw; m < MP; m += NGW) {
#pragma unroll
        for (int j = 0; j < 8; ++j) { v[j] = nx[j]; o[j] = no[j]; }
        const float q = nq;
        if (m + NGW < MP) { const int mn = m + NGW; const f32x4* xr = (const f32x4*)(xp + (size_t)mn * DM) + lane; const f32x4* orow = (const f32x4*)(O + (size_t)mn * DM) + lane;
#pragma unroll
            for (int j = 0; j < 8; ++j) { nx[j] = xr[64 * j]; no[j] = orow[64 * j]; }
            nq = lane < 32 ? ssqo[(size_t)mn * 32 + lane] : 0.f; }
        const float* mr = mod + (size_t)(m >> 11) * NMOD;
        const float rstdo = 1.0f / sqrtf(wave_sum(q) * (1.0f / DM) + EPS);
#pragma unroll
        for (int j = 0; j < 8; ++j) { const int k = 4 * (lane + 64 * j);
            const f32x4 gt = *(const f32x4*)(mr + 2 * DM + k), gp = *(const f32x4*)(gpost + k);
            v[j] = v[j] + gt * (o[j] * rstdo * gp); }
        const float rstd = 1.0f / sqrtf(wave_sum(ssq8(v)) * (1.0f / DM) + EPS);
        f32x4* xo = (f32x4*)(out + (size_t)m * DM) + lane;
        v2u* o8 = (v2u*)(H + (size_t)m * DM) + lane;
#pragma unroll
        for (int j = 0; j < 8; ++j) { const int k = 4 * (lane + 64 * j);
            xo[64 * j] = v[j];
            const f32x4 gg = *(const f32x4*)(gpreff + k), sh = *(const f32x4*)(mr + 3 * DM + k), sc = *(const f32x4*)(mr + 4 * DM + k);
            const f32x4 h = v[j] * rstd * gg * (sc + 1.0f) + sh;
            o8[64 * j] = (v2u){cvtpk(h[0], h[1]), cvtpk(h[2], h[3])}; }
    }
    LAS float* red = (LAS float*)lds;
    for (int pr = vcu; pr < MS / 2; pr += G) {
        const int r = 2 * pr + (wid >> 2), m = MP + r, c0 = (wid & 3) * 512 + 4 * lane;
        const float* mr = mod + (size_t)(4 + (r >> 2)) * NMOD;
        f32x4 x[2], a[2];
#pragma unroll
        for (int j = 0; j < 2; ++j) { x[j] = *(const f32x4*)(xs + (size_t)r * DM + c0 + 256 * j); a[j] = (f32x4){0.f, 0.f, 0.f, 0.f}; }
#pragma unroll
        for (int sl = 0; sl < pg8::NSL; ++sl)
#pragma unroll
            for (int j = 0; j < 2; ++j) a[j] = a[j] + *(const f32x4*)(slab + ((size_t)sl * 512 + r) * DM + c0 + 256 * j);
        const float rstdo = 1.0f / sqrtf(quad_sum(red, ssq2(a), wid, lane) * (1.0f / DM) + EPS);
#pragma unroll
        for (int j = 0; j < 2; ++j) { const int k = c0 + 256 * j;
            const f32x4 gt = *(const f32x4*)(mr + 2 * DM + k), gp = *(const f32x4*)(gpost + k);
            x[j] = x[j] + gt * (a[j] * rstdo * gp); }
        const float rstd = 1.0f / sqrtf(quad_sum(red, ssq2(x), wid, lane) * (1.0f / DM) + EPS);
#pragma unroll
        for (int j = 0; j < 2; ++j) { const int k = c0 + 256 * j;
            *(f32x4*)(out + (size_t)m * DM + k) = x[j];
            const f32x4 gg = *(const f32x4*)(gpreff + k), sh = *(const f32x4*)(mr + 3 * DM + k), sc = *(const f32x4*)(mr + 4 * DM + k);
            const f32x4 h = x[j] * rstd * gg * (sc + 1.0f) + sh;
            *(v2u*)(H + (size_t)m * DM + k) = (v2u){cvtpk(h[0], h[1]), cvtpk(h[2], h[3])}; }
    }
}
__device__ __forceinline__ void p8_rows(LAS unsigned char* lds, int vcu, int G, int gw, int NGW, int wid, int lane, const float* mod, const float* F, const float* ssqf, const float* slab,
                                        const float* gpostff, float* out) {
    f32x4 v[8], o[8], nx[8], no[8]; float nq = 0.f;
    if (gw < MP) { const f32x4* xr = (const f32x4*)(out + (size_t)gw * DM) + lane; const f32x4* orow = (const f32x4*)(F + (size_t)gw * DM) + lane;
#pragma unroll
        for (int j = 0; j < 8; ++j) { nx[j] = xr[64 * j]; no[j] = orow[64 * j]; }
        nq = lane < 32 ? ssqf[(size_t)gw * 32 + lane] : 0.f; }
    for (int m = gw; m < MP; m += NGW) {
#pragma unroll
        for (int j = 0; j < 8; ++j) { v[j] = nx[j]; o[j] = no[j]; }
        const float q = nq;
        if (m + NGW < MP) { const int mn = m + NGW; const f32x4* xr = (const f32x4*)(out + (size_t)mn * DM) + lane; const f32x4* orow = (const f32x4*)(F + (size_t)mn * DM) + lane;
#pragma unroll
            for (int j = 0; j < 8; ++j) { nx[j] = xr[64 * j]; no[j] = orow[64 * j]; }
            nq = lane < 32 ? ssqf[(size_t)mn * 32 + lane] : 0.f; }
        const float* mr = mod + (size_t)(m >> 11) * NMOD;
        const float rstdf = 1.0f / sqrtf(wave_sum(q) * (1.0f / DM) + EPS);
        f32x4* xo = (f32x4*)(out + (size_t)m * DM) + lane;
#pragma unroll
        for (int j = 0; j < 8; ++j) { const int k = 4 * (lane + 64 * j);
            const f32x4 gt = *(const f32x4*)(mr + 5 * DM + k), gp = *(const f32x4*)(gpostff + k);
            xo[64 * j] = v[j] + gt * (o[j] * rstdf * gp); }
    }
    LAS float* red = (LAS float*)lds;
    for (int pr = vcu; pr < MS / 2; pr += G) {
        const int r = 2 * pr + (wid >> 2), m = MP + r, c0 = (wid & 3) * 512 + 4 * lane;
        const float* mr = mod + (size_t)(4 + (r >> 2)) * NMOD;
        f32x4 x[2], a[2];
#pragma unroll
        for (int j = 0; j < 2; ++j) { x[j] = *(const f32x4*)(out + (size_t)m * DM + c0 + 256 * j); a[j] = (f32x4){0.f, 0.f, 0.f, 0.f}; }
#pragma unroll
        for (int sl = 0; sl < pg8::NSL; ++sl)
#pragma unroll
            for (int j = 0; j < 2; ++j) a[j] = a[j] + *(const f32x4*)(slab + ((size_t)sl * 512 + r) * DM + c0 + 256 * j);
        const float rstdf = 1.0f / sqrtf(quad_sum(red, ssq2(a), wid, lane) * (1.0f / DM) + EPS);
#pragma unroll
        for (int j = 0; j < 2; ++j) { const int k = c0 + 256 * j;
            const f32x4 gt = *(const f32x4*)(mr + 5 * DM + k), gp = *(const f32x4*)(gpostff + k);
            *(f32x4*)(out + (size_t)m * DM + k) = x[j] + gt * (a[j] * rstdf * gp); }
    }
}

constexpr int AT_K = 0, AT_V = 36864, AT_LUT = 70656;
__device__ __forceinline__ void attn_prompt_unit(LAS unsigned char* lds, int b, int nb, int h, const bf16* Qb, const bf16* Kb, const bf16* Vb, bf16* MG, float* ssqm,
                                                 const float* sinks, int tid, int wid, int lane) {
    const int kvh = h >> 3, tokq = b * 2048 + nb * 128, tokk = tokq - 128;
    const LAS int* bkt = (const LAS int*)(lds + X_BKT); const LAS float* tab = (const LAS float*)(lds + X_TAB);
    __syncthreads();
#pragma unroll
    for (int i = 0; i < 4; ++i) { const int idx = tid + 512 * i, key = idx >> 3, ch = idx & 7;
        v4u v = (v4u){0u, 0u, 0u, 0u}; if (nb > 0 || key >= 128) v = *(const v4u*)(Kb + (size_t)(tokk + key) * 128 + kvh * 64 + ch * 8);
        *(LAS v4u*)(lds + AT_K + key * 144 + ch * 16) = v; }
#pragma unroll
    for (int i = 0; i < 4; ++i) { const int idx = tid + 512 * i, key = idx & 255, ch = idx >> 8;
        v4u v = (v4u){0u, 0u, 0u, 0u}; if (nb > 0 || key >= 128) v = *(const v4u*)(Vb + (size_t)(tokk + key) * 128 + kvh * 64 + ch * 8);
        LAS unsigned short* vt = (LAS unsigned short*)(lds + AT_V) + (ch * 8) * 264 + key;
        vt[0 * 264] = (unsigned short)(v.x & 0xffffu); vt[1 * 264] = (unsigned short)(v.x >> 16); vt[2 * 264] = (unsigned short)(v.y & 0xffffu); vt[3 * 264] = (unsigned short)(v.y >> 16);
        vt[4 * 264] = (unsigned short)(v.z & 0xffffu); vt[5 * 264] = (unsigned short)(v.z >> 16); vt[6 * 264] = (unsigned short)(v.w & 0xffffu); vt[7 * 264] = (unsigned short)(v.w >> 16); }
    if (tid < 128) ((LAS float*)(lds + AT_LUT))[tid] = tab[bkt[tid] * 16 + h];
    __syncthreads();
    const int fr = lane & 15, g = lane >> 4, f0 = wid < 6 ? wid : 6, qi = 16 * wid + fr;
    const bf16* qp = Qb + (size_t)(tokq + qi) * 1024 + h * 64 + 8 * g;
    const bf16x8 q0 = *(const bf16x8*)qp, q1 = *(const bf16x8*)(qp + 32);
    f32x4 s[10];
#pragma unroll
    for (int f = 0; f < 10; ++f) { const LAS unsigned char* kp = lds + AT_K + (16 * (f0 + f) + fr) * 144 + 16 * g;
        const bf16x8 k0 = *(const LAS bf16x8*)kp, k1 = *(const LAS bf16x8*)(kp + 64);
        s[f] = MFMA16(k0, q0, ((f32x4){0.f, 0.f, 0.f, 0.f})); s[f] = MFMA16(k1, q1, s[f]); }
    const LAS float* lut = (const LAS float*)(lds + AT_LUT);
    const float sk = sinks[h] * LOG2E;
    float mx = -INFINITY;
#pragma unroll
    for (int f = 0; f < 10; ++f)
#pragma unroll
        for (int i = 0; i < 4; ++i) { const int kj = 16 * (f0 + f) + 4 * g + i, dist = 128 + qi - kj; const bool valid = (dist >= 0) && (dist < 128) && (nb > 0 || kj >= 128);
            const float v = valid ? s[f][i] + lut[dist & 127] : -INFINITY; s[f][i] = v; mx = fmaxf(mx, v); }
    mx = fmaxf(mx, __shfl_xor(mx, 16)); mx = fmaxf(mx, __shfl_xor(mx, 32)); mx = fmaxf(mx, sk);
    float l = 0.f;
#pragma unroll
    for (int f = 0; f < 10; ++f)
#pragma unroll
        for (int i = 0; i < 4; ++i) { const float p = __builtin_amdgcn_exp2f(s[f][i] - mx); s[f][i] = p; l += p; }
    l += __shfl_xor(l, 16); l += __shfl_xor(l, 32); l += __builtin_amdgcn_exp2f(sk - mx);
    const float rl = 1.0f / l;
    f32x4 o[4];
#pragma unroll
    for (int df = 0; df < 4; ++df) o[df] = (f32x4){0.f, 0.f, 0.f, 0.f};
#pragma unroll
    for (int si = 0; si < 5; ++si) { const bf16x8 pb = pack8(s[2 * si], s[2 * si + 1]); const int key0 = 16 * (f0 + 2 * si);
#pragma unroll
        for (int df = 0; df < 4; ++df) { const LAS unsigned char* vp = lds + AT_V + ((16 * df + fr) * 264 + key0 + 4 * g) * 2;
            const v2u lo = *(const LAS v2u*)vp, hi = *(const LAS v2u*)(vp + 32);
            const bf16x8 va = __builtin_bit_cast(bf16x8, ((v4u){lo.x, lo.y, hi.x, hi.y}));
            o[df] = MFMA16(va, pb, o[df]); } }
    float ss = 0.f; bf16* op = MG + (size_t)(tokq + qi) * DM + h * 64 + 4 * g;
#pragma unroll
    for (int df = 0; df < 4; ++df) { const f32x4 v = o[df] * rl; ss += (v[0] * v[0] + v[1] * v[1]) + (v[2] * v[2] + v[3] * v[3]);
        *(v2u*)(op + 16 * df) = (v2u){cvtpk(v[0], v[1]), cvtpk(v[2], v[3])}; }
    ss += __shfl_xor(ss, 16); ss += __shfl_xor(ss, 32);
    if (g == 0) ssqm[(size_t)(tokq + qi) * 24 + h] = ss;
}

constexpr int SA_K = 0, SA_V = 41472, SA_END = 84480;
__device__ __forceinline__ void attn_sample_unit(LAS unsigned char* lds, int db, const bf16* Qb, const bf16* Kb, const bf16* Vb, const float* cache_k, const float* cache_v,
                                                 bf16* MG, float* ssqm, const float* sinks, int tid, int wid, int lane) {
    const LAS int* bkt = (const LAS int*)(lds + X_BKT); const LAS float* tab = (const LAS float*)(lds + X_TAB);
    const int tok0 = MP + db * 4;
    __syncthreads();
    for (int i = tid; i < SA_END / 16; i += 512) *(LAS v4u*)(lds + i * 16) = (v4u){0u, 0u, 0u, 0u};
    __syncthreads();
#pragma unroll
    for (int i = 0; i < 8; ++i) { const int idx = tid + 512 * i, j = idx >> 5, kvh = (idx >> 4) & 1, c4 = idx & 15;
        const f32x4 kv = *(const f32x4*)(cache_k + (size_t)db * 16384 + (size_t)idx * 4), vv = *(const f32x4*)(cache_v + (size_t)db * 16384 + (size_t)idx * 4);
        *(LAS v2u*)(lds + SA_K + (kvh * 144 + j) * 144 + 8 * c4) = (v2u){cvtpk(kv[0], kv[1]), cvtpk(kv[2], kv[3])};
        const unsigned w0 = cvtpk(vv[0], vv[1]), w1 = cvtpk(vv[2], vv[3]);
        LAS unsigned short* vt = (LAS unsigned short*)(lds + SA_V) + (kvh * 64 + 4 * c4) * 168 + j;
        vt[0] = (unsigned short)(w0 & 0xffffu); vt[168] = (unsigned short)(w0 >> 16); vt[336] = (unsigned short)(w1 & 0xffffu); vt[504] = (unsigned short)(w1 >> 16); }
    if (tid < 64) { const int t = tid >> 4, kvh = (tid >> 3) & 1, ch = tid & 7;
        const v4u kv = *(const v4u*)(Kb + (size_t)(tok0 + t) * 128 + kvh * 64 + 8 * ch), vv = *(const v4u*)(Vb + (size_t)(tok0 + t) * 128 + kvh * 64 + 8 * ch);
        *(LAS v4u*)(lds + SA_K + (kvh * 144 + 128 + t) * 144 + 16 * ch) = kv;
        LAS unsigned short* vt = (LAS unsigned short*)(lds + SA_V) + (kvh * 64 + 8 * ch) * 168 + 128 + t;
        vt[0 * 168] = (unsigned short)(vv.x & 0xffffu); vt[1 * 168] = (unsigned short)(vv.x >> 16); vt[2 * 168] = (unsigned short)(vv.y & 0xffffu); vt[3 * 168] = (unsigned short)(vv.y >> 16);
        vt[4 * 168] = (unsigned short)(vv.z & 0xffffu); vt[5 * 168] = (unsigned short)(vv.z >> 16); vt[6 * 168] = (unsigned short)(vv.w & 0xffffu); vt[7 * 168] = (unsigned short)(vv.w >> 16); }
    __syncthreads();
    if (wid < 4) {
        const int fr = lane & 15, g = lane >> 4, kvh = wid >> 1, hh = 4 * wid + (fr >> 2), t = fr & 3;
        const bf16* qp = Qb + (size_t)(tok0 + t) * 1024 + hh * 64 + 8 * g;
        const bf16x8 q0 = *(const bf16x8*)qp, q1 = *(const bf16x8*)(qp + 32);
        f32x4 s[10];
#pragma unroll
        for (int f = 0; f < 9; ++f) { const LAS unsigned char* kp = lds + SA_K + (kvh * 144 + 16 * f + fr) * 144 + 16 * g;
            const bf16x8 k0 = *(const LAS bf16x8*)kp, k1 = *(const LAS bf16x8*)(kp + 64);
            s[f] = MFMA16(k0, q0, ((f32x4){0.f, 0.f, 0.f, 0.f})); s[f] = MFMA16(k1, q1, s[f]); }
        s[9] = (f32x4){0.f, 0.f, 0.f, 0.f};
        const float sk = sinks[hh] * LOG2E;
        float mx = -INFINITY;
#pragma unroll
        for (int f = 0; f < 9; ++f)
#pragma unroll
            for (int i = 0; i < 4; ++i) { const int j = 16 * f + 4 * g + i, dist = 128 + t - j; const bool valid = (dist >= 0) && (dist < 128);
                const float v = valid ? s[f][i] + tab[bkt[dist & 127] * 16 + hh] : -INFINITY; s[f][i] = v; mx = fmaxf(mx, v); }
        mx = fmaxf(mx, __shfl_xor(mx, 16)); mx = fmaxf(mx, __shfl_xor(mx, 32)); mx = fmaxf(mx, sk);
        float l = 0.f;
#pragma unroll
        for (int f = 0; f < 9; ++f)
#pragma unroll
            for (int i = 0; i < 4; ++i) { const float p = __builtin_amdgcn_exp2f(s[f][i] - mx); s[f][i] = p; l += p; }
        l += __shfl_xor(l, 16); l += __shfl_xor(l, 32); l += __builtin_amdgcn_exp2f(sk - mx);
        const float rl = 1.0f / l;
        f32x4 o[4];
#pragma unroll
        for (int df = 0; df < 4; ++df) o[df] = (f32x4){0.f, 0.f, 0.f, 0.f};
#pragma unroll
        for (int si = 0; si < 5; ++si) { const bf16x8 pb = pack8(s[2 * si], s[2 * si + 1]);
#pragma unroll
            for (int df = 0; df < 4; ++df) { const LAS unsigned char* vp = lds + SA_V + ((kvh * 64 + 16 * df + fr) * 168 + 32 * si + 4 * g) * 2;
                const v2u lo = *(const LAS v2u*)vp, hi = *(const LAS v2u*)(vp + 32);
                const bf16x8 va = __builtin_bit_cast(bf16x8, ((v4u){lo.x, lo.y, hi.x, hi.y}));
                o[df] = MFMA16(va, pb, o[df]); } }
        float ss = 0.f; bf16* op = MG + (size_t)(tok0 + t) * DM + hh * 64 + 4 * g;
#pragma unroll
        for (int df = 0; df < 4; ++df) { const f32x4 v = o[df] * rl; ss += (v[0] * v[0] + v[1] * v[1]) + (v[2] * v[2] + v[3] * v[3]);
            *(v2u*)(op + 16 * df) = (v2u){cvtpk(v[0], v[1]), cvtpk(v[2], v[3])}; }
        ss += __shfl_xor(ss, 16); ss += __shfl_xor(ss, 32);
        if (g == 0) ssqm[(size_t)(tok0 + t) * 24 + hh] = ss;
    }
}

constexpr int GM_W = 0, GM_V = 34816, GM_RED = 69632;
__device__ __forceinline__ void gmlp_prompt_unit(LAS unsigned char* lds, int b, int n, int h, const bf16* GU, const bf16* GV, const float* w_s, const float* b_s, const float* vgain,
                                                 bf16* MG, float* ssqm, int tid, int wid, int lane) {
    const int tok0 = b * 2048 + n * 128;
    __syncthreads();
#pragma unroll
    for (int ii = 0; ii < 8; ++ii) { const int idx = tid + 512 * ii, i = idx >> 5, j4 = idx & 31; f32x4 w = *(const f32x4*)(w_s + ((size_t)h * 128 + i) * 128 + 4 * j4);
#pragma unroll
        for (int e = 0; e < 4; ++e) if (4 * j4 + e > i) w[e] = 0.f;
        *(LAS v2u*)(lds + GM_W + i * 272 + 8 * j4) = (v2u){cvtpk(w[0], w[1]), cvtpk(w[2], w[3])}; }
    const int j = tid & 127, chq = tid >> 7;
    v4u vr[4]; float sq = 0.f;
#pragma unroll
    for (int ii = 0; ii < 4; ++ii) { const int ch = chq + 4 * ii; vr[ii] = *(const v4u*)(GV + (size_t)(tok0 + j) * 1024 + h * 128 + 8 * ch);
#pragma unroll
        for (int e = 0; e < 4; ++e) { const float a = bflo(vr[ii][e]), c = bfhi(vr[ii][e]); sq += a * a + c * c; } }
    ((LAS float*)(lds + GM_RED))[chq * 128 + j] = sq;
    __syncthreads();
    { const LAS float* red = (const LAS float*)(lds + GM_RED); const float tot = (red[j] + red[128 + j]) + (red[256 + j] + red[384 + j]);
      const float rstd = 1.0f / sqrtf(tot * (1.0f / 128.0f) + EPS);
      LAS unsigned short* vt = (LAS unsigned short*)(lds + GM_V);
#pragma unroll
      for (int ii = 0; ii < 4; ++ii) { const int ch = chq + 4 * ii; const f32x4 g0 = *(const f32x4*)(vgain + h * 128 + 8 * ch), g1 = *(const f32x4*)(vgain + h * 128 + 8 * ch + 4);
#pragma unroll
          for (int e = 0; e < 4; ++e) { const float ga = e < 2 ? g0[2 * e] : g1[2 * e - 4], gb = e < 2 ? g0[2 * e + 1] : g1[2 * e - 3];
              const unsigned w = cvtpk(bflo(vr[ii][e]) * rstd * ga, bfhi(vr[ii][e]) * rstd * gb);
              vt[(8 * ch + 2 * e) * 136 + j] = (unsigned short)(w & 0xffffu); vt[(8 * ch + 2 * e + 1) * 136 + j] = (unsigned short)(w >> 16); } } }
    __syncthreads();
    const int fr = lane & 15, g = lane >> 4, ns = (wid >> 1) + 1;
    f32x4 acc[8];
#pragma unroll
    for (int cf = 0; cf < 8; ++cf) acc[cf] = (f32x4){0.f, 0.f, 0.f, 0.f};
    for (int s = 0; s < ns; ++s) { const bf16x8 bw = *(const LAS bf16x8*)(lds + GM_W + (16 * wid + fr) * 272 + (32 * s + 8 * g) * 2);
#pragma unroll
        for (int cf = 0; cf < 8; ++cf) { const bf16x8 av = *(const LAS bf16x8*)(lds + GM_V + (16 * cf + fr) * 272 + (32 * s + 8 * g) * 2); acc[cf] = MFMA16(av, bw, acc[cf]); } }
    const int i = 16 * wid + fr, tok = tok0 + i; const float bs = b_s[h * 128 + i]; float ss = 0.f;
    const bf16* up = GU + (size_t)tok * 1024 + h * 128 + 4 * g; bf16* op = MG + (size_t)tok * DM + 1024 + h * 128 + 4 * g;
#pragma unroll
    for (int cf = 0; cf < 8; ++cf) { const v2u uu = *(const v2u*)(up + 16 * cf);
        f32x4 v; v[0] = bflo(uu.x) * (acc[cf][0] + bs); v[1] = bfhi(uu.x) * (acc[cf][1] + bs); v[2] = bflo(uu.y) * (acc[cf][2] + bs); v[3] = bfhi(uu.y) * (acc[cf][3] + bs);
        ss += (v[0] * v[0] + v[1] * v[1]) + (v[2] * v[2] + v[3] * v[3]);
        *(v2u*)(op + 16 * cf) = (v2u){cvtpk(v[0], v[1]), cvtpk(v[2], v[3])}; }
    ss += __shfl_xor(ss, 16); ss += __shfl_xor(ss, 32);
    if (g == 0) ssqm[(size_t)tok * 24 + 16 + h] = ss;
}

__device__ __forceinline__ void gmlp_sample_wave(int db, int h, const bf16* GU, const bf16* GV, const float* w_s, const float* b_s, const float* vgain, bf16* MG, float* ssqm, float* out, int lane) {
    const int tok0 = MP + db * 4, c = 2 * lane;
    const f32x2 gn = *(const f32x2*)(vgain + h * 128 + c);
    float vn[4][2];
#pragma unroll
    for (int t = 0; t < 4; ++t) { const unsigned w = *(const unsigned*)(GV + (size_t)(tok0 + t) * 1024 + h * 128 + c); const float a = bflo(w), b2 = bfhi(w);
        const float rstd = 1.0f / sqrtf(wave_sum(a * a + b2 * b2) * (1.0f / 128.0f) + EPS);
        vn[t][0] = a * rstd * gn[0]; vn[t][1] = b2 * rstd * gn[1];
        *(f32x2*)(out + pg8::OGV + ((size_t)(db * 4 + t) * 8 + h) * 128 + c) = (f32x2){vn[t][0], vn[t][1]}; }
#pragma unroll
    for (int i = 0; i < 4; ++i) { float m0 = b_s[h * 128 + i], m1 = m0;
#pragma unroll
        for (int jj = 0; jj <= i; ++jj) { const float w = w_s[((size_t)h * 128 + i) * 128 + jj]; m0 += w * vn[jj][0]; m1 += w * vn[jj][1]; }
        const unsigned uw = *(const unsigned*)(GU + (size_t)(tok0 + i) * 1024 + h * 128 + c);
        const float o0 = bflo(uw) * m0, o1 = bfhi(uw) * m1;
        *(unsigned*)(MG + (size_t)(tok0 + i) * DM + 1024 + h * 128 + c) = cvtpk(o0, o1);
        const float ss = wave_sum(o0 * o0 + o1 * o1);
        if (lane == 0) ssqm[(size_t)(tok0 + i) * 24 + 16 + h] = ss; }
}

__device__ __forceinline__ const float* in_ptr(LAS unsigned char* lds, int i) {
    const unsigned long long v = ((const LAS unsigned long long*)(lds + X_PTR))[i];
    const unsigned lo = __builtin_amdgcn_readfirstlane((unsigned)v), hi = __builtin_amdgcn_readfirstlane((unsigned)(v >> 32));
    return (const float*)(const GAS float*)(((unsigned long long)hi << 32) | lo);
}
struct Args { const float* in[23]; float* out; unsigned char* ws; int ph_lo, ph_hi; };
__global__ void __launch_bounds__(NWAVES * 64, 2) mk_fwd(Args args) {
    extern __shared__ __attribute__((aligned(16))) unsigned char lds_raw[];
    LAS unsigned char* lds = (LAS unsigned char*)lds_raw;
    const int tid = threadIdx.x, lane = tid & 63, wid = __builtin_amdgcn_readfirstlane(tid >> 6);
    const int G = gridDim.x, bx = blockIdx.x, vcu = (G % 8 == 0) ? (bx % 8) * (G / 8) + bx / 8 : bx;
    const int gw = vcu * NWAVES + wid, NGW = G * NWAVES;
    unsigned char* ws = args.ws;
    float* out = args.out;
    bf16* Win_t = (bf16*)(ws + WS_WIN); bf16* Wout_t = (bf16*)(ws + WS_WOUT); bf16* Wff1_t = (bf16*)(ws + WS_WFF1); bf16* Wff2_t = (bf16*)(ws + WS_WFF2);
    float* mod = (float*)(ws + WS_MOD); float* ssqm = (float*)(ws + WS_SSQM); float* ssqo = (float*)(ws + WS_SSQO); float* ssqf = (float*)(ws + WS_SSQF);
    bf16* H = (bf16*)(ws + WS_H); bf16* Qb = (bf16*)(ws + WS_Q); bf16* Kb = (bf16*)(ws + WS_K); bf16* Vb = (bf16*)(ws + WS_V); bf16* GU = (bf16*)(ws + WS_GU); bf16* GV = (bf16*)(ws + WS_GV);
    bf16* MG = (bf16*)(ws + WS_MG); float* Ob = (float*)(ws + WS_O); bf16* F1 = (bf16*)(ws + WS_F1); float* Fb = (float*)(ws + WS_F);

    for (int u = tid; u < (LDS_BYTES - X_MISC) / 4; u += NWAVES * 64) ((LAS unsigned*)(lds + X_MISC))[u] = 0u;
    if (tid < 128) { const int n = tid; int bk = n; if (n >= 16) { bk = 16 + (int)(logf((float)n / 16.0f) / 2.0794415416798357f * 16.0f); bk = bk < 31 ? bk : 31; } ((LAS int*)(lds + X_BKT))[tid] = bk; }
    ((LAS float*)(lds + X_TAB))[tid] = args.in[6][tid] * LOG2E;
    if (tid < 23) ((LAS unsigned long long*)(lds + X_PTR))[tid] = (unsigned long long)args.in[tid];
    __syncthreads();
#define INP(i) in_ptr(lds, (i))
#if !MK_CG_SYNC
    XcdBarrier bar = xcd_barrier_post((unsigned*)(ws + WS_CTL) + CW_BAR, (volatile LAS unsigned*)(lds + X_MISC));
#define GRID_BAR(seam) do { if ((seam) == 0) cg::this_grid().sync(); else xcd_barrier(bar); } while (0)
#else
#define GRID_BAR(seam) cg::this_grid().sync()
#endif
    const int lo = args.ph_lo, hi = args.ph_hi;
#ifndef PROBE_PHASE
#define PROBE_PHASE -1
#endif
#define PROBE_MULT 4
    unsigned long long pt0_ = 0, pdt_ = 0;
#define PSTART(k) do { if (PROBE_PHASE == (k) && bx == 0 && tid == 0) pt0_ = __builtin_amdgcn_s_memrealtime(); } while (0)
#define PEND(k) do { if (PROBE_PHASE == (k) && bx == 0 && tid == 0) pdt_ = __builtin_amdgcn_s_memrealtime() - pt0_; } while (0)
#ifndef PH_MASK
#define PH_MASK 0x1ff
#endif
#define IN(k) ((((PH_MASK) >> (k)) & 1) && lo <= (k) && (k) < hi)
#ifndef DUP_MASK
#define DUP_MASK 0
#endif
#define REP(k) for (int rep_ = 0; rep_ < 1 + (((DUP_MASK) >> (k)) & 1); ++rep_)
#define BOTH(k) (IN(k) && IN((k) + 1))

    PSTART(0);
    if (IN(0)) REP(0) {
        silu_publish(G, bx, tid, INP(4), INP(5), (bf16*)(ws + WS_S), (unsigned*)(ws + WS_CTL) + CW_SCNT);
        LAS float* scr = (LAS float*)(lds + wid * 16384);
        constexpr int I_IN = (DM / 64) * (INC / 32), I_OUT = (DM / 64) * (DM / 32), I_F1 = (DM / 64) * (DFF / 32), I_F2 = (DFF / 64) * (DM / 32);
        constexpr int NITEMS = I_IN + I_OUT + I_F1 + I_F2;
        for (int it = gw; it < NITEMS; it += NGW) {
            int r = it;
            if (r < I_IN) { p0_transpose_item(INP(10), DM, INC, Win_t, nullptr, scr, r, lane); continue; } r -= I_IN;
            if (r < I_OUT) { const int kb = r / (DM / 32); p0_transpose_item(INP(17), DM, DM, Wout_t, kb < 16 ? INP(15) : INP(16) - 1024, scr, r, lane); continue; } r -= I_OUT;
            if (r < I_F1) { p0_transpose_item(INP(20), DM, DFF, Wff1_t, nullptr, scr, r, lane); continue; } r -= I_F1;
            p0_transpose_item(INP(21), DFF, DM, Wff2_t, nullptr, scr, r, lane);
        }
        silu_wait(G, tid, (unsigned*)(ws + WS_CTL) + CW_SCNT);
        adaln_phase(lds, vcu, G, tid, wid, lane, (const bf16*)(ws + WS_S), INP(7), INP(8), mod);
        if (BOTH(0)) GRID_BAR(0);
    }
    PEND(0);
    PSTART(1);
    if (IN(1)) REP(1) { p1_rows(lds, vcu, G, gw, NGW, wid, lane, INP(0), INP(1), mod, INP(9), H); if (BOTH(1)) GRID_BAR(1); }
    PEND(1);
    PSTART(2);
    if (IN(2)) REP(2) {
        pg8::Gemm g{H, Win_t, M, INC, DM}; pg8::StaticOrder S; S.init(M, INC, DM, G, bx);
        pg8::EpiInProj E{Qb, Kb, Vb, GU, GV, out};
        pg8::gemm_phase<pg8::EpiInProj, pg8::StaticOrder, true, true>(lds, g, S, E);
        if (BOTH(2)) GRID_BAR(2);
    }
    PEND(2);
    PSTART(3);
    if (IN(3)) REP(3) {
        constexpr int N_AP = 1024, N_GP = 512, N_SA = 128, N_SG = 128;
        for (int r = vcu; r < N_AP; r += G) attn_prompt_unit(lds, r >> 8, (r >> 4) & 15, r & 15, Qb, Kb, Vb, MG, ssqm, INP(11), tid, wid, lane);
        for (int r = vcu; r < N_GP; r += G) gmlp_prompt_unit(lds, r >> 7, (r >> 3) & 15, r & 7, GU, GV, INP(13), INP(14), INP(12), MG, ssqm, tid, wid, lane);
        for (int r = vcu; r < N_SA; r += G) attn_sample_unit(lds, r, Qb, Kb, Vb, INP(2), INP(3), MG, ssqm, INP(11), tid, wid, lane);
        for (int r = (vcu + G - (G >> 1)) % G; r < N_SG; r += G) { const int wu = r * 8 + wid; gmlp_sample_wave(wu >> 3, wu & 7, GU, GV, INP(13), INP(14), INP(12), MG, ssqm, out, lane); }
        __syncthreads();
        if (BOTH(3)) GRID_BAR(3);
    }
    PEND(3);
    PSTART(4);
    if (IN(4)) REP(4) {
        pg8::Gemm g{MG, Wout_t, M, DM, DM}; pg8::SplitOrder S; S.init(DM, G, bx);
        pg8::EpiF32Ssq<true> E{Ob, ssqo, ssqm, (LAS float*)(lds + X_RATIO), (float*)(ws + WS_SLAB4)};
        pg8::gemm_phase<pg8::EpiF32Ssq<true>, pg8::SplitOrder, true, true>(lds, g, S, E);
        if (BOTH(4)) GRID_BAR(4);
    }
    PEND(4);
    PSTART(5);
    if (IN(5)) REP(5) { p5_rows(lds, vcu, G, gw, NGW, wid, lane, INP(0), INP(1), mod, Ob, ssqo, (const float*)(ws + WS_SLAB4), INP(18), INP(19), out, H); if (BOTH(5)) GRID_BAR(5); }
    PEND(5);
    PSTART(6);
    if (IN(6)) REP(6) {
        pg8::Gemm g{H, Wff1_t, M, DFF, DM}; pg8::StaticOrder S; S.init(M, DFF, DM, G, bx);
        pg8::EpiRelu2 E{F1, DFF};
        pg8::gemm_phase<pg8::EpiRelu2, pg8::StaticOrder, true, true>(lds, g, S, E);
        if (BOTH(6)) GRID_BAR(6);
    }
    PEND(6);
    PSTART(7);
    if (IN(7)) REP(7) {
        pg8::Gemm g{F1, Wff2_t, M, DM, DFF}; pg8::SplitOrder S; S.init(DFF, G, bx);
        pg8::EpiF32Ssq<false> E{Fb, ssqf, nullptr, (LAS float*)(lds + X_RATIO), (float*)(ws + WS_SLAB7)};
        pg8::gemm_phase<pg8::EpiF32Ssq<false>, pg8::SplitOrder, true, true>(lds, g, S, E);
        if (BOTH(7)) GRID_BAR(7);
    }
    PEND(7);
    PSTART(8);
    if (IN(8)) { p8_rows(lds, vcu, G, gw, NGW, wid, lane, mod, Fb, ssqf, (const float*)(ws + WS_SLAB7), INP(22), out); }
    PEND(8);
    if (PROBE_PHASE >= 0 && bx == 0 && tid == 0) { const unsigned long long te = __builtin_amdgcn_s_memrealtime(); while (__builtin_amdgcn_s_memrealtime() - te < PROBE_MULT * pdt_) __builtin_amdgcn_s_sleep(8); }
#undef IN
#undef BOTH
}

extern "C" void kernel_launch(void* const* d_in, const int* in_sizes, int n_in, void* d_out, int out_size, void* d_ws, size_t ws_size, hipStream_t stream) {
    static int grid = 0;
    if (grid == 0) {
        if (n_in != 23 || out_size != pg8::OUT_TOTAL || ws_size < WS_END) { fprintf(stderr, "kernel_launch: unexpected shapes: n_in %d out %d ws %zu (need >= %zu)\n", n_in, out_size, ws_size, (size_t)WS_END); grid = -1; return; }
        int dev = 0, cus = 0, per_cu = 0;
        if (hipGetDevice(&dev) != hipSuccess || hipDeviceGetAttribute(&cus, hipDeviceAttributeMultiprocessorCount, dev) != hipSuccess) { grid = -1; return; }
        if (hipFuncSetAttribute((const void*)mk_fwd, hipFuncAttributeMaxDynamicSharedMemorySize, LDS_BYTES) != hipSuccess) { fprintf(stderr, "kernel_launch: hipFuncSetAttribute failed\n"); grid = -1; return; }
        if (hipOccupancyMaxActiveBlocksPerMultiprocessor(&per_cu, (const void*)mk_fwd, NWAVES * 64, LDS_BYTES) != hipSuccess || per_cu < 1) { fprintf(stderr, "kernel_launch: occupancy query says %d\n", per_cu); (void)hipGetLastError(); grid = -1; return; }
        grid = cus;
    }
    if (grid < 0) return;
    (void)hipMemsetAsync((char*)d_ws + WS_CTL, 0, CTL_ZERO_BYTES, stream);
    Args a{};
    for (int i = 0; i < 23; ++i) a.in[i] = (const float*)d_in[i];
    a.out = (float*)d_out; a.ws = (unsigned char*)d_ws;
    if (N_LAUNCHES == 1) {
        a.ph_lo = 0; a.ph_hi = N_PHASES;
        void* kargs[] = {&a};
        hipError_t e = hipLaunchCooperativeKernel((const void*)mk_fwd, dim3(grid), dim3(NWAVES * 64), kargs, LDS_BYTES, stream);
        if (e != hipSuccess) fprintf(stderr, "kernel_launch: cooperative launch failed: %s (grid %d)\n", hipGetErrorString(e), grid);
    } else {
        for (int p = 0; p < N_PHASES; ++p) { a.ph_lo = p; a.ph_hi = p + 1;
            hipLaunchKernelGGL(mk_fwd, dim3(grid), dim3(NWAVES * 64), LDS_BYTES, stream, a); }
    }
}
```

```cpp
#include <hip/hip_runtime.h>
#include <hip/hip_cooperative_groups.h>
#include <cstdio>
#include <cstdint>
#include <cmath>
namespace cg = cooperative_groups;

#ifndef MK_N_LAUNCHES
#define MK_N_LAUNCHES 1
#endif
#ifndef MK_CG_SYNC
#define MK_CG_SYNC 0
#endif

namespace pg8 {
#define PG8_LAS __attribute__((address_space(3)))
typedef unsigned short bf16_t;
typedef short bf16x8 __attribute__((ext_vector_type(8)));
typedef float f32x4 __attribute__((ext_vector_type(4)));
typedef unsigned u32x4 __attribute__((ext_vector_type(4)));
typedef unsigned u32x2 __attribute__((ext_vector_type(2)));
constexpr int BM = 256, BK = 64, HALF = 128, HTB = HALF * BK * 2, STAGE_BYTES = 8 * HTB, NXCD = 8, WGM = 8;

__host__ __device__ __forceinline__ int lds_byte(int r, int c) { const int st = (r >> 4) * 2 + (c >> 5), rr = r & 15, cc = c & 31, ob = rr * 64 + cc * 2; return st * 1024 + (ob ^ (((ob >> 9) & 1) << 5)); }
__host__ __device__ __forceinline__ void stage_rc(int b, int& R, int& C) { const int st = b / 1024, sb = b % 1024, swz = sb ^ (((sb >> 9) & 1) << 5); R = (st >> 1) * 16 + swz / 64; C = (st & 1) * 32 + (swz % 64) / 2; }
__host__ __device__ __forceinline__ int perm32(int rho) { const int n = rho >> 4, i = rho & 15; return 8 * (i >> 2) + 4 * n + (i & 3); }

struct Unit { int pm, pn, kt0, nkt, slice; };
struct Gemm { const bf16_t* A; const bf16_t* Bt; int M, N, K; };

struct StaticOrder {
    int nM, nN, nwg, G, c, ntf;
    __host__ __device__ __forceinline__ void init(int M, int N, int K, int G_, int c_) { nM = M / BM; nN = N / BM; nwg = nM * nN; G = G_; c = c_; ntf = K / BK; }
    __host__ __device__ __forceinline__ void unit_of(int L, Unit& u) const {
        int wgid = L; { const int q = nwg / NXCD, r = nwg % NXCD, xcd = wgid % NXCD, off = wgid / NXCD; wgid = (xcd < r ? xcd * (q + 1) : r * (q + 1) + (xcd - r) * q) + off; }
        const int nig = WGM * nN, gid = wgid / nig, fm = gid * WGM, gsz = (nM - fm) < WGM ? (nM - fm) : WGM;
        u.pm = fm + ((wgid % nig) % gsz); u.pn = (wgid % nig) / gsz; u.kt0 = 0; u.nkt = ntf; u.slice = -1;
    }
    __host__ __device__ __forceinline__ bool next(int i, Unit& u) const { const long L = (long)i * G + c; if (L >= nwg) return false; unit_of((int)L, u); return true; }
    __device__ __forceinline__ void a_ready(const Unit&) const {}
    __device__ __forceinline__ void done(const Unit&) const {}
};
constexpr int NSL = 16;
struct SplitOrder {
    StaticOrder full; int G, c, ntf;
    __host__ __device__ __forceinline__ void init(int K, int G_, int c_) { full.init(8192, 2048, K, G_, c_); G = G_; c = c_; ntf = K / BK; }
    __host__ __device__ __forceinline__ bool next(int i, Unit& u) const {
        const long L = (long)i * G + c; if (L >= 512) return false;
        const bool isfull = L < 256;
        Unit f; full.unit_of(isfull ? (int)L : 0, f);
        const int j = (int)L - 256, tile = j / NSL, sl = j % NSL, nsk = ntf / NSL;
        u.pm = isfull ? f.pm : 32 + (tile >> 3); u.pn = isfull ? f.pn : (tile & 7); u.nkt = isfull ? ntf : nsk; u.kt0 = isfull ? 0 : sl * nsk; u.slice = isfull ? -1 : sl; return true;
    }
    __device__ __forceinline__ void a_ready(const Unit&) const {}
    __device__ __forceinline__ void done(const Unit&) const {}
};

__device__ __forceinline__ unsigned cvt_pk_bf16(float lo, float hi) { unsigned r; asm volatile("v_cvt_pk_bf16_f32 %0, %1, %2" : "=v"(r) : "v"(lo), "v"(hi)); return r; }

__device__ __forceinline__ float gelu_tanh(float x) {
    const float u = x * (0.7978845608028654f + 0.035677408136300125f * x * x);
    const float e = __builtin_amdgcn_exp2f(-2.885390081777927f * u);
    return x * __builtin_amdgcn_rcpf(1.0f + e);
}

constexpr int OY = 0, OKP = 17825792, OVP = 17891328, OKS = 17956864, OVS = 18022400, OGV = 18087936, OUT_TOTAL = 18612224;
constexpr float QSCALE = 0.125f * 1.4426950408889634f;

struct EpiInProj {
    static constexpr bool PERM = true, AFTER_DRAIN = false, MID = false;
    bf16_t *Q, *Kb, *Vb, *GU, *GV; float* out;
    __device__ __forceinline__ void unit_start(const Unit&, int, int) const {}
    __device__ __forceinline__ void mid(f32x4 (&)[2][2][4][2], int, int, int) const {}
    __device__ __forceinline__ void operator()(const f32x4 (&acc)[2][2][4][2], const Unit& u, int wr, int wc, int fr, int fq, int) const {
        const int row0 = u.pm * BM + wr * 64 + fr, cl = wc * 32 + 8 * fq;
        if (u.pn < 4) {
#pragma unroll
            for (int ai = 0; ai < 2; ++ai)
#pragma unroll
                for (int m = 0; m < 4; ++m) { bf16_t* rowp = Q + (size_t)(row0 + ai * HALF + m * 16) * 1024 + u.pn * 256 + cl;
#pragma unroll
                    for (int bj = 0; bj < 2; ++bj) { const f32x4 v0 = acc[ai][bj][m][0] * QSCALE, v1 = acc[ai][bj][m][1] * QSCALE;
                        u32x4 w; w.x = cvt_pk_bf16(v0[0], v0[1]); w.y = cvt_pk_bf16(v0[2], v0[3]); w.z = cvt_pk_bf16(v1[0], v1[1]); w.w = cvt_pk_bf16(v1[2], v1[3]);
                        *(u32x4*)(rowp + bj * HALF) = w; } }
        } else if (u.pn == 4) {
#pragma unroll
            for (int ai = 0; ai < 2; ++ai)
#pragma unroll
                for (int m = 0; m < 4; ++m) { const int row = row0 + ai * HALF + m * 16;
#pragma unroll
                    for (int bj = 0; bj < 2; ++bj) { const f32x4 v0 = acc[ai][bj][m][0], v1 = acc[ai][bj][m][1];
                        u32x4 w; w.x = cvt_pk_bf16(v0[0], v0[1]); w.y = cvt_pk_bf16(v0[2], v0[3]); w.z = cvt_pk_bf16(v1[0], v1[1]); w.w = cvt_pk_bf16(v1[2], v1[3]);
                        bf16_t* base = bj == 0 ? Kb : Vb;
                        *(u32x4*)(base + (size_t)row * 128 + cl) = w;
                        float* o = nullptr;
                        if (row < 8192) { const int t = row & 2047; if (t >= 1920) o = out + (bj == 0 ? OKP : OVP) + ((row >> 11) * 128 + (t - 1920)) * 128 + cl; }
                        else o = out + (bj == 0 ? OKS : OVS) + (row - 8192) * 128 + cl;
                        if (o) { *(f32x4*)o = v0; *(f32x4*)(o + 4) = v1; } } }
        } else {
            bf16_t* base = u.pn < 9 ? GU : GV; const int coff = (u.pn < 9 ? u.pn - 5 : u.pn - 9) * 256 + cl;
#pragma unroll
            for (int ai = 0; ai < 2; ++ai)
#pragma unroll
                for (int m = 0; m < 4; ++m) { bf16_t* rowp = base + (size_t)(row0 + ai * HALF + m * 16) * 1024 + coff;
#pragma unroll
                    for (int bj = 0; bj < 2; ++bj) { const f32x4 v0 = acc[ai][bj][m][0], v1 = acc[ai][bj][m][1];
                        u32x4 w; w.x = cvt_pk_bf16(gelu_tanh(v0[0]), gelu_tanh(v0[1])); w.y = cvt_pk_bf16(gelu_tanh(v0[2]), gelu_tanh(v0[3]));
                        w.z = cvt_pk_bf16(gelu_tanh(v1[0]), gelu_tanh(v1[1])); w.w = cvt_pk_bf16(gelu_tanh(v1[2]), gelu_tanh(v1[3]));
                        *(u32x4*)(rowp + bj * HALF) = w; } }
        }
    }
};

struct EpiRelu2 {
    static constexpr bool PERM = true, AFTER_DRAIN = false, MID = false;
    bf16_t* O; int ldc;
    __device__ __forceinline__ void unit_start(const Unit&, int, int) const {}
    __device__ __forceinline__ void mid(f32x4 (&)[2][2][4][2], int, int, int) const {}
    __device__ __forceinline__ void operator()(const f32x4 (&acc)[2][2][4][2], const Unit& u, int wr, int wc, int fr, int fq, int) const {
        const int row0 = u.pm * BM + wr * 64 + fr, col0 = u.pn * BM + wc * 32 + 8 * fq;
#pragma unroll
        for (int ai = 0; ai < 2; ++ai)
#pragma unroll
            for (int m = 0; m < 4; ++m) { bf16_t* rowp = O + (size_t)(row0 + ai * HALF + m * 16) * ldc + col0;
#pragma unroll
                for (int bj = 0; bj < 2; ++bj) { f32x4 v0 = acc[ai][bj][m][0], v1 = acc[ai][bj][m][1];
#pragma unroll
                    for (int e = 0; e < 4; ++e) { const float a = fmaxf(v0[e], 0.f), b = fmaxf(v1[e], 0.f); v0[e] = a * a; v1[e] = b * b; }
                    u32x4 w; w.x = cvt_pk_bf16(v0[0], v0[1]); w.y = cvt_pk_bf16(v0[2], v0[3]); w.z = cvt_pk_bf16(v1[0], v1[1]); w.w = cvt_pk_bf16(v1[2], v1[3]);
                    *(u32x4*)(rowp + bj * HALF) = w; } }
    }
};

template <bool SCALE> struct EpiF32Ssq {
    static constexpr bool PERM = false, AFTER_DRAIN = false, MID = SCALE;
    float* O; float* ssq; const float* ssqm; PG8_LAS float* xr;
    float* slab;
    __device__ __forceinline__ void unit_start(const Unit& u, int ui, int tid) const {
        if (SCALE) { if (tid < 256) { const float* p = ssqm + (size_t)(u.pm * BM + tid) * 24; float sa = 0.f, sg = 0.f;
#pragma unroll
                for (int i = 0; i < 4; ++i) { const f32x4 v = *(const f32x4*)(p + 4 * i); sa += (v[0] + v[1]) + (v[2] + v[3]); }
#pragma unroll
                for (int i = 4; i < 6; ++i) { const f32x4 v = *(const f32x4*)(p + 4 * i); sg += (v[0] + v[1]) + (v[2] + v[3]); }
                const float ra = 1.0f / sqrtf(sa * (1.0f / 1024.0f) + 1e-6f), rg = 1.0f / sqrtf(sg * (1.0f / 1024.0f) + 1e-6f);
                xr[(ui & 1) * 512 + tid] = ra / rg; xr[(ui & 1) * 512 + 256 + tid] = (u.slice >= 0 && u.slice < NSL / 2) ? ra : rg; } }
    }
    __device__ __forceinline__ void mid(f32x4 (&acc)[2][2][4][2], int ui, int wr, int fr) const {
        if (SCALE) {
#pragma unroll
            for (int ai = 0; ai < 2; ++ai)
#pragma unroll
                for (int m = 0; m < 4; ++m) { const float r = xr[(ui & 1) * 512 + ai * HALF + wr * 64 + m * 16 + fr];
#pragma unroll
                    for (int bj = 0; bj < 2; ++bj)
#pragma unroll
                        for (int n = 0; n < 2; ++n) acc[ai][bj][m][n] = acc[ai][bj][m][n] * r; } }
    }
    __device__ __forceinline__ void operator()(const f32x4 (&acc)[2][2][4][2], const Unit& u, int wr, int wc, int fr, int fq, int ui) const {
        const int col0 = u.pn * BM + wc * 32 + 4 * fq;
        const bool part = u.slice >= 0;
        float* base = (part ? slab + ((size_t)u.slice * 512 + (size_t)(u.pm - 32) * BM) * 2048 : O + (size_t)u.pm * BM * 2048) + (size_t)(wr * 64 + fr) * 2048 + col0;
        float* sq = ssq + (size_t)(u.pm * BM + wr * 64 + fr) * 32 + u.pn * 4 + wc;
#pragma unroll
        for (int ai = 0; ai < 2; ++ai)
#pragma unroll
            for (int m = 0; m < 4; ++m) { const int rl = ai * HALF + wr * 64 + m * 16 + fr;
                const float rg = SCALE ? xr[(ui & 1) * 512 + 256 + rl] : 1.0f; float s = 0.f;
#pragma unroll
                for (int bj = 0; bj < 2; ++bj)
#pragma unroll
                    for (int n = 0; n < 2; ++n) { const f32x4 v = acc[ai][bj][m][n] * rg; s += (v[0] * v[0] + v[1] * v[1]) + (v[2] * v[2] + v[3] * v[3]);
                        *(f32x4*)(base + (size_t)(ai * HALF + m * 16) * 2048 + bj * HALF + n * 16) = v; }
                s += __shfl_xor(s, 16); s += __shfl_xor(s, 32);
                if (!part && fq == 0) sq[(ai * HALF + m * 16) * 32] = s; }
    }
};

template <class Epi, class Sched, bool ALIGN_EPI = false, bool SP2 = false>
__device__ __forceinline__ void gemm_phase(PG8_LAS unsigned char* lds, const Gemm g, const Sched& S, const Epi& E) {
    const int tid = threadIdx.x, wid = __builtin_amdgcn_readfirstlane(tid >> 6), lane = tid & 63, wr = wid >> 2, wc = wid & 3, fr = lane & 15, fq = lane >> 4;
    const int K = g.K;
    unsigned voffA[2], voffB[2];
#pragma unroll
    for (int i = 0; i < 2; ++i) { int R, C; stage_rc(tid * 16 + i * 8192, R, C); const int Rb = Epi::PERM ? ((R & ~31) + perm32(R & 31)) : R;
        voffA[i] = (unsigned)(R * K + C) * 2u; voffB[i] = (unsigned)(Rb * K + C) * 2u; }
    const size_t kstep = (size_t)(BK * 2);
    const size_t hstep = (size_t)HALF * K * 2;
    const size_t tstep = 2 * hstep;
    const unsigned ldsw = (unsigned)wid * 1024u;
    const int aoff = lds_byte(wr * 64 + fr, fq * 8), boff = lds_byte(wc * 32 + fr, fq * 8);
#define PG8_SA(b, h) (((b) * 2 + (h)) * HTB)
#define PG8_SB(b, h) ((4 + (b) * 2 + (h)) * HTB)
#define PG8_STAGE(bufoff, gbase, voff) do { _Pragma("unroll") for (int _i = 0; _i < 2; ++_i) \
        __builtin_amdgcn_global_load_lds((const unsigned*)((const char*)(gbase) + (voff)[_i]), (PG8_LAS unsigned*)(lds + (bufoff) + ldsw + _i * 8192), 16, 0, 0); } while (0)
#define PG8_LDA(dst, b, h) do { _Pragma("unroll") for (int m = 0; m < 4; ++m) _Pragma("unroll") for (int k = 0; k < 2; ++k) dst[m][k] = *(const PG8_LAS bf16x8*)(lds + PG8_SA(b, h) + aoff + m * 2048 + k * 1024); } while (0)
#define PG8_LDB(dst, b, h) do { _Pragma("unroll") for (int n = 0; n < 2; ++n) _Pragma("unroll") for (int k = 0; k < 2; ++k) dst[n][k] = *(const PG8_LAS bf16x8*)(lds + PG8_SB(b, h) + boff + n * 2048 + k * 1024); } while (0)
#define PG8_MMA(ai, bj, At, Bt) do { __builtin_amdgcn_s_setprio(1); _Pragma("unroll") for (int m = 0; m < 4; ++m) _Pragma("unroll") for (int n = 0; n < 2; ++n) _Pragma("unroll") for (int k = 0; k < 2; ++k) \
        acc[ai][bj][m][n] = __builtin_amdgcn_mfma_f32_16x16x32_bf16(Bt[n][k], At[m][k], acc[ai][bj][m][n], 0, 0, 0); __builtin_amdgcn_s_setprio(0); } while (0)
#define PG8_WAIT_V(n) asm volatile("s_waitcnt vmcnt(" #n ")" ::: "memory")
#define PG8_WAIT_L(n) asm volatile("s_waitcnt lgkmcnt(" #n ")" ::: "memory")
#define PG8_BAR __builtin_amdgcn_s_barrier()
#define PG8_SCHED __builtin_amdgcn_sched_barrier(0)
    Unit cur, nxt; int ui = 0;
    if (!S.next(0, cur)) return;
    f32x4 acc[2][2][4][2];
#pragma unroll
    for (int a = 0; a < 2; ++a)
#pragma unroll
        for (int b = 0; b < 2; ++b)
#pragma unroll
            for (int m = 0; m < 4; ++m)
#pragma unroll
                for (int n = 0; n < 2; ++n) acc[a][b][m][n] = (f32x4){0.f, 0.f, 0.f, 0.f};
    bf16x8 At[4][2], B0[2][2], B1[2][2];
    const char* cA = (const char*)g.A + (size_t)cur.pm * tstep + (size_t)cur.kt0 * kstep; const char* cB = (const char*)g.Bt + (size_t)cur.pn * tstep + (size_t)cur.kt0 * kstep;
    S.a_ready(cur);
    if constexpr (SP2) {
        PG8_STAGE(PG8_SB(0, 0), cB, voffB); PG8_STAGE(PG8_SB(0, 1), cB + hstep, voffB); PG8_STAGE(PG8_SA(0, 0), cA, voffA); PG8_STAGE(PG8_SA(0, 1), cA + hstep, voffA);
        if (wr == 1) PG8_BAR;
        PG8_WAIT_V(2); PG8_BAR;
        PG8_STAGE(PG8_SB(1, 0), cB + kstep, voffB); PG8_STAGE(PG8_SA(1, 0), cA + kstep, voffA); PG8_STAGE(PG8_SB(1, 1), cB + hstep + kstep, voffB);
        PG8_WAIT_V(6); PG8_BAR;
    } else {
        PG8_STAGE(PG8_SB(0, 0), cB, voffB); PG8_STAGE(PG8_SA(0, 0), cA, voffA); PG8_STAGE(PG8_SB(0, 1), cB + hstep, voffB); PG8_STAGE(PG8_SA(0, 1), cA + hstep, voffA);
        if (wr == 1) PG8_BAR;
        PG8_WAIT_V(4); PG8_BAR;
        PG8_STAGE(PG8_SB(1, 0), cB + kstep, voffB); PG8_STAGE(PG8_SA(1, 0), cA + kstep, voffA); PG8_STAGE(PG8_SB(1, 1), cB + hstep + kstep, voffB);
        PG8_WAIT_V(6); PG8_BAR;
    }
    for (;;) {
        const bool has_next = S.next(ui + 1, nxt);
        const char* nA = has_next ? (const char*)g.A + (size_t)nxt.pm * tstep + (size_t)nxt.kt0 * kstep : cA; const char* nB = has_next ? (const char*)g.Bt + (size_t)nxt.pn * tstep + (size_t)nxt.kt0 * kstep : cB;
        const int nt = cur.nkt;
        if constexpr (Epi::MID) E.unit_start(cur, ui, tid);
        for (int t = 0; t < nt; t += 2) {
            const bool last = (t == nt - 2);
            const char* a1 = cA + (size_t)(t + 1) * kstep;
            const char* a2 = last ? nA : cA + (size_t)(t + 2) * kstep; const char* b2 = last ? nB : cB + (size_t)(t + 2) * kstep;
            const char* a3 = a2 + kstep; const char* b3 = b2 + kstep;
            if (last && has_next) S.a_ready(nxt);
            if constexpr (Epi::MID) { if (cur.slice < 0 && t == (nt >> 1)) E.mid(acc, ui, wr, fr); }
            if constexpr (SP2) {
            PG8_LDB(B0, 0, 0); PG8_LDB(B1, 0, 1); PG8_SCHED; PG8_LDA(At, 0, 0); PG8_STAGE(PG8_SA(1, 1), a1 + hstep, voffA);
            PG8_WAIT_V(8); PG8_WAIT_L(0); PG8_BAR; PG8_MMA(0, 0, At, B0); PG8_MMA(0, 1, At, B1); PG8_BAR; PG8_SCHED;
            PG8_LDA(At, 0, 1); PG8_STAGE(PG8_SB(0, 0), b2, voffB); PG8_STAGE(PG8_SB(0, 1), b2 + hstep, voffB); PG8_STAGE(PG8_SA(0, 0), a2, voffA);
            PG8_WAIT_V(8); PG8_WAIT_L(0); PG8_BAR; PG8_MMA(1, 0, At, B0); PG8_MMA(1, 1, At, B1); PG8_BAR; PG8_SCHED;
            PG8_LDB(B0, 1, 0); PG8_LDB(B1, 1, 1); PG8_SCHED; PG8_LDA(At, 1, 0); PG8_STAGE(PG8_SA(0, 1), a2 + hstep, voffA);
            PG8_WAIT_V(8); PG8_WAIT_L(0); PG8_BAR; PG8_MMA(0, 0, At, B0); PG8_MMA(0, 1, At, B1); PG8_BAR; PG8_SCHED;
            PG8_LDA(At, 1, 1); PG8_STAGE(PG8_SB(1, 0), b3, voffB); PG8_STAGE(PG8_SB(1, 1), b3 + hstep, voffB); PG8_STAGE(PG8_SA(1, 0), a3, voffA);
            PG8_WAIT_V(8); PG8_WAIT_L(0); PG8_BAR; PG8_MMA(1, 0, At, B0); PG8_MMA(1, 1, At, B1); PG8_BAR; PG8_SCHED;
            } else {
            PG8_LDB(B0, 0, 0); PG8_SCHED; PG8_LDA(At, 0, 0); PG8_STAGE(PG8_SA(1, 1), a1 + hstep, voffA);
            PG8_WAIT_L(8); PG8_BAR; PG8_WAIT_L(0); PG8_MMA(0, 0, At, B0); PG8_BAR; PG8_SCHED;
            PG8_LDB(B1, 0, 1); PG8_STAGE(PG8_SB(0, 0), b2, voffB);
            PG8_BAR; PG8_WAIT_L(0); PG8_MMA(0, 1, At, B1); PG8_BAR;
            PG8_LDA(At, 0, 1); PG8_STAGE(PG8_SA(0, 0), a2, voffA);
            PG8_BAR; PG8_WAIT_L(0); PG8_MMA(1, 0, At, B0); PG8_BAR; PG8_SCHED;
            PG8_STAGE(PG8_SB(0, 1), b2 + hstep, voffB);
            PG8_WAIT_V(6); PG8_BAR; PG8_MMA(1, 1, At, B1); PG8_BAR;
            PG8_LDB(B0, 1, 0); PG8_SCHED; PG8_LDA(At, 1, 0); PG8_STAGE(PG8_SA(0, 1), a2 + hstep, voffA);
            PG8_WAIT_L(8); PG8_BAR; PG8_WAIT_L(0); PG8_MMA(0, 0, At, B0); PG8_BAR; PG8_SCHED;
            PG8_LDB(B1, 1, 1); PG8_STAGE(PG8_SB(1, 0), b3, voffB);
            PG8_BAR; PG8_WAIT_L(0); PG8_MMA(0, 1, At, B1); PG8_BAR;
            PG8_LDA(At, 1, 1); PG8_STAGE(PG8_SA(1, 0), a3, voffA);
            PG8_BAR; PG8_WAIT_L(0); PG8_MMA(1, 0, At, B0); PG8_BAR; PG8_SCHED;
            PG8_STAGE(PG8_SB(1, 1), b3 + hstep, voffB);
            PG8_WAIT_V(6); PG8_BAR; PG8_MMA(1, 1, At, B1); PG8_BAR;
            }
        }
        if constexpr (ALIGN_EPI) { if (wr == 0) PG8_BAR; }
        if constexpr (!Epi::AFTER_DRAIN) { E(acc, cur, wr, wc, fr, fq, ui); S.done(cur); }
        if (!has_next) break;
#pragma unroll
        for (int a = 0; a < 2; ++a)
#pragma unroll
            for (int b = 0; b < 2; ++b)
#pragma unroll
                for (int m = 0; m < 4; ++m)
#pragma unroll
                    for (int n = 0; n < 2; ++n) acc[a][b][m][n] = (f32x4){0.f, 0.f, 0.f, 0.f};
        cur = nxt; cA = nA; cB = nB; ++ui;
        if constexpr (ALIGN_EPI) { if (wr == 1) PG8_BAR; }
    }
    PG8_WAIT_V(0);
    if constexpr (!ALIGN_EPI) { if (wr == 0) PG8_BAR; }
    PG8_BAR;
#undef PG8_SA
#undef PG8_SB
#undef PG8_STAGE
#undef PG8_LDA
#undef PG8_LDB
#undef PG8_MMA
#undef PG8_WAIT_V
#undef PG8_WAIT_L
#undef PG8_BAR
#undef PG8_SCHED
}
}

constexpr int NWAVES = 8;
constexpr int DM = 2048, MP = 8192, MS = 512, M = MP + MS, INC = 3328, DFF = 8192, NMOD = 12288;
constexpr float EPS = 1e-6f, LOG2E = 1.4426950408889634f;
constexpr int N_PHASES = 9;
constexpr int N_LAUNCHES = MK_N_LAUNCHES;

constexpr size_t MiB = 1u << 20;
constexpr size_t WS_CTL = 0, CTL_ZERO_BYTES = 1 * MiB;
constexpr size_t WS_WIN = 2 * MiB, WS_WOUT = 16 * MiB, WS_WFF1 = 24 * MiB, WS_WFF2 = 90 * MiB;
constexpr size_t WS_H = 56 * MiB;
constexpr size_t WS_MOD = 122 * MiB;
constexpr size_t WS_SSQM = 129 * MiB, WS_SSQO = 130 * MiB, WS_SSQF = 132 * MiB;
constexpr size_t WS_Q = 134 * MiB, WS_K = 151 * MiB, WS_V = 154 * MiB, WS_GU = 157 * MiB, WS_GV = 174 * MiB;
constexpr size_t WS_MG = 202 * MiB;
constexpr size_t WS_O = 134 * MiB;
constexpr size_t WS_F1 = 134 * MiB;
constexpr size_t WS_F = 270 * MiB;
constexpr size_t WS_SLAB4 = 270 * MiB;
constexpr size_t WS_SLAB7 = 2 * MiB;
constexpr size_t WS_END = 338 * MiB;
constexpr size_t SLAB_BYTES = (size_t)16 * 512 * 2048 * 4;
static_assert(WS_SSQM + (size_t)M * 24 * 4 <= WS_SSQO && WS_SSQO + (size_t)M * 32 * 4 <= WS_SSQF && WS_SSQF + (size_t)M * 32 * 4 <= WS_Q, "partials");
static_assert(WS_MOD + (size_t)132 * NMOD * 4 <= WS_SSQM && WS_H + (size_t)M * DM * 2 <= WS_WFF2 && WS_Q + (size_t)M * 1024 * 2 <= WS_K && WS_K + (size_t)M * 128 * 2 <= WS_V &&
              WS_V + (size_t)M * 128 * 2 <= WS_GU && WS_GU + (size_t)M * 1024 * 2 <= WS_GV && WS_GV + (size_t)M * 1024 * 2 <= WS_MG && WS_O + (size_t)M * DM * 4 <= WS_MG &&
              WS_MG + (size_t)M * DM * 2 <= WS_F && WS_F1 + (size_t)M * DFF * 2 <= WS_F && WS_F + (size_t)M * DM * 4 <= WS_END && WS_SLAB4 + SLAB_BYTES <= WS_END &&
              WS_SLAB7 + SLAB_BYTES <= WS_WFF2, "d_ws map");
static_assert(WS_WIN + (size_t)INC * DM * 2 <= WS_WOUT && WS_WOUT + (size_t)DM * DM * 2 <= WS_WFF1 && WS_WFF1 + (size_t)DFF * DM * 2 <= WS_H && WS_WFF2 + (size_t)DFF * DM * 2 <= WS_MOD, "weights");
constexpr int CW_BAR = 4096, CW_SCNT = 64;
constexpr size_t WS_S = 1 * MiB;

constexpr int RING_BYTES = 131072;
constexpr int X_RATIO = 131072;
constexpr int X_BKT = X_RATIO + 4096;
constexpr int X_TAB = X_BKT + 512;
constexpr int X_PTR = X_TAB + 2048;
constexpr int X_MISC = 139264;
constexpr int LDS_BYTES = 147456;

#define GAS __attribute__((address_space(1)))
#define LAS __attribute__((address_space(3)))
typedef unsigned short bf16;
typedef unsigned v4u __attribute__((ext_vector_type(4)));
typedef unsigned v2u __attribute__((ext_vector_type(2)));
typedef float f32x4 __attribute__((ext_vector_type(4)));
typedef float f32x2 __attribute__((ext_vector_type(2)));
typedef short bf16x8 __attribute__((ext_vector_type(8)));
typedef GAS unsigned gu32;
#define RLX_AGENT __ATOMIC_RELAXED, __HIP_MEMORY_SCOPE_AGENT
#define LDS_WAIT() asm volatile("s_waitcnt lgkmcnt(0)" ::: "memory")
#define VM_WAIT() asm volatile("s_waitcnt vmcnt(0)" ::: "memory")

__device__ __forceinline__ unsigned cvtpk(float lo, float hi) { return pg8::cvt_pk_bf16(lo, hi); }
__device__ __forceinline__ float bf2f(unsigned b) { return __uint_as_float(b << 16); }
__device__ __forceinline__ float bflo(unsigned w) { return __uint_as_float(w << 16); }
__device__ __forceinline__ float bfhi(unsigned w) { return __uint_as_float(w & 0xffff0000u); }
__device__ __forceinline__ bf16x8 pack8(f32x4 a, f32x4 b) { v4u w; w.x = cvtpk(a[0], a[1]); w.y = cvtpk(a[2], a[3]); w.z = cvtpk(b[0], b[1]); w.w = cvtpk(b[2], b[3]); return __builtin_bit_cast(bf16x8, w); }
__device__ __forceinline__ float wave_sum(float v) {
#pragma unroll
    for (int o = 1; o < 64; o <<= 1) v += __shfl_xor(v, o);
    return v;
}
__device__ __forceinline__ float silu_f(float x) { return x * __builtin_amdgcn_rcpf(1.0f + __builtin_amdgcn_exp2f(-LOG2E * x)); }
#define MFMA16(a, b, c) __builtin_amdgcn_mfma_f32_16x16x32_bf16((a), (b), (c), 0, 0, 0)

#define XB_TMO      128
#define XB_XCNT(j)  (256  + 64 * (j))
#define XB_XSUB(j)  (1280 + 64 * (j))
#define XB_XGEN(j)  (2304 + 64 * (j))
#define XB_TOP      3328
#define XB_TOPGEN   3392
#define XCD_BAR_WORDS 3456
#define XB_SPIN_CAP (1u << 18)
__device__ __forceinline__ unsigned xb_ld(unsigned* p)              { return __hip_atomic_load(p, __ATOMIC_RELAXED, __HIP_MEMORY_SCOPE_AGENT); }
__device__ __forceinline__ unsigned xb_add(unsigned* p, unsigned v) { return __hip_atomic_fetch_add(p, v, __ATOMIC_RELAXED, __HIP_MEMORY_SCOPE_AGENT); }
__device__ __forceinline__ unsigned xb_xcc_id() { return (unsigned)__builtin_amdgcn_s_getreg((3 << 11) | 20) & 0xFu; }
#define XB_SPIN(cond, bar) do { unsigned _sp = 0; while (cond) { __builtin_amdgcn_s_sleep(1); \
    if ((++_sp & 255u) == 0u) { if (xb_ld(&(bar)[XB_TMO])) break; if (_sp > XB_SPIN_CAP) { atomicAdd(&(bar)[XB_TMO], 1u); break; } } } } while (0)
struct XcdBarrier { unsigned* bar; unsigned x; volatile LAS unsigned* st; };
__device__ __forceinline__ XcdBarrier xcd_barrier_post(unsigned* bar, volatile LAS unsigned* st) {
    XcdBarrier b; b.bar = bar; b.x = xb_xcc_id(); b.st = st;
    if (threadIdx.x == 0) (void)xb_add(&bar[XB_XCNT(b.x)], 1u);
    return b;
}
__device__ __forceinline__ void xcd_barrier_complete(unsigned* bar, unsigned x, unsigned& nloc, unsigned& nx) {
    const unsigned G = gridDim.x * gridDim.y * gridDim.z;
    unsigned sum, cnt, mine, sp = 0u;
    for (;;) {
        sum = 0u; cnt = 0u; mine = 0u;
#pragma unroll
        for (unsigned j = 0; j < 16; ++j) { const unsigned c = xb_ld(&bar[XB_XCNT(j)]); sum += c; cnt += (c > 0u) ? 1u : 0u; mine = (j == x) ? c : mine; }
        if (sum == G) break;
        __builtin_amdgcn_s_sleep(1);
        if ((++sp & 255u) == 0u) { if (xb_ld(&bar[XB_TMO])) break; if (sp > XB_SPIN_CAP) { atomicAdd(&bar[XB_TMO], 1u); break; } }
    }
    nloc = mine > 0u ? mine : 1u; nx = cnt > 0u ? cnt : 1u;
}
__device__ __forceinline__ void xcd_barrier(const XcdBarrier& b) {
    asm volatile("s_waitcnt vmcnt(0)" ::: "memory");
    __syncthreads();
    if (threadIdx.x == 0) {
        unsigned* bar = b.bar;
        __builtin_amdgcn_s_waitcnt(0);
        unsigned nloc = b.st[0], nx = b.st[1];
        if (nloc == 0u) { xcd_barrier_complete(bar, b.x, nloc, nx); b.st[0] = nloc; b.st[1] = nx; }
        const unsigned old = xb_add(&bar[XB_XSUB(b.x)], 1u);
        const unsigned gen = old / nloc;
        if (old + 1u == (gen + 1u) * nloc) {
            __builtin_amdgcn_fence(__ATOMIC_RELEASE, "agent");
            asm volatile("s_waitcnt vmcnt(0)" ::: "memory");
            const unsigned og = xb_add(&bar[XB_TOP], 1u);
            const unsigned tg = og / nx;
            if (og + 1u == (tg + 1u) * nx) xb_add(&bar[XB_TOPGEN], 1u);
            else XB_SPIN(xb_ld(&bar[XB_TOPGEN]) == tg, bar);
            __builtin_amdgcn_fence(__ATOMIC_ACQUIRE, "agent");
            xb_add(&bar[XB_XGEN(b.x)], 1u);
            asm volatile("s_waitcnt vmcnt(0)" ::: "memory");
        } else {
            XB_SPIN(xb_ld(&bar[XB_XGEN(b.x)]) == gen, bar);
            __builtin_amdgcn_fence(__ATOMIC_ACQUIRE, "agent");
            asm volatile("s_waitcnt vmcnt(0)" ::: "memory");
        }
    }
    __syncthreads();
}

__device__ __forceinline__ void p0_transpose_item(const float* W, int K, int N, bf16* WT, const float* kscale, LAS float* scr, int item, int lane) {
    const int nblk = N / 32, kb = item / nblk, nb = item % nblk, k0 = 64 * kb, n0 = 32 * nb;
    float tv[32];
    const float* wp = W + (size_t)(k0 + (lane >> 5)) * N + n0 + (lane & 31);
#pragma unroll
    for (int i = 0; i < 32; ++i) tv[i] = wp[(size_t)(2 * i) * N];
    if (kscale) {
#pragma unroll
        for (int i = 0; i < 32; ++i) tv[i] *= kscale[k0 + 2 * i + (lane >> 5)]; }
#pragma unroll
    for (int i = 0; i < 32; ++i) scr[(2 * i + (lane >> 5)) * 33 + (lane & 31)] = tv[i];
    LDS_WAIT(); asm volatile("" ::: "memory");
    const int c = lane & 7;
#pragma unroll
    for (int j = 0; j < 4; ++j) { const int n = (lane >> 3) + 8 * j; const LAS float* s = scr + (8 * c) * 33 + n;
        v4u o; o.x = cvtpk(s[0 * 33], s[1 * 33]); o.y = cvtpk(s[2 * 33], s[3 * 33]); o.z = cvtpk(s[4 * 33], s[5 * 33]); o.w = cvtpk(s[6 * 33], s[7 * 33]);
        *(GAS v4u*)(WT + (size_t)(n0 + n) * K + k0 + 8 * c) = o; }
    LDS_WAIT(); asm volatile("" ::: "memory");
}

__device__ __forceinline__ void silu_publish(int G, int bx, int tid, const float* c_prompt, const float* c_sample, bf16* S, unsigned* cnt) {
    for (int grp = bx * 512 + tid; grp < 144 * 256; grp += G * 512) { const int row = grp >> 8, k8 = (grp & 255) * 8;
        v4u w = (v4u){0u, 0u, 0u, 0u};
        if (row < 132) { const float* cp = (row < 4 ? c_prompt + (size_t)row * DM : c_sample + (size_t)(row - 4) * DM) + k8;
            const f32x4 a = *(const f32x4*)cp, b = *(const f32x4*)(cp + 4);
            w.x = cvtpk(silu_f(a[0]), silu_f(a[1])); w.y = cvtpk(silu_f(a[2]), silu_f(a[3])); w.z = cvtpk(silu_f(b[0]), silu_f(b[1])); w.w = cvtpk(silu_f(b[2]), silu_f(b[3])); }
        *(v4u*)(S + (size_t)row * DM + k8) = w; }
    asm volatile("s_waitcnt vmcnt(0)" ::: "memory");
    __syncthreads();
    if (tid == 0) { __builtin_amdgcn_fence(__ATOMIC_RELEASE, "agent"); asm volatile("s_waitcnt vmcnt(0)" ::: "memory"); __hip_atomic_fetch_add(cnt, 1u, __ATOMIC_RELAXED, __HIP_MEMORY_SCOPE_AGENT); }
}
__device__ __forceinline__ void silu_wait(int G, int tid, unsigned* cnt) {
    if (tid == 0) { unsigned sp = 0;
        while (__hip_atomic_load(cnt, __ATOMIC_RELAXED, __HIP_MEMORY_SCOPE_AGENT) < (unsigned)G) { __builtin_amdgcn_s_sleep(2); if (++sp > (1u << 22)) break; }
        __builtin_amdgcn_fence(__ATOMIC_ACQUIRE, "agent"); asm volatile("s_waitcnt vmcnt(0)" ::: "memory"); }
    __syncthreads();
}
__device__ __forceinline__ void adaln_phase(LAS unsigned char* lds, int vcu, int G, int tid, int wid, int lane, const bf16* S, const float* w_ada, const float* b_ada, float* mod) {
    const int fr = lane & 15, g = lane >> 4;
    LAS float* scr = (LAS float*)(lds + wid * 16384);
    const unsigned wvoff = (unsigned)(((lane >> 2) * NMOD + 4 * (lane & 3)) * 4);
    const unsigned soff = (unsigned)((fr * DM + 8 * g) * 2);
    const int scr_w = (lane >> 2) * 52 + 4 * (lane & 3);
    for (int strip = vcu; strip < NMOD / 48; strip += G) {
        const int n0 = strip * 48;
        f32x4 acc[9][3];
#pragma unroll
        for (int rf = 0; rf < 9; ++rf)
#pragma unroll
            for (int nf = 0; nf < 3; ++nf) acc[rf][nf] = (f32x4){0.f, 0.f, 0.f, 0.f};
        f32x4 wv[6];
        { const char* wb = (const char*)(w_ada + (size_t)(wid * 256) * NMOD + n0);
#pragma unroll
          for (int i = 0; i < 6; ++i) wv[i] = *(const f32x4*)(wb + (size_t)(16 * (i / 3)) * NMOD * 4 + 64 * (i % 3) + wvoff); }
#pragma unroll 1
        for (int kb = 0; kb < 8; ++kb) {
            const int k0 = wid * 256 + kb * 32;
            bf16x8 af[9];
            { const char* sb = (const char*)(S + k0) + soff;
#pragma unroll
              for (int rf = 0; rf < 9; ++rf) af[rf] = *(const bf16x8*)(sb + (size_t)(16 * rf) * DM * 2); }
#pragma unroll
            for (int i = 0; i < 6; ++i) *(LAS f32x4*)(scr + scr_w + 16 * (i / 3) * 52 + 16 * (i % 3)) = wv[i];
            asm volatile("" ::: "memory");
            if (kb < 7) { const char* wb = (const char*)(w_ada + (size_t)(k0 + 32) * NMOD + n0);
#pragma unroll
                for (int i = 0; i < 6; ++i) wv[i] = *(const f32x4*)(wb + (size_t)(16 * (i / 3)) * NMOD * 4 + 64 * (i % 3) + wvoff); }
            LDS_WAIT(); asm volatile("" ::: "memory");
            bf16x8 bfr[3];
#pragma unroll
            for (int nf = 0; nf < 3; ++nf) { const LAS float* s = scr + (8 * g) * 52 + 16 * nf + fr;
                bfr[nf] = pack8((f32x4){s[0], s[52], s[104], s[156]}, (f32x4){s[208], s[260], s[312], s[364]}); }
#pragma unroll
            for (int rf = 0; rf < 9; ++rf)
#pragma unroll
                for (int nf = 0; nf < 3; ++nf) acc[rf][nf] = MFMA16(af[rf], bfr[nf], acc[rf][nf]);
            LDS_WAIT(); asm volatile("" ::: "memory");
        }
#pragma unroll
        for (int p = 0; p < 3; ++p) {
            __syncthreads();
            LAS float* red = (LAS float*)lds + wid * 2304;
#pragma unroll
            for (int rf = 0; rf < 9; ++rf)
#pragma unroll
                for (int i = 0; i < 4; ++i) red[(16 * rf + 4 * g + i) * 16 + fr] = acc[rf][p][i];
            __syncthreads();
            for (int e = tid; e < 2304; e += 512) { const int r = e >> 4, c = e & 15; float sum = 0.f;
#pragma unroll
                for (int w = 0; w < 8; ++w) sum += ((LAS float*)lds)[w * 2304 + e];
                if (r < 132) mod[(size_t)r * NMOD + n0 + 16 * p + c] = sum + b_ada[n0 + 16 * p + c]; }
        }
        __syncthreads();
    }
}

__device__ __forceinline__ const float* x_row(const float* xp, const float* xs, int m) { return m < MP ? xp + (size_t)m * DM : xs + (size_t)(m - MP) * DM; }
__device__ __forceinline__ int mod_row(int m) { return m < MP ? (m >> 11) : 4 + ((m - MP) >> 2); }

__device__ __forceinline__ float ssq8(const f32x4 (&v)[8]) { float s = 0.f;
#pragma unroll
    for (int j = 0; j < 8; ++j) s += (v[j][0] * v[j][0] + v[j][1] * v[j][1]) + (v[j][2] * v[j][2] + v[j][3] * v[j][3]);
    return s; }
__device__ __forceinline__ float ssq2(const f32x4 (&v)[2]) { return ((v[0][0] * v[0][0] + v[0][1] * v[0][1]) + (v[0][2] * v[0][2] + v[0][3] * v[0][3])) + ((v[1][0] * v[1][0] + v[1][1] * v[1][1]) + (v[1][2] * v[1][2] + v[1][3] * v[1][3])); }
__device__ __forceinline__ float quad_sum(LAS float* red, float v, int wid, int lane) {
    v = wave_sum(v); if (lane == 0) red[wid] = v; __syncthreads();
    const int b = wid & 4; const float t = (red[b] + red[b + 1]) + (red[b + 2] + red[b + 3]); __syncthreads(); return t;
}
__device__ __forceinline__ void p1_rows(LAS unsigned char* lds, int vcu, int G, int gw, int NGW, int wid, int lane, const float* xp, const float* xs, const float* mod, const float* gpre, bf16* H) {
    f32x4 v[8], nx[8];
    if (gw < MP) { const f32x4* xr = (const f32x4*)(xp + (size_t)gw * DM) + lane;
#pragma unroll
        for (int j = 0; j < 8; ++j) nx[j] = xr[64 * j]; }
    for (int m = gw; m < MP; m += NGW) {
#pragma unroll
        for (int j = 0; j < 8; ++j) v[j] = nx[j];
        if (m + NGW < MP) { const f32x4* xr = (const f32x4*)(xp + (size_t)(m + NGW) * DM) + lane;
#pragma unroll
            for (int j = 0; j < 8; ++j) nx[j] = xr[64 * j]; }
        const float* mr = mod + (size_t)(m >> 11) * NMOD;
        const float rstd = 1.0f / sqrtf(wave_sum(ssq8(v)) * (1.0f / DM) + EPS);
        v2u* o8 = (v2u*)(H + (size_t)m * DM) + lane;
#pragma unroll
        for (int j = 0; j < 8; ++j) { const int k = 4 * (lane + 64 * j);
            const f32x4 gg = *(const f32x4*)(gpre + k), sh = *(const f32x4*)(mr + k), sc = *(const f32x4*)(mr + DM + k);
            const f32x4 h = v[j] * rstd * gg * (sc + 1.0f) + sh;
            o8[64 * j] = (v2u){cvtpk(h[0], h[1]), cvtpk(h[2], h[3])}; }
    }
    LAS float* red = (LAS float*)lds;
    for (int pr = vcu; pr < MS / 2; pr += G) {
        const int r = 2 * pr + (wid >> 2), m = MP + r, c0 = (wid & 3) * 512 + 4 * lane;
        const float* mr = mod + (size_t)(4 + (r >> 2)) * NMOD;
        f32x4 x[2];
#pragma unroll
        for (int j = 0; j < 2; ++j) x[j] = *(const f32x4*)(xs + (size_t)r * DM + c0 + 256 * j);
        const float rstd = 1.0f / sqrtf(quad_sum(red, ssq2(x), wid, lane) * (1.0f / DM) + EPS);
#pragma unroll
        for (int j = 0; j < 2; ++j) { const int k = c0 + 256 * j;
            const f32x4 gg = *(const f32x4*)(gpre + k), sh = *(const f32x4*)(mr + k), sc = *(const f32x4*)(mr + DM + k);
            const f32x4 h = x[j] * rstd * gg * (sc + 1.0f) + sh;
            *(v2u*)(H + (size_t)m * DM + k) = (v2u){cvtpk(h[0], h[1]), cvtpk(h[2], h[3])}; }
    }
}
__device__ __forceinline__ void p5_rows(LAS unsigned char* lds, int vcu, int G, int gw, int NGW, int wid, int lane, const float* xp, const float* xs, const float* mod, const float* O,
                                        const float* ssqo, const float* slab, const float* gpost, const float* gpreff, float* out, bf16* H) {
    f32x4 v[8], o[8], nx[8], no[8]; float nq = 0.f;
    if (gw < MP) { const f32x4* xr = (const f32x4*)(xp + (size_t)gw * DM) + lane; const f32x4* orow = (const f32x4*)(O + (size_t)gw * DM) + lane;
#pragma unroll
        for (int j = 0; j < 8; ++j) { nx[j] = xr[64 * j]; no[j] = orow[64 * j]; }
        nq = lane < 32 ? ssqo[(size_t)gw * 32 + lane] : 0.f; }
    for (int m = gw; m < MP; m += NGW) {
#pragma unroll
        for (int j = 0; j < 8; ++j) { v[j] = nx[j]; o[j] = no[j]; }
        const float q = nq;
        if (m + NGW < MP) { const int mn = m + NGW; const f32x4* xr = (const f32x4*)(xp + (size_t)mn * DM) + lane; const f32x4* orow = (const f32x4*)(O + (size_t)mn * DM) + lane;
#pragma unroll
            for (int j = 0; j < 8; ++j) { nx[j] = xr[64 * j]; no[j] = orow[64 * j]; }
            nq = lane < 32 ? ssqo[(size_t)mn * 32 + lane] : 0.f; }
        const float* mr = mod + (size_t)(m >> 11) * NMOD;
        const float rstdo = 1.0f / sqrtf(wave_sum(q) * (1.0f / DM) + EPS);
#pragma unroll
        for (int j = 0; j < 8; ++j) { const int k = 4 * (lane + 64 * j);
            const f32x4 gt = *(const f32x4*)(mr + 2 * DM + k), gp = *(const f32x4*)(gpost + k);
            v[j] = v[j] + gt * (o[j] * rstdo * gp); }
        const float rstd = 1.0f / sqrtf(wave_sum(ssq8(v)) * (1.0f / DM) + EPS);
        f32x4* xo = (f32x4*)(out + (size_t)m * DM) + lane;
        v2u* o8 = (v2u*)(H + (size_t)m * DM) + lane;
#pragma unroll
        for (int j = 0; j < 8; ++j) { const int k = 4 * (lane + 64 * j);
            xo[64 * j] = v[j];
            const f32x4 gg = *(const f32x4*)(gpreff + k), sh = *(const f32x4*)(mr + 3 * DM + k), sc = *(const f32x4*)(mr + 4 * DM + k);
            const f32x4 h = v[j] * rstd * gg * (sc + 1.0f) + sh;
            o8[64 * j] = (v2u){cvtpk(h[0], h[1]), cvtpk(h[2], h[3])}; }
    }
    LAS float* red = (LAS float*)lds;
    for (int pr = vcu; pr < MS / 2; pr += G) {
        const int r = 2 * pr + (wid >> 2), m = MP + r, c0 = (wid & 3) * 512 + 4 * lane;
        const float* mr = mod + (size_t)(4 + (r >> 2)) * NMOD;
        f32x4 x[2], a[2];
#pragma unroll
        for (int j = 0; j < 2; ++j) { x[j] = *(const f32x4*)(xs + (size_t)r * DM + c0 + 256 * j); a[j] = (f32x4){0.f, 0.f, 0.f, 0.f}; }
#pragma unroll
        for (int sl = 0; sl < pg8::NSL; ++sl)
#pragma unroll
            for (int j = 0; j < 2; ++j) a[j] = a[j] + *(const f32x4*)(slab + ((size_t)sl * 512 + r) * DM + c0 + 256 * j);
        const float rstdo = 1.0f / sqrtf(quad_sum(red, ssq2(a), wid, lane) * (1.0f / DM) + EPS);
#pragma unroll
        for (int j = 0; j < 2; ++j) { const int k = c0 + 256 * j;
            const f32x4 gt = *(const f32x4*)(mr + 2 * DM + k), gp = *(const f32x4*)(gpost + k);
            x[j] = x[j] + gt * (a[j] * rstdo * gp); }
        const float rstd = 1.0f / sqrtf(quad_sum(red, ssq2(x), wid, lane) * (1.0f / DM) + EPS);
#pragma unroll
        for (int j = 0; j < 2; ++j) { const int k = c0 + 256 * j;
            *(f32x4*)(out + (size_t)m * DM + k) = x[j];
            const f32x4 gg = *(const f32x4*)(gpreff + k), sh = *(const f32x4*)(mr + 3 * DM + k), sc = *(const f32x4*)(mr + 4 * DM + k);
            const f32x4 h = x[j] * rstd * gg * (sc + 1.0f) + sh;
            *(v2u*)(H + (size_t)m * DM + k) = (v2u){cvtpk(h[0], h[1]), cvtpk(h[2], h[3])}; }
    }
}
__device__ __forceinline__ void p8_rows(LAS unsigned char* lds, int vcu, int G, int gw, int NGW, int wid, int lane, const float* mod, const float* F, const float* ssqf, const float* slab,
                                        const float* gpostff, float* out) {
    f32x4 v[8], o[8], nx[8], no[8]; float nq = 0.f;
    if (gw < MP) { const f32x4* xr = (const f32x4*)(out + (size_t)gw * DM) + lane; const f32x4* orow = (const f32x4*)(F + (size_t)gw * DM) + lane;
#pragma unroll
        for (int j = 0; j < 8; ++j) { nx[j] = xr[64 * j]; no[j] = orow[64 * j]; }
        nq = lane < 32 ? ssqf[(size_t)gw * 32 + lane] : 0.f; }
    for (int m = gw; m < MP; m += NGW) {
#pragma unroll
        for (int j = 0; j < 8; ++j) { v[j] = nx[j]; o[j] = no[j]; }
        const float q = nq;
        if (m + NGW < MP) { const int mn = m + NGW; const f32x4* xr = (const f32x4*)(out + (size_t)mn * DM) + lane; const f32x4* orow = (const f32x4*)(F + (size_t)mn * DM) + lane;
#pragma unroll
            for (int j = 0; j < 8; ++j) { nx[j] = xr[64 * j]; no[j] = orow[64 * j]; }
            nq = lane < 32 ? ssqf[(size_t)mn * 32 + lane] : 0.f; }
        const float* mr = mod + (size_t)(m >> 11) * NMOD;
        const float rstdf = 1.0f / sqrtf(wave_sum(q) * (1.0f / DM) + EPS);
        f32x4* xo = (f32x4*)(out + (size_t)m * DM) + lane;
#pragma unroll
        for (int j = 0; j < 8; ++j) { const int k = 4 * (lane + 64 * j);
            const f32x4 gt = *(const f32x4*)(mr + 5 * DM + k), gp = *(const f32x4*)(gpostff + k);
            xo[64 * j] = v[j] + gt * (o[j] * rstdf * gp); }
    }
    LAS float* red = (LAS float*)lds;
    for (int pr = vcu; pr < MS / 2; pr += G) {
        const int r = 2 * pr + (wid >> 2), m = MP + r, c0 = (wid & 3) * 512 + 4 * lane;
        const float* mr = mod + (size_t)(4 + (r >> 2)) * NMOD;
        f32x4 x[2], a[2];
#pragma unroll
        for (int j = 0; j < 2; ++j) { x[j] = *(const f32x4*)(out + (size_t)m * DM + c0 + 256 * j); a[j] = (f32x4){0.f, 0.f, 0.f, 0.f}; }
#pragma unroll
        for (int sl = 0; sl < pg8::NSL; ++sl)
#pragma unroll
            for (int j = 0; j < 2; ++j) a[j] = a[j] + *(const f32x4*)(slab + ((size_t)sl * 512 + r) * DM + c0 + 256 * j);
        const float rstdf = 1.0f / sqrtf(quad_sum(red, ssq2(a), wid, lane) * (1.0f / DM) + EPS);
#pragma unroll
        for (int j = 0; j < 2; ++j) { const int k = c0 + 256 * j;
            const f32x4 gt = *(const f32x4*)(mr + 5 * DM + k), gp = *(const f32x4*)(gpostff + k);
            *(f32x4*)(out + (size_t)m * DM + k) = x[j] + gt * (a[j] * rstdf * gp); }
    }
}

constexpr int AT_K = 0, AT_V = 36864, AT_LUT = 70656;
__device__ __forceinline__ void attn_prompt_unit(LAS unsigned char* lds, int b, int nb, int h, const bf16* Qb, const bf16* Kb, const bf16* Vb, bf16* MG, float* ssqm,
                                                 const float* sinks, int tid, int wid, int lane) {
    const int kvh = h >> 3, tokq = b * 2048 + nb * 128, tokk = tokq - 128;
    const LAS int* bkt = (const LAS int*)(lds + X_BKT); const LAS float* tab = (const LAS float*)(lds + X_TAB);
    __syncthreads();
#pragma unroll
    for (int i = 0; i < 4; ++i) { const int idx = tid + 512 * i, key = idx >> 3, ch = idx & 7;
        v4u v = (v4u){0u, 0u, 0u, 0u}; if (nb > 0 || key >= 128) v = *(const v4u*)(Kb + (size_t)(tokk + key) * 128 + kvh * 64 + ch * 8);
        *(LAS v4u*)(lds + AT_K + key * 144 + ch * 16) = v; }
#pragma unroll
    for (int i = 0; i < 4; ++i) { const int idx = tid + 512 * i, key = idx & 255, ch = idx >> 8;
        v4u v = (v4u){0u, 0u, 0u, 0u}; if (nb > 0 || key >= 128) v = *(const v4u*)(Vb + (size_t)(tokk + key) * 128 + kvh * 64 + ch * 8);
        LAS unsigned short* vt = (LAS unsigned short*)(lds + AT_V) + (ch * 8) * 264 + key;
        vt[0 * 264] = (unsigned short)(v.x & 0xffffu); vt[1 * 264] = (unsigned short)(v.x >> 16); vt[2 * 264] = (unsigned short)(v.y & 0xffffu); vt[3 * 264] = (unsigned short)(v.y >> 16);
        vt[4 * 264] = (unsigned short)(v.z & 0xffffu); vt[5 * 264] = (unsigned short)(v.z >> 16); vt[6 * 264] = (unsigned short)(v.w & 0xffffu); vt[7 * 264] = (unsigned short)(v.w >> 16); }
    if (tid < 128) ((LAS float*)(lds + AT_LUT))[tid] = tab[bkt[tid] * 16 + h];
    __syncthreads();
    const int fr = lane & 15, g = lane >> 4, f0 = wid < 6 ? wid : 6, qi = 16 * wid + fr;
    const bf16* qp = Qb + (size_t)(tokq + qi) * 1024 + h * 64 + 8 * g;
    const bf16x8 q0 = *(const bf16x8*)qp, q1 = *(const bf16x8*)(qp + 32);
    f32x4 s[10];
#pragma unroll
    for (int f = 0; f < 10; ++f) { const LAS unsigned char* kp = lds + AT_K + (16 * (f0 + f) + fr) * 144 + 16 * g;
        const bf16x8 k0 = *(const LAS bf16x8*)kp, k1 = *(const LAS bf16x8*)(kp + 64);
        s[f] = MFMA16(k0, q0, ((f32x4){0.f, 0.f, 0.f, 0.f})); s[f] = MFMA16(k1, q1, s[f]); }
    const LAS float* lut = (const LAS float*)(lds + AT_LUT);
    const float sk = sinks[h] * LOG2E;
    float mx = -INFINITY;
#pragma unroll
    for (int f = 0; f < 10; ++f)
#pragma unroll
        for (int i = 0; i < 4; ++i) { const int kj = 16 * (f0 + f) + 4 * g + i, dist = 128 + qi - kj; const bool valid = (dist >= 0) && (dist < 128) && (nb > 0 || kj >= 128);
            const float v = valid ? s[f][i] + lut[dist & 127] : -INFINITY; s[f][i] = v; mx = fmaxf(mx, v); }
    mx = fmaxf(mx, __shfl_xor(mx, 16)); mx = fmaxf(mx, __shfl_xor(mx, 32)); mx = fmaxf(mx, sk);
    float l = 0.f;
#pragma unroll
    for (int f = 0; f < 10; ++f)
#pragma unroll
        for (int i = 0; i < 4; ++i) { const float p = __builtin_amdgcn_exp2f(s[f][i] - mx); s[f][i] = p; l += p; }
    l += __shfl_xor(l, 16); l += __shfl_xor(l, 32); l += __builtin_amdgcn_exp2f(sk - mx);
    const float rl = 1.0f / l;
    f32x4 o[4];
#pragma unroll
    for (int df = 0; df < 4; ++df) o[df] = (f32x4){0.f, 0.f, 0.f, 0.f};
#pragma unroll
    for (int si = 0; si < 5; ++si) { const bf16x8 pb = pack8(s[2 * si], s[2 * si + 1]); const int key0 = 16 * (f0 + 2 * si);
#pragma unroll
        for (int df = 0; df < 4; ++df) { const LAS unsigned char* vp = lds + AT_V + ((16 * df + fr) * 264 + key0 + 4 * g) * 2;
            const v2u lo = *(const LAS v2u*)vp, hi = *(const LAS v2u*)(vp + 32);
            const bf16x8 va = __builtin_bit_cast(bf16x8, ((v4u){lo.x, lo.y, hi.x, hi.y}));
            o[df] = MFMA16(va, pb, o[df]); } }
    float ss = 0.f; bf16* op = MG + (size_t)(tokq + qi) * DM + h * 64 + 4 * g;
#pragma unroll
    for (int df = 0; df < 4; ++df) { const f32x4 v = o[df] * rl; ss += (v[0] * v[0] + v[1] * v[1]) + (v[2] * v[2] + v[3] * v[3]);
        *(v2u*)(op + 16 * df) = (v2u){cvtpk(v[0], v[1]), cvtpk(v[2], v[3])}; }
    ss += __shfl_xor(ss, 16); ss += __shfl_xor(ss, 32);
    if (g == 0) ssqm[(size_t)(tokq + qi) * 24 + h] = ss;
}

constexpr int SA_K = 0, SA_V = 41472, SA_END = 84480;
__device__ __forceinline__ void attn_sample_unit(LAS unsigned char* lds, int db, const bf16* Qb, const bf16* Kb, const bf16* Vb, const float* cache_k, const float* cache_v,
                                                 bf16* MG, float* ssqm, const float* sinks, int tid, int wid, int lane) {
    const LAS int* bkt = (const LAS int*)(lds + X_BKT); const LAS float* tab = (const LAS float*)(lds + X_TAB);
    const int tok0 = MP + db * 4;
    __syncthreads();
    for (int i = tid; i < SA_END / 16; i += 512) *(LAS v4u*)(lds + i * 16) = (v4u){0u, 0u, 0u, 0u};
    __syncthreads();
#pragma unroll
    for (int i = 0; i < 8; ++i) { const int idx = tid + 512 * i, j = idx >> 5, kvh = (idx >> 4) & 1, c4 = idx & 15;
        const f32x4 kv = *(const f32x4*)(cache_k + (size_t)db * 16384 + (size_t)idx * 4), vv = *(const f32x4*)(cache_v + (size_t)db * 16384 + (size_t)idx * 4);
        *(LAS v2u*)(lds + SA_K + (kvh * 144 + j) * 144 + 8 * c4) = (v2u){cvtpk(kv[0], kv[1]), cvtpk(kv[2], kv[3])};
        const unsigned w0 = cvtpk(vv[0], vv[1]), w1 = cvtpk(vv[2], vv[3]);
        LAS unsigned short* vt = (LAS unsigned short*)(lds + SA_V) + (kvh * 64 + 4 * c4) * 168 + j;
        vt[0] = (unsigned short)(w0 & 0xffffu); vt[168] = (unsigned short)(w0 >> 16); vt[336] = (unsigned short)(w1 & 0xffffu); vt[504] = (unsigned short)(w1 >> 16); }
    if (tid < 64) { const int t = tid >> 4, kvh = (tid >> 3) & 1, ch = tid & 7;
        const v4u kv = *(const v4u*)(Kb + (size_t)(tok0 + t) * 128 + kvh * 64 + 8 * ch), vv = *(const v4u*)(Vb + (size_t)(tok0 + t) * 128 + kvh * 64 + 8 * ch);
        *(LAS v4u*)(lds + SA_K + (kvh * 144 + 128 + t) * 144 + 16 * ch) = kv;
        LAS unsigned short* vt = (LAS unsigned short*)(lds + SA_V) + (kvh * 64 + 8 * ch) * 168 + 128 + t;
        vt[0 * 168] = (unsigned short)(vv.x & 0xffffu); vt[1 * 168] = (unsigned short)(vv.x >> 16); vt[2 * 168] = (unsigned short)(vv.y & 0xffffu); vt[3 * 168] = (unsigned short)(vv.y >> 16);
        vt[4 * 168] = (unsigned short)(vv.z & 0xffffu); vt[5 * 168] = (unsigned short)(vv.z >> 16); vt[6 * 168] = (unsigned short)(vv.w & 0xffffu); vt[7 * 168] = (unsigned short)(vv.w >> 16); }
    __syncthreads();
    if (wid < 4) {
        const int fr = lane & 15, g = lane >> 4, kvh = wid >> 1, hh = 4 * wid + (fr >> 2), t = fr & 3;
        const bf16* qp = Qb + (size_t)(tok0 + t) * 1024 + hh * 64 + 8 * g;
        const bf16x8 q0 = *(const bf16x8*)qp, q1 = *(const bf16x8*)(qp + 32);
        f32x4 s[10];
#pragma unroll
        for (int f = 0; f < 9; ++f) { const LAS unsigned char* kp = lds + SA_K + (kvh * 144 + 16 * f + fr) * 144 + 16 * g;
            const bf16x8 k0 = *(const LAS bf16x8*)kp, k1 = *(const LAS bf16x8*)(kp + 64);
            s[f] = MFMA16(k0, q0, ((f32x4){0.f, 0.f, 0.f, 0.f})); s[f] = MFMA16(k1, q1, s[f]); }
        s[9] = (f32x4){0.f, 0.f, 0.f, 0.f};
        const float sk = sinks[hh] * LOG2E;
        float mx = -INFINITY;
#pragma unroll
        for (int f = 0; f < 9; ++f)
#pragma unroll
            for (int i = 0; i < 4; ++i) { const int j = 16 * f + 4 * g + i, dist = 128 + t - j; const bool valid = (dist >= 0) && (dist < 128);
                const float v = valid ? s[f][i] + tab[bkt[dist & 127] * 16 + hh] : -INFINITY; s[f][i] = v; mx = fmaxf(mx, v); }
        mx = fmaxf(mx, __shfl_xor(mx, 16)); mx = fmaxf(mx, __shfl_xor(mx, 32)); mx = fmaxf(mx, sk);
        float l = 0.f;
#pragma unroll
        for (int f = 0; f < 9; ++f)
#pragma unroll
            for (int i = 0; i < 4; ++i) { const float p = __builtin_amdgcn_exp2f(s[f][i] - mx); s[f][i] = p; l += p; }
        l += __shfl_xor(l, 16); l += __shfl_xor(l, 32); l += __builtin_amdgcn_exp2f(sk - mx);
        const float rl = 1.0f / l;
        f32x4 o[4];
#pragma unroll
        for (int df = 0; df < 4; ++df) o[df] = (f32x4){0.f, 0.f, 0.f, 0.f};
#pragma unroll
        for (int si = 0; si < 5; ++si) { const bf16x8 pb = pack8(s[2 * si], s[2 * si + 1]);
#pragma unroll
            for (int df = 0; df < 4; ++df) { const LAS unsigned char* vp = lds + SA_V + ((kvh * 64 + 16 * df + fr) * 168 + 32 * si + 4 * g) * 2;
                const v2u lo = *(const LAS v2u*)vp, hi = *(const LAS v2u*)(vp + 32);
                const bf16x8 va = __builtin_bit_cast(bf16x8, ((v4u){lo.x, lo.y, hi.x, hi.y}));
                o[df] = MFMA16(va, pb, o[df]); } }
        float ss = 0.f; bf16* op = MG + (size_t)(tok0 + t) * DM + hh * 64 + 4 * g;
#pragma unroll
        for (int df = 0; df < 4; ++df) { const f32x4 v = o[df] * rl; ss += (v[0] * v[0] + v[1] * v[1]) + (v[2] * v[2] + v[3] * v[3]);
            *(v2u*)(op + 16 * df) = (v2u){cvtpk(v[0], v[1]), cvtpk(v[2], v[3])}; }
        ss += __shfl_xor(ss, 16); ss += __shfl_xor(ss, 32);
        if (g == 0) ssqm[(size_t)(tok0 + t) * 24 + hh] = ss;
    }
}

constexpr int GM_W = 0, GM_V = 34816, GM_RED = 69632;
__device__ __forceinline__ void gmlp_prompt_unit(LAS unsigned char* lds, int b, int n, int h, const bf16* GU, const bf16* GV, const float* w_s, const float* b_s, const float* vgain,
                                                 bf16* MG, float* ssqm, int tid, int wid, int lane) {
    const int tok0 = b * 2048 + n * 128;
    __syncthreads();
#pragma unroll
    for (int ii = 0; ii < 8; ++ii) { const int idx = tid + 512 * ii, i = idx >> 5, j4 = idx & 31; f32x4 w = *(const f32x4*)(w_s + ((size_t)h * 128 + i) * 128 + 4 * j4);
#pragma unroll
        for (int e = 0; e < 4; ++e) if (4 * j4 + e > i) w[e] = 0.f;
        *(LAS v2u*)(lds + GM_W + i * 272 + 8 * j4) = (v2u){cvtpk(w[0], w[1]), cvtpk(w[2], w[3])}; }
    const int j = tid & 127, chq = tid >> 7;
    v4u vr[4]; float sq = 0.f;
#pragma unroll
    for (int ii = 0; ii < 4; ++ii) { const int ch = chq + 4 * ii; vr[ii] = *(const v4u*)(GV + (size_t)(tok0 + j) * 1024 + h * 128 + 8 * ch);
#pragma unroll
        for (int e = 0; e < 4; ++e) { const float a = bflo(vr[ii][e]), c = bfhi(vr[ii][e]); sq += a * a + c * c; } }
    ((LAS float*)(lds + GM_RED))[chq * 128 + j] = sq;
    __syncthreads();
    { const LAS float* red = (const LAS float*)(lds + GM_RED); const float tot = (red[j] + red[128 + j]) + (red[256 + j] + red[384 + j]);
      const float rstd = 1.0f / sqrtf(tot * (1.0f / 128.0f) + EPS);
      LAS unsigned short* vt = (LAS unsigned short*)(lds + GM_V);
#pragma unroll
      for (int ii = 0; ii < 4; ++ii) { const int ch = chq + 4 * ii; const f32x4 g0 = *(const f32x4*)(vgain + h * 128 + 8 * ch), g1 = *(const f32x4*)(vgain + h * 128 + 8 * ch + 4);
#pragma unroll
          for (int e = 0; e < 4; ++e) { const float ga = e < 2 ? g0[2 * e] : g1[2 * e - 4], gb = e < 2 ? g0[2 * e + 1] : g1[2 * e - 3];
              const unsigned w = cvtpk(bflo(vr[ii][e]) * rstd * ga, bfhi(vr[ii][e]) * rstd * gb);
              vt[(8 * ch + 2 * e) * 136 + j] = (unsigned short)(w & 0xffffu); vt[(8 * ch + 2 * e + 1) * 136 + j] = (unsigned short)(w >> 16); } } }
    __syncthreads();
    const int fr = lane & 15, g = lane >> 4, ns = (wid >> 1) + 1;
    f32x4 acc[8];
#pragma unroll
    for (int cf = 0; cf < 8; ++cf) acc[cf] = (f32x4){0.f, 0.f, 0.f, 0.f};
    for (int s = 0; s < ns; ++s) { const bf16x8 bw = *(const LAS bf16x8*)(lds + GM_W + (16 * wid + fr) * 272 + (32 * s + 8 * g) * 2);
#pragma unroll
        for (int cf = 0; cf < 8; ++cf) { const bf16x8 av = *(const LAS bf16x8*)(lds + GM_V + (16 * cf + fr) * 272 + (32 * s + 8 * g) * 2); acc[cf] = MFMA16(av, bw, acc[cf]); } }
    const int i = 16 * wid + fr, tok = tok0 + i; const float bs = b_s[h * 128 + i]; float ss = 0.f;
    const bf16* up = GU + (size_t)tok * 1024 + h * 128 + 4 * g; bf16* op = MG + (size_t)tok * DM + 1024 + h * 128 + 4 * g;
#pragma unroll
    for (int cf = 0; cf < 8; ++cf) { const v2u uu = *(const v2u*)(up + 16 * cf);
        f32x4 v; v[0] = bflo(uu.x) * (acc[cf][0] + bs); v[1] = bfhi(uu.x) * (acc[cf][1] + bs); v[2] = bflo(uu.y) * (acc[cf][2] + bs); v[3] = bfhi(uu.y) * (acc[cf][3] + bs);
        ss += (v[0] * v[0] + v[1] * v[1]) + (v[2] * v[2] + v[3] * v[3]);
        *(v2u*)(op + 16 * cf) = (v2u){cvtpk(v[0], v[1]), cvtpk(v[2], v[3])}; }
    ss += __shfl_xor(ss, 16); ss += __shfl_xor(ss, 32);
    if (g == 0) ssqm[(size_t)tok * 24 + 16 + h] = ss;
}

__device__ __forceinline__ void gmlp_sample_wave(int db, int h, const bf16* GU, const bf16* GV, const float* w_s, const float* b_s, const float* vgain, bf16* MG, float* ssqm, float* out, int lane) {
    const int tok0 = MP + db * 4, c = 2 * lane;
    const f32x2 gn = *(const f32x2*)(vgain + h * 128 + c);
    float vn[4][2];
#pragma unroll
    for (int t = 0; t < 4; ++t) { const unsigned w = *(const unsigned*)(GV + (size_t)(tok0 + t) * 1024 + h * 128 + c); const float a = bflo(w), b2 = bfhi(w);
        const float rstd = 1.0f / sqrtf(wave_sum(a * a + b2 * b2) * (1.0f / 128.0f) + EPS);
        vn[t][0] = a * rstd * gn[0]; vn[t][1] = b2 * rstd * gn[1];
        *(f32x2*)(out + pg8::OGV + ((size_t)(db * 4 + t) * 8 + h) * 128 + c) = (f32x2){vn[t][0], vn[t][1]}; }
#pragma unroll
    for (int i = 0; i < 4; ++i) { float m0 = b_s[h * 128 + i], m1 = m0;
#pragma unroll
        for (int jj = 0; jj <= i; ++jj) { const float w = w_s[((size_t)h * 128 + i) * 128 + jj]; m0 += w * vn[jj][0]; m1 += w * vn[jj][1]; }
        const unsigned uw = *(const unsigned*)(GU + (size_t)(tok0 + i) * 1024 + h * 128 + c);
        const float o0 = bflo(uw) * m0, o1 = bfhi(uw) * m1;
        *(unsigned*)(MG + (size_t)(tok0 + i) * DM + 1024 + h * 128 + c) = cvtpk(o0, o1);
        const float ss = wave_sum(o0 * o0 + o1 * o1);
        if (lane == 0) ssqm[(size_t)(tok0 + i) * 24 + 16 + h] = ss; }
}

__device__ __forceinline__ const float* in_ptr(LAS unsigned char* lds, int i) {
    const unsigned long long v = ((const LAS unsigned long long*)(lds + X_PTR))[i];
    const unsigned lo = __builtin_amdgcn_readfirstlane((unsigned)v), hi = __builtin_amdgcn_readfirstlane((unsigned)(v >> 32));
    return (const float*)(const GAS float*)(((unsigned long long)hi << 32) | lo);
}
struct Args { const float* in[23]; float* out; unsigned char* ws; int ph_lo, ph_hi; };
__global__ void __launch_bounds__(NWAVES * 64, 2) mk_fwd(Args args) {
    extern __shared__ __attribute__((aligned(16))) unsigned char lds_raw[];
    LAS unsigned char* lds = (LAS unsigned char*)lds_raw;
    const int tid = threadIdx.x, lane = tid & 63, wid = __builtin_amdgcn_readfirstlane(tid >> 6);
    const int G = gridDim.x, bx = blockIdx.x, vcu = (G % 8 == 0) ? (bx % 8) * (G / 8) + bx / 8 : bx;
    const int gw = vcu * NWAVES + wid, NGW = G * NWAVES;
    unsigned char* ws = args.ws;
    float* out = args.out;
    bf16* Win_t = (bf16*)(ws + WS_WIN); bf16* Wout_t = (bf16*)(ws + WS_WOUT); bf16* Wff1_t = (bf16*)(ws + WS_WFF1); bf16* Wff2_t = (bf16*)(ws + WS_WFF2);
    float* mod = (float*)(ws + WS_MOD); float* ssqm = (float*)(ws + WS_SSQM); float* ssqo = (float*)(ws + WS_SSQO); float* ssqf = (float*)(ws + WS_SSQF);
    bf16* H = (bf16*)(ws + WS_H); bf16* Qb = (bf16*)(ws + WS_Q); bf16* Kb = (bf16*)(ws + WS_K); bf16* Vb = (bf16*)(ws + WS_V); bf16* GU = (bf16*)(ws + WS_GU); bf16* GV = (bf16*)(ws + WS_GV);
    bf16* MG = (bf16*)(ws + WS_MG); float* Ob = (float*)(ws + WS_O); bf16* F1 = (bf16*)(ws + WS_F1); float* Fb = (float*)(ws + WS_F);

    for (int u = tid; u < (LDS_BYTES - X_MISC) / 4; u += NWAVES * 64) ((LAS unsigned*)(lds + X_MISC))[u] = 0u;
    if (tid < 128) { const int n = tid; int bk = n; if (n >= 16) { bk = 16 + (int)(logf((float)n / 16.0f) / 2.0794415416798357f * 16.0f); bk = bk < 31 ? bk : 31; } ((LAS int*)(lds + X_BKT))[tid] = bk; }
    ((LAS float*)(lds + X_TAB))[tid] = args.in[6][tid] * LOG2E;
    if (tid < 23) ((LAS unsigned long long*)(lds + X_PTR))[tid] = (unsigned long long)args.in[tid];
    __syncthreads();
#define INP(i) in_ptr(lds, (i))
#if !MK_CG_SYNC
    XcdBarrier bar = xcd_barrier_post((unsigned*)(ws + WS_CTL) + CW_BAR, (volatile LAS unsigned*)(lds + X_MISC));
#define GRID_BAR(seam) xcd_barrier(bar)
    if (args.ph_lo < 0) cg::this_grid().sync();
#else
#define GRID_BAR(seam) cg::this_grid().sync()
#endif
    const int lo = args.ph_lo, hi = args.ph_hi;
#ifndef PROBE_PHASE
#define PROBE_PHASE -1
#endif
#define PROBE_MULT 4
    unsigned long long pt0_ = 0, pdt_ = 0;
#define PSTART(k) do { if (PROBE_PHASE == (k) && bx == 0 && tid == 0) pt0_ = __builtin_amdgcn_s_memrealtime(); } while (0)
#define PEND(k) do { if (PROBE_PHASE == (k) && bx == 0 && tid == 0) pdt_ = __builtin_amdgcn_s_memrealtime() - pt0_; } while (0)
#ifndef PH_MASK
#define PH_MASK 0x1ff
#endif
#define IN(k) ((((PH_MASK) >> (k)) & 1) && lo <= (k) && (k) < hi)
#ifndef DUP_MASK
#define DUP_MASK 0
#endif
#define REP(k) for (int rep_ = 0; rep_ < 1 + (((DUP_MASK) >> (k)) & 1); ++rep_)
#define BOTH(k) (IN(k) && IN((k) + 1))

    PSTART(0);
    if (IN(0)) REP(0) {
        silu_publish(G, bx, tid, INP(4), INP(5), (bf16*)(ws + WS_S), (unsigned*)(ws + WS_CTL) + CW_SCNT);
        LAS float* scr = (LAS float*)(lds + wid * 16384);
        constexpr int I_IN = (DM / 64) * (INC / 32), I_OUT = (DM / 64) * (DM / 32), I_F1 = (DM / 64) * (DFF / 32), I_F2 = (DFF / 64) * (DM / 32);
        constexpr int NITEMS = I_IN + I_OUT + I_F1 + I_F2;
        for (int it = gw; it < NITEMS; it += NGW) {
            int r = it;
            if (r < I_IN) { p0_transpose_item(INP(10), DM, INC, Win_t, nullptr, scr, r, lane); continue; } r -= I_IN;
            if (r < I_OUT) { const int kb = r / (DM / 32); p0_transpose_item(INP(17), DM, DM, Wout_t, kb < 16 ? INP(15) : INP(16) - 1024, scr, r, lane); continue; } r -= I_OUT;
            if (r < I_F1) { p0_transpose_item(INP(20), DM, DFF, Wff1_t, nullptr, scr, r, lane); continue; } r -= I_F1;
            p0_transpose_item(INP(21), DFF, DM, Wff2_t, nullptr, scr, r, lane);
        }
        silu_wait(G, tid, (unsigned*)(ws + WS_CTL) + CW_SCNT);
        adaln_phase(lds, vcu, G, tid, wid, lane, (const bf16*)(ws + WS_S), INP(7), INP(8), mod);
        if (BOTH(0)) GRID_BAR(0);
    }
    PEND(0);
    PSTART(1);
    if (IN(1)) REP(1) { p1_rows(lds, vcu, G, gw, NGW, wid, lane, INP(0), INP(1), mod, INP(9), H); if (BOTH(1)) GRID_BAR(1); }
    PEND(1);
    PSTART(2);
    if (IN(2)) REP(2) {
        pg8::Gemm g{H, Win_t, M, INC, DM}; pg8::StaticOrder S; S.init(M, INC, DM, G, bx);
        pg8::EpiInProj E{Qb, Kb, Vb, GU, GV, out};
        pg8::gemm_phase<pg8::EpiInProj, pg8::StaticOrder, true, true>(lds, g, S, E);
        if (BOTH(2)) GRID_BAR(2);
    }
    PEND(2);
    PSTART(3);
    if (IN(3)) REP(3) {
        constexpr int N_AP = 1024, N_GP = 512, N_SA = 128, N_SG = 128;
        for (int r = vcu; r < N_AP; r += G) attn_prompt_unit(lds, r >> 8, (r >> 4) & 15, r & 15, Qb, Kb, Vb, MG, ssqm, INP(11), tid, wid, lane);
        for (int r = vcu; r < N_GP; r += G) gmlp_prompt_unit(lds, r >> 7, (r >> 3) & 15, r & 7, GU, GV, INP(13), INP(14), INP(12), MG, ssqm, tid, wid, lane);
        for (int r = vcu; r < N_SA; r += G) attn_sample_unit(lds, r, Qb, Kb, Vb, INP(2), INP(3), MG, ssqm, INP(11), tid, wid, lane);
        for (int r = (vcu + G - (G >> 1)) % G; r < N_SG; r += G) { const int wu = r * 8 + wid; gmlp_sample_wave(wu >> 3, wu & 7, GU, GV, INP(13), INP(14), INP(12), MG, ssqm, out, lane); }
        __syncthreads();
        if (BOTH(3)) GRID_BAR(3);
    }
    PEND(3);
    PSTART(4);
    if (IN(4)) REP(4) {
        pg8::Gemm g{MG, Wout_t, M, DM, DM}; pg8::SplitOrder S; S.init(DM, G, bx);
        pg8::EpiF32Ssq<true> E{Ob, ssqo, ssqm, (LAS float*)(lds + X_RATIO), (float*)(ws + WS_SLAB4)};
        pg8::gemm_phase<pg8::EpiF32Ssq<true>, pg8::SplitOrder, true, true>(lds, g, S, E);
        if (BOTH(4)) GRID_BAR(4);
    }
    PEND(4);
    PSTART(5);
    if (IN(5)) REP(5) { p5_rows(lds, vcu, G, gw, NGW, wid, lane, INP(0), INP(1), mod, Ob, ssqo, (const float*)(ws + WS_SLAB4), INP(18), INP(19), out, H); if (BOTH(5)) GRID_BAR(5); }
    PEND(5);
    PSTART(6);
    if (IN(6)) REP(6) {
        pg8::Gemm g{H, Wff1_t, M, DFF, DM}; pg8::StaticOrder S; S.init(M, DFF, DM, G, bx);
        pg8::EpiRelu2 E{F1, DFF};
        pg8::gemm_phase<pg8::EpiRelu2, pg8::StaticOrder, true, true>(lds, g, S, E);
        if (BOTH(6)) GRID_BAR(6);
    }
    PEND(6);
    PSTART(7);
    if (IN(7)) REP(7) {
        pg8::Gemm g{F1, Wff2_t, M, DM, DFF}; pg8::SplitOrder S; S.init(DFF, G, bx);
        pg8::EpiF32Ssq<false> E{Fb, ssqf, nullptr, (LAS float*)(lds + X_RATIO), (float*)(ws + WS_SLAB7)};
        pg8::gemm_phase<pg8::EpiF32Ssq<false>, pg8::SplitOrder, true, true>(lds, g, S, E);
        if (BOTH(7)) GRID_BAR(7);
    }
    PEND(7);
    PSTART(8);
    if (IN(8)) { p8_rows(lds, vcu, G, gw, NGW, wid, lane, mod, Fb, ssqf, (const float*)(ws + WS_SLAB7), INP(22), out); }
    PEND(8);
    if (PROBE_PHASE >= 0 && bx == 0 && tid == 0) { const unsigned long long te = __builtin_amdgcn_s_memrealtime(); while (__builtin_amdgcn_s_memrealtime() - te < PROBE_MULT * pdt_) __builtin_amdgcn_s_sleep(8); }
#undef IN
#undef BOTH
}

extern "C" void kernel_launch(void* const* d_in, const int* in_sizes, int n_in, void* d_out, int out_size, void* d_ws, size_t ws_size, hipStream_t stream) {
    static int grid = 0;
    if (grid == 0) {
        if (n_in != 23 || out_size != pg8::OUT_TOTAL || ws_size < WS_END) { fprintf(stderr, "kernel_launch: unexpected shapes: n_in %d out %d ws %zu (need >= %zu)\n", n_in, out_size, ws_size, (size_t)WS_END); grid = -1; return; }
        int dev = 0, cus = 0, per_cu = 0;
        if (hipGetDevice(&dev) != hipSuccess || hipDeviceGetAttribute(&cus, hipDeviceAttributeMultiprocessorCount, dev) != hipSuccess) { grid = -1; return; }
        if (hipFuncSetAttribute((const void*)mk_fwd, hipFuncAttributeMaxDynamicSharedMemorySize, LDS_BYTES) != hipSuccess) { fprintf(stderr, "kernel_launch: hipFuncSetAttribute failed\n"); grid = -1; return; }
        if (hipOccupancyMaxActiveBlocksPerMultiprocessor(&per_cu, (const void*)mk_fwd, NWAVES * 64, LDS_BYTES) != hipSuccess || per_cu < 1) { fprintf(stderr, "kernel_launch: occupancy query says %d\n", per_cu); (void)hipGetLastError(); grid = -1; return; }
        grid = cus;
    }
    if (grid < 0) return;
    (void)hipMemsetAsync((char*)d_ws + WS_CTL, 0, CTL_ZERO_BYTES, stream);
    Args a{};
    for (int i = 0; i < 23; ++i) a.in[i] = (const float*)d_in[i];
    a.out = (float*)d_out; a.ws = (unsigned char*)d_ws;
    if (N_LAUNCHES == 1) {
        a.ph_lo = 0; a.ph_hi = N_PHASES;
        void* kargs[] = {&a};
        hipError_t e = hipLaunchCooperativeKernel((const void*)mk_fwd, dim3(grid), dim3(NWAVES * 64), kargs, LDS_BYTES, stream);
        if (e != hipSuccess) fprintf(stderr, "kernel_launch: cooperative launch failed: %s (grid %d)\n", hipGetErrorString(e), grid);
    } else {
        for (int p = 0; p < N_PHASES; ++p) { a.ph_lo = p; a.ph_hi = p + 1;
            hipLaunchKernelGGL(mk_fwd, dim3(grid), dim3(NWAVES * 64), LDS_BYTES, stream, a); }
    }
}
```

```cpp
#include <hip/hip_runtime.h>
#include <hip/hip_cooperative_groups.h>
#include <cstdio>
#include <cstdint>
#include <cmath>
namespace cg = cooperative_groups;

#ifndef MK_N_LAUNCHES
#define MK_N_LAUNCHES 1
#endif
#ifndef MK_CG_SYNC
#define MK_CG_SYNC 0
#endif

namespace pg8 {
#define PG8_LAS __attribute__((address_space(3)))
typedef unsigned short bf16_t;
typedef short bf16x8 __attribute__((ext_vector_type(8)));
typedef float f32x4 __attribute__((ext_vector_type(4)));
typedef unsigned u32x4 __attribute__((ext_vector_type(4)));
typedef unsigned u32x2 __attribute__((ext_vector_type(2)));
constexpr int BM = 256, BK = 64, HALF = 128, HTB = HALF * BK * 2, STAGE_BYTES = 8 * HTB, NXCD = 8, WGM = 8;

__host__ __device__ __forceinline__ int lds_byte(int r, int c) { const int st = (r >> 4) * 2 + (c >> 5), rr = r & 15, cc = c & 31, ob = rr * 64 + cc * 2; return st * 1024 + (ob ^ (((ob >> 9) & 1) << 5)); }
__host__ __device__ __forceinline__ void stage_rc(int b, int& R, int& C) { const int st = b / 1024, sb = b % 1024, swz = sb ^ (((sb >> 9) & 1) << 5); R = (st >> 1) * 16 + swz / 64; C = (st & 1) * 32 + (swz % 64) / 2; }
__host__ __device__ __forceinline__ int perm32(int rho) { const int n = rho >> 4, i = rho & 15; return 8 * (i >> 2) + 4 * n + (i & 3); }

struct Unit { int pm, pn, kt0, nkt, slice; };
struct Gemm { const bf16_t* A; const bf16_t* Bt; int M, N, K; };

struct StaticOrder {
    int nM, nN, nwg, G, c, ntf;
    __host__ __device__ __forceinline__ void init(int M, int N, int K, int G_, int c_) { nM = M / BM; nN = N / BM; nwg = nM * nN; G = G_; c = c_; ntf = K / BK; }
    __host__ __device__ __forceinline__ void unit_of(int L, Unit& u) const {
        int wgid = L; { const int q = nwg / NXCD, r = nwg % NXCD, xcd = wgid % NXCD, off = wgid / NXCD; wgid = (xcd < r ? xcd * (q + 1) : r * (q + 1) + (xcd - r) * q) + off; }
        const int nig = WGM * nN, gid = wgid / nig, fm = gid * WGM, gsz = (nM - fm) < WGM ? (nM - fm) : WGM;
        u.pm = fm + ((wgid % nig) % gsz); u.pn = (wgid % nig) / gsz; u.kt0 = 0; u.nkt = ntf; u.slice = -1;
    }
    __host__ __device__ __forceinline__ bool next(int i, Unit& u) const { const long L = (long)i * G + c; if (L >= nwg) return false; unit_of((int)L, u); return true; }
    __device__ __forceinline__ void a_ready(const Unit&) const {}
    __device__ __forceinline__ void done(const Unit&) const {}
};
constexpr int NSL = 16;
struct SplitOrder {
    StaticOrder full; int G, c, ntf;
    __host__ __device__ __forceinline__ void init(int K, int G_, int c_) { full.init(8192, 2048, K, G_, c_); G = G_; c = c_; ntf = K / BK; }
    __host__ __device__ __forceinline__ bool next(int i, Unit& u) const {
        const long L = (long)i * G + c; if (L >= 512) return false;
        const bool isfull = L < 256;
        Unit f; full.unit_of(isfull ? (int)L : 0, f);
        const int j = (int)L - 256, tile = j / NSL, sl = j % NSL, nsk = ntf / NSL;
        u.pm = isfull ? f.pm : 32 + (tile >> 3); u.pn = isfull ? f.pn : (tile & 7); u.nkt = isfull ? ntf : nsk; u.kt0 = isfull ? 0 : sl * nsk; u.slice = isfull ? -1 : sl; return true;
    }
    __device__ __forceinline__ void a_ready(const Unit&) const {}
    __device__ __forceinline__ void done(const Unit&) const {}
};

__device__ __forceinline__ unsigned cvt_pk_bf16(float lo, float hi) { unsigned r; asm volatile("v_cvt_pk_bf16_f32 %0, %1, %2" : "=v"(r) : "v"(lo), "v"(hi)); return r; }

__device__ __forceinline__ float gelu_tanh(float x) {
    const float u = x * (0.7978845608028654f + 0.035677408136300125f * x * x);
    const float e = __builtin_amdgcn_exp2f(-2.885390081777927f * u);
    return x * __builtin_amdgcn_rcpf(1.0f + e);
}

constexpr int OY = 0, OKP = 17825792, OVP = 17891328, OKS = 17956864, OVS = 18022400, OGV = 18087936, OUT_TOTAL = 18612224;
constexpr float QSCALE = 0.125f * 1.4426950408889634f;

struct EpiInProj {
    static constexpr bool PERM = true, AFTER_DRAIN = false, MID = false;
    bf16_t *Q, *Kb, *Vb, *GU, *GV; float* out;
    __device__ __forceinline__ void unit_start(const Unit&, int, int) const {}
    __device__ __forceinline__ void mid(f32x4 (&)[2][2][4][2], int, int, int) const {}
    __device__ __forceinline__ void operator()(const f32x4 (&acc)[2][2][4][2], const Unit& u, int wr, int wc, int fr, int fq, int) const {
        const int row0 = u.pm * BM + wr * 64 + fr, cl = wc * 32 + 8 * fq;
        if (u.pn < 4) {
#pragma unroll
            for (int ai = 0; ai < 2; ++ai)
#pragma unroll
                for (int m = 0; m < 4; ++m) { bf16_t* rowp = Q + (size_t)(row0 + ai * HALF + m * 16) * 1024 + u.pn * 256 + cl;
#pragma unroll
                    for (int bj = 0; bj < 2; ++bj) { const f32x4 v0 = acc[ai][bj][m][0] * QSCALE, v1 = acc[ai][bj][m][1] * QSCALE;
                        u32x4 w; w.x = cvt_pk_bf16(v0[0], v0[1]); w.y = cvt_pk_bf16(v0[2], v0[3]); w.z = cvt_pk_bf16(v1[0], v1[1]); w.w = cvt_pk_bf16(v1[2], v1[3]);
                        *(u32x4*)(rowp + bj * HALF) = w; } }
        } else if (u.pn == 4) {
#pragma unroll
            for (int ai = 0; ai < 2; ++ai)
#pragma unroll
                for (int m = 0; m < 4; ++m) { const int row = row0 + ai * HALF + m * 16;
#pragma unroll
                    for (int bj = 0; bj < 2; ++bj) { const f32x4 v0 = acc[ai][bj][m][0], v1 = acc[ai][bj][m][1];
                        u32x4 w; w.x = cvt_pk_bf16(v0[0], v0[1]); w.y = cvt_pk_bf16(v0[2], v0[3]); w.z = cvt_pk_bf16(v1[0], v1[1]); w.w = cvt_pk_bf16(v1[2], v1[3]);
                        bf16_t* base = bj == 0 ? Kb : Vb;
                        *(u32x4*)(base + (size_t)row * 128 + cl) = w;
                        float* o = nullptr;
                        if (row < 8192) { const int t = row & 2047; if (t >= 1920) o = out + (bj == 0 ? OKP : OVP) + ((row >> 11) * 128 + (t - 1920)) * 128 + cl; }
                        else o = out + (bj == 0 ? OKS : OVS) + (row - 8192) * 128 + cl;
                        if (o) { *(f32x4*)o = v0; *(f32x4*)(o + 4) = v1; } } }
        } else {
            bf16_t* base = u.pn < 9 ? GU : GV; const int coff = (u.pn < 9 ? u.pn - 5 : u.pn - 9) * 256 + cl;
#pragma unroll
            for (int ai = 0; ai < 2; ++ai)
#pragma unroll
                for (int m = 0; m < 4; ++m) { bf16_t* rowp = base + (size_t)(row0 + ai * HALF + m * 16) * 1024 + coff;
#pragma unroll
                    for (int bj = 0; bj < 2; ++bj) { const f32x4 v0 = acc[ai][bj][m][0], v1 = acc[ai][bj][m][1];
                        u32x4 w; w.x = cvt_pk_bf16(gelu_tanh(v0[0]), gelu_tanh(v0[1])); w.y = cvt_pk_bf16(gelu_tanh(v0[2]), gelu_tanh(v0[3]));
                        w.z = cvt_pk_bf16(gelu_tanh(v1[0]), gelu_tanh(v1[1])); w.w = cvt_pk_bf16(gelu_tanh(v1[2]), gelu_tanh(v1[3]));
                        *(u32x4*)(rowp + bj * HALF) = w; } }
        }
    }
};

struct EpiRelu2 {
    static constexpr bool PERM = true, AFTER_DRAIN = false, MID = false;
    bf16_t* O; int ldc;
    __device__ __forceinline__ void unit_start(const Unit&, int, int) const {}
    __device__ __forceinline__ void mid(f32x4 (&)[2][2][4][2], int, int, int) const {}
    __device__ __forceinline__ void operator()(const f32x4 (&acc)[2][2][4][2], const Unit& u, int wr, int wc, int fr, int fq, int) const {
        const int row0 = u.pm * BM + wr * 64 + fr, col0 = u.pn * BM + wc * 32 + 8 * fq;
#pragma unroll
        for (int ai = 0; ai < 2; ++ai)
#pragma unroll
            for (int m = 0; m < 4; ++m) { bf16_t* rowp = O + (size_t)(row0 + ai * HALF + m * 16) * ldc + col0;
#pragma unroll
                for (int bj = 0; bj < 2; ++bj) { f32x4 v0 = acc[ai][bj][m][0], v1 = acc[ai][bj][m][1];
#pragma unroll
                    for (int e = 0; e < 4; ++e) { const float a = fmaxf(v0[e], 0.f), b = fmaxf(v1[e], 0.f); v0[e] = a * a; v1[e] = b * b; }
                    u32x4 w; w.x = cvt_pk_bf16(v0[0], v0[1]); w.y = cvt_pk_bf16(v0[2], v0[3]); w.z = cvt_pk_bf16(v1[0], v1[1]); w.w = cvt_pk_bf16(v1[2], v1[3]);
                    *(u32x4*)(rowp + bj * HALF) = w; } }
    }
};

template <bool SCALE> struct EpiF32Ssq {
    static constexpr bool PERM = false, AFTER_DRAIN = false, MID = SCALE;
    float* O; float* ssq; const float* ssqm; PG8_LAS float* xr;
    float* slab;
    __device__ __forceinline__ void unit_start(const Unit& u, int ui, int tid) const {
        if (SCALE) { if (tid < 256) { const float* p = ssqm + (size_t)(u.pm * BM + tid) * 24; float sa = 0.f, sg = 0.f;
#pragma unroll
                for (int i = 0; i < 4; ++i) { const f32x4 v = *(const f32x4*)(p + 4 * i); sa += (v[0] + v[1]) + (v[2] + v[3]); }
#pragma unroll
                for (int i = 4; i < 6; ++i) { const f32x4 v = *(const f32x4*)(p + 4 * i); sg += (v[0] + v[1]) + (v[2] + v[3]); }
                const float ra = 1.0f / sqrtf(sa * (1.0f / 1024.0f) + 1e-6f), rg = 1.0f / sqrtf(sg * (1.0f / 1024.0f) + 1e-6f);
                xr[(ui & 1) * 512 + tid] = ra / rg; xr[(ui & 1) * 512 + 256 + tid] = (u.slice >= 0 && u.slice < NSL / 2) ? ra : rg; } }
    }
    __device__ __forceinline__ void mid(f32x4 (&acc)[2][2][4][2], int ui, int wr, int fr) const {
        if (SCALE) {
#pragma unroll
            for (int ai = 0; ai < 2; ++ai)
#pragma unroll
                for (int m = 0; m < 4; ++m) { const float r = xr[(ui & 1) * 512 + ai * HALF + wr * 64 + m * 16 + fr];
#pragma unroll
                    for (int bj = 0; bj < 2; ++bj)
#pragma unroll
                        for (int n = 0; n < 2; ++n) acc[ai][bj][m][n] = acc[ai][bj][m][n] * r; } }
    }
    __device__ __forceinline__ void operator()(const f32x4 (&acc)[2][2][4][2], const Unit& u, int wr, int wc, int fr, int fq, int ui) const {
        const int col0 = u.pn * BM + wc * 32 + 4 * fq;
        const bool part = u.slice >= 0;
        float* base = (part ? slab + ((size_t)u.slice * 512 + (size_t)(u.pm - 32) * BM) * 2048 : O + (size_t)u.pm * BM * 2048) + (size_t)(wr * 64 + fr) * 2048 + col0;
        float* sq = ssq + (size_t)(u.pm * BM + wr * 64 + fr) * 32 + u.pn * 4 + wc;
#pragma unroll
        for (int ai = 0; ai < 2; ++ai)
#pragma unroll
            for (int m = 0; m < 4; ++m) { const int rl = ai * HALF + wr * 64 + m * 16 + fr;
                const float rg = SCALE ? xr[(ui & 1) * 512 + 256 + rl] : 1.0f; float s = 0.f;
#pragma unroll
                for (int bj = 0; bj < 2; ++bj)
#pragma unroll
                    for (int n = 0; n < 2; ++n) { const f32x4 v = acc[ai][bj][m][n] * rg; s += (v[0] * v[0] + v[1] * v[1]) + (v[2] * v[2] + v[3] * v[3]);
                        *(f32x4*)(base + (size_t)(ai * HALF + m * 16) * 2048 + bj * HALF + n * 16) = v; }
                s += __shfl_xor(s, 16); s += __shfl_xor(s, 32);
                if (!part && fq == 0) sq[(ai * HALF + m * 16) * 32] = s; }
    }
};

template <class Epi, class Sched, bool ALIGN_EPI = false, bool SP2 = false>
__device__ __forceinline__ void gemm_phase(PG8_LAS unsigned char* lds, const Gemm g, const Sched& S, const Epi& E) {
    const int tid = threadIdx.x, wid = __builtin_amdgcn_readfirstlane(tid >> 6), lane = tid & 63, wr = wid >> 2, wc = wid & 3, fr = lane & 15, fq = lane >> 4;
    const int K = g.K;
    unsigned voffA[2], voffB[2];
#pragma unroll
    for (int i = 0; i < 2; ++i) { int R, C; stage_rc(tid * 16 + i * 8192, R, C); const int Rb = Epi::PERM ? ((R & ~31) + perm32(R & 31)) : R;
        voffA[i] = (unsigned)(R * K + C) * 2u; voffB[i] = (unsigned)(Rb * K + C) * 2u; }
    const size_t kstep = (size_t)(BK * 2);
    const size_t hstep = (size_t)HALF * K * 2;
    const size_t tstep = 2 * hstep;
    const unsigned ldsw = (unsigned)wid * 1024u;
    const int aoff = lds_byte(wr * 64 + fr, fq * 8), boff = lds_byte(wc * 32 + fr, fq * 8);
#define PG8_SA(b, h) (((b) * 2 + (h)) * HTB)
#define PG8_SB(b, h) ((4 + (b) * 2 + (h)) * HTB)
#define PG8_STAGE(bufoff, gbase, voff) do { _Pragma("unroll") for (int _i = 0; _i < 2; ++_i) \
        __builtin_amdgcn_global_load_lds((const unsigned*)((const char*)(gbase) + (voff)[_i]), (PG8_LAS unsigned*)(lds + (bufoff) + ldsw + _i * 8192), 16, 0, 0); } while (0)
#define PG8_LDA(dst, b, h) do { _Pragma("unroll") for (int m = 0; m < 4; ++m) _Pragma("unroll") for (int k = 0; k < 2; ++k) dst[m][k] = *(const PG8_LAS bf16x8*)(lds + PG8_SA(b, h) + aoff + m * 2048 + k * 1024); } while (0)
#define PG8_LDB(dst, b, h) do { _Pragma("unroll") for (int n = 0; n < 2; ++n) _Pragma("unroll") for (int k = 0; k < 2; ++k) dst[n][k] = *(const PG8_LAS bf16x8*)(lds + PG8_SB(b, h) + boff + n * 2048 + k * 1024); } while (0)
#define PG8_MMA(ai, bj, At, Bt) do { __builtin_amdgcn_s_setprio(1); _Pragma("unroll") for (int m = 0; m < 4; ++m) _Pragma("unroll") for (int n = 0; n < 2; ++n) _Pragma("unroll") for (int k = 0; k < 2; ++k) \
        acc[ai][bj][m][n] = __builtin_amdgcn_mfma_f32_16x16x32_bf16(Bt[n][k], At[m][k], acc[ai][bj][m][n], 0, 0, 0); __builtin_amdgcn_s_setprio(0); } while (0)
#define PG8_WAIT_V(n) asm volatile("s_waitcnt vmcnt(" #n ")" ::: "memory")
#define PG8_WAIT_L(n) asm volatile("s_waitcnt lgkmcnt(" #n ")" ::: "memory")
#define PG8_BAR __builtin_amdgcn_s_barrier()
#define PG8_SCHED __builtin_amdgcn_sched_barrier(0)
    Unit cur, nxt; int ui = 0;
    if (!S.next(0, cur)) return;
    f32x4 acc[2][2][4][2];
#pragma unroll
    for (int a = 0; a < 2; ++a)
#pragma unroll
        for (int b = 0; b < 2; ++b)
#pragma unroll
            for (int m = 0; m < 4; ++m)
#pragma unroll
                for (int n = 0; n < 2; ++n) acc[a][b][m][n] = (f32x4){0.f, 0.f, 0.f, 0.f};
    bf16x8 At[4][2], B0[2][2], B1[2][2];
    const char* cA = (const char*)g.A + (size_t)cur.pm * tstep + (size_t)cur.kt0 * kstep; const char* cB = (const char*)g.Bt + (size_t)cur.pn * tstep + (size_t)cur.kt0 * kstep;
    S.a_ready(cur);
    if constexpr (SP2) {
        PG8_STAGE(PG8_SB(0, 0), cB, voffB); PG8_STAGE(PG8_SB(0, 1), cB + hstep, voffB); PG8_STAGE(PG8_SA(0, 0), cA, voffA); PG8_STAGE(PG8_SA(0, 1), cA + hstep, voffA);
        if (wr == 1) PG8_BAR;
        PG8_WAIT_V(2); PG8_BAR;
        PG8_STAGE(PG8_SB(1, 0), cB + kstep, voffB); PG8_STAGE(PG8_SA(1, 0), cA + kstep, voffA); PG8_STAGE(PG8_SB(1, 1), cB + hstep + kstep, voffB);
        PG8_WAIT_V(6); PG8_BAR;
    } else {
        PG8_STAGE(PG8_SB(0, 0), cB, voffB); PG8_STAGE(PG8_SA(0, 0), cA, voffA); PG8_STAGE(PG8_SB(0, 1), cB + hstep, voffB); PG8_STAGE(PG8_SA(0, 1), cA + hstep, voffA);
        if (wr == 1) PG8_BAR;
        PG8_WAIT_V(4); PG8_BAR;
        PG8_STAGE(PG8_SB(1, 0), cB + kstep, voffB); PG8_STAGE(PG8_SA(1, 0), cA + kstep, voffA); PG8_STAGE(PG8_SB(1, 1), cB + hstep + kstep, voffB);
        PG8_WAIT_V(6); PG8_BAR;
    }
    for (;;) {
        const bool has_next = S.next(ui + 1, nxt);
        const char* nA = has_next ? (const char*)g.A + (size_t)nxt.pm * tstep + (size_t)nxt.kt0 * kstep : cA; const char* nB = has_next ? (const char*)g.Bt + (size_t)nxt.pn * tstep + (size_t)nxt.kt0 * kstep : cB;
        const int nt = cur.nkt;
        if constexpr (Epi::MID) E.unit_start(cur, ui, tid);
        for (int t = 0; t < nt; t += 2) {
            const bool last = (t == nt - 2);
            const char* a1 = cA + (size_t)(t + 1) * kstep;
            const char* a2 = last ? nA : cA + (size_t)(t + 2) * kstep; const char* b2 = last ? nB : cB + (size_t)(t + 2) * kstep;
            const char* a3 = a2 + kstep; const char* b3 = b2 + kstep;
            if (last && has_next) S.a_ready(nxt);
            if constexpr (Epi::MID) { if (cur.slice < 0 && t == (nt >> 1)) E.mid(acc, ui, wr, fr); }
            if constexpr (SP2) {
            PG8_LDB(B0, 0, 0); PG8_LDB(B1, 0, 1); PG8_SCHED; PG8_LDA(At, 0, 0); PG8_STAGE(PG8_SA(1, 1), a1 + hstep, voffA);
            PG8_WAIT_V(8); PG8_WAIT_L(0); PG8_BAR; PG8_MMA(0, 0, At, B0); PG8_MMA(0, 1, At, B1); PG8_BAR; PG8_SCHED;
            PG8_LDA(At, 0, 1); PG8_STAGE(PG8_SB(0, 0), b2, voffB); PG8_STAGE(PG8_SB(0, 1), b2 + hstep, voffB); PG8_STAGE(PG8_SA(0, 0), a2, voffA);
            PG8_WAIT_V(8); PG8_WAIT_L(0); PG8_BAR; PG8_MMA(1, 0, At, B0); PG8_MMA(1, 1, At, B1); PG8_BAR; PG8_SCHED;
            PG8_LDB(B0, 1, 0); PG8_LDB(B1, 1, 1); PG8_SCHED; PG8_LDA(At, 1, 0); PG8_STAGE(PG8_SA(0, 1), a2 + hstep, voffA);
            PG8_WAIT_V(8); PG8_WAIT_L(0); PG8_BAR; PG8_MMA(0, 0, At, B0); PG8_MMA(0, 1, At, B1); PG8_BAR; PG8_SCHED;
            PG8_LDA(At, 1, 1); PG8_STAGE(PG8_SB(1, 0), b3, voffB); PG8_STAGE(PG8_SB(1, 1), b3 + hstep, voffB); PG8_STAGE(PG8_SA(1, 0), a3, voffA);
            PG8_WAIT_V(8); PG8_WAIT_L(0); PG8_BAR; PG8_MMA(1, 0, At, B0); PG8_MMA(1, 1, At, B1); PG8_BAR; PG8_SCHED;
            } else {
            PG8_LDB(B0, 0, 0); PG8_SCHED; PG8_LDA(At, 0, 0); PG8_STAGE(PG8_SA(1, 1), a1 + hstep, voffA);
            PG8_WAIT_L(8); PG8_BAR; PG8_WAIT_L(0); PG8_MMA(0, 0, At, B0); PG8_BAR; PG8_SCHED;
            PG8_LDB(B1, 0, 1); PG8_STAGE(PG8_SB(0, 0), b2, voffB);
            PG8_BAR; PG8_WAIT_L(0); PG8_MMA(0, 1, At, B1); PG8_BAR;
            PG8_LDA(At, 0, 1); PG8_STAGE(PG8_SA(0, 0), a2, voffA);
            PG8_BAR; PG8_WAIT_L(0); PG8_MMA(1, 0, At, B0); PG8_BAR; PG8_SCHED;
            PG8_STAGE(PG8_SB(0, 1), b2 + hstep, voffB);
            PG8_WAIT_V(6); PG8_BAR; PG8_MMA(1, 1, At, B1); PG8_BAR;
            PG8_LDB(B0, 1, 0); PG8_SCHED; PG8_LDA(At, 1, 0); PG8_STAGE(PG8_SA(0, 1), a2 + hstep, voffA);
            PG8_WAIT_L(8); PG8_BAR; PG8_WAIT_L(0); PG8_MMA(0, 0, At, B0); PG8_BAR; PG8_SCHED;
            PG8_LDB(B1, 1, 1); PG8_STAGE(PG8_SB(1, 0), b3, voffB);
            PG8_BAR; PG8_WAIT_L(0); PG8_MMA(0, 1, At, B1); PG8_BAR;
            PG8_LDA(At, 1, 1); PG8_STAGE(PG8_SA(1, 0), a3, voffA);
            PG8_BAR; PG8_WAIT_L(0); PG8_MMA(1, 0, At, B0); PG8_BAR; PG8_SCHED;
            PG8_STAGE(PG8_SB(1, 1), b3 + hstep, voffB);
            PG8_WAIT_V(6); PG8_BAR; PG8_MMA(1, 1, At, B1); PG8_BAR;
            }
        }
        if constexpr (ALIGN_EPI) { if (wr == 0) PG8_BAR; }
        if constexpr (!Epi::AFTER_DRAIN) { E(acc, cur, wr, wc, fr, fq, ui); S.done(cur); }
        if (!has_next) break;
#pragma unroll
        for (int a = 0; a < 2; ++a)
#pragma unroll
            for (int b = 0; b < 2; ++b)
#pragma unroll
                for (int m = 0; m < 4; ++m)
#pragma unroll
                    for (int n = 0; n < 2; ++n) acc[a][b][m][n] = (f32x4){0.f, 0.f, 0.f, 0.f};
        cur = nxt; cA = nA; cB = nB; ++ui;
        if constexpr (ALIGN_EPI) { if (wr == 1) PG8_BAR; }
    }
    PG8_WAIT_V(0);
    if constexpr (!ALIGN_EPI) { if (wr == 0) PG8_BAR; }
    PG8_BAR;
#undef PG8_SA
#undef PG8_SB
#undef PG8_STAGE
#undef PG8_LDA
#undef PG8_LDB
#undef PG8_MMA
#undef PG8_WAIT_V
#undef PG8_WAIT_L
#undef PG8_BAR
#undef PG8_SCHED
}
}

constexpr int NWAVES = 8;
constexpr int DM = 2048, MP = 8192, MS = 512, M = MP + MS, INC = 3328, DFF = 8192, NMOD = 12288;
constexpr float EPS = 1e-6f, LOG2E = 1.4426950408889634f;
constexpr int N_PHASES = 9;
constexpr int N_LAUNCHES = MK_N_LAUNCHES;

constexpr size_t MiB = 1u << 20;
constexpr size_t WS_CTL = 0, CTL_ZERO_BYTES = 32768;
constexpr size_t WS_WIN = 2 * MiB, WS_WOUT = 16 * MiB, WS_WFF1 = 24 * MiB, WS_WFF2 = 90 * MiB;
constexpr size_t WS_H = 56 * MiB;
constexpr size_t WS_MOD = 122 * MiB;
constexpr size_t WS_SSQM = 129 * MiB, WS_SSQO = 130 * MiB, WS_SSQF = 132 * MiB;
constexpr size_t WS_Q = 134 * MiB, WS_K = 151 * MiB, WS_V = 154 * MiB, WS_GU = 157 * MiB, WS_GV = 174 * MiB;
constexpr size_t WS_MG = 202 * MiB;
constexpr size_t WS_O = 134 * MiB;
constexpr size_t WS_F1 = 134 * MiB;
constexpr size_t WS_F = 270 * MiB;
constexpr size_t WS_SLAB4 = 270 * MiB;
constexpr size_t WS_SLAB7 = 2 * MiB;
constexpr size_t WS_END = 338 * MiB;
constexpr size_t SLAB_BYTES = (size_t)16 * 512 * 2048 * 4;
static_assert(WS_SSQM + (size_t)M * 24 * 4 <= WS_SSQO && WS_SSQO + (size_t)M * 32 * 4 <= WS_SSQF && WS_SSQF + (size_t)M * 32 * 4 <= WS_Q, "partials");
static_assert(WS_MOD + (size_t)132 * NMOD * 4 <= WS_SSQM && WS_H + (size_t)M * DM * 2 <= WS_WFF2 && WS_Q + (size_t)M * 1024 * 2 <= WS_K && WS_K + (size_t)M * 128 * 2 <= WS_V &&
              WS_V + (size_t)M * 128 * 2 <= WS_GU && WS_GU + (size_t)M * 1024 * 2 <= WS_GV && WS_GV + (size_t)M * 1024 * 2 <= WS_MG && WS_O + (size_t)M * DM * 4 <= WS_MG &&
              WS_MG + (size_t)M * DM * 2 <= WS_F && WS_F1 + (size_t)M * DFF * 2 <= WS_F && WS_F + (size_t)M * DM * 4 <= WS_END && WS_SLAB4 + SLAB_BYTES <= WS_END &&
              WS_SLAB7 + SLAB_BYTES <= WS_WFF2, "d_ws map");
static_assert(WS_WIN + (size_t)INC * DM * 2 <= WS_WOUT && WS_WOUT + (size_t)DM * DM * 2 <= WS_WFF1 && WS_WFF1 + (size_t)DFF * DM * 2 <= WS_H && WS_WFF2 + (size_t)DFF * DM * 2 <= WS_MOD, "weights");
constexpr int CW_BAR = 4096, CW_SCNT = 64;
constexpr size_t WS_S = 1 * MiB;

constexpr int RING_BYTES = 131072;
constexpr int X_RATIO = 131072;
constexpr int X_BKT = X_RATIO + 4096;
constexpr int X_TAB = X_BKT + 512;
constexpr int X_PTR = X_TAB + 2048;
constexpr int X_MISC = 139264;
constexpr int LDS_BYTES = 147456;

#define GAS __attribute__((address_space(1)))
#define LAS __attribute__((address_space(3)))
typedef unsigned short bf16;
typedef unsigned v4u __attribute__((ext_vector_type(4)));
typedef unsigned v2u __attribute__((ext_vector_type(2)));
typedef float f32x4 __attribute__((ext_vector_type(4)));
typedef float f32x2 __attribute__((ext_vector_type(2)));
typedef short bf16x8 __attribute__((ext_vector_type(8)));
typedef GAS unsigned gu32;
#define RLX_AGENT __ATOMIC_RELAXED, __HIP_MEMORY_SCOPE_AGENT
#define LDS_WAIT() asm volatile("s_waitcnt lgkmcnt(0)" ::: "memory")
#define VM_WAIT() asm volatile("s_waitcnt vmcnt(0)" ::: "memory")

__device__ __forceinline__ unsigned cvtpk(float lo, float hi) { return pg8::cvt_pk_bf16(lo, hi); }
__device__ __forceinline__ float bf2f(unsigned b) { return __uint_as_float(b << 16); }
__device__ __forceinline__ float bflo(unsigned w) { return __uint_as_float(w << 16); }
__device__ __forceinline__ float bfhi(unsigned w) { return __uint_as_float(w & 0xffff0000u); }
__device__ __forceinline__ bf16x8 pack8(f32x4 a, f32x4 b) { v4u w; w.x = cvtpk(a[0], a[1]); w.y = cvtpk(a[2], a[3]); w.z = cvtpk(b[0], b[1]); w.w = cvtpk(b[2], b[3]); return __builtin_bit_cast(bf16x8, w); }
__device__ __forceinline__ float wave_sum(float v) {
#pragma unroll
    for (int o = 1; o < 64; o <<= 1) v += __shfl_xor(v, o);
    return v;
}
__device__ __forceinline__ float silu_f(float x) { return x * __builtin_amdgcn_rcpf(1.0f + __builtin_amdgcn_exp2f(-LOG2E * x)); }
#define MFMA16(a, b, c) __builtin_amdgcn_mfma_f32_16x16x32_bf16((a), (b), (c), 0, 0, 0)

#define XB_TMO      128
#define XB_XCNT(j)  (256  + 64 * (j))
#define XB_XSUB(j)  (1280 + 64 * (j))
#define XB_XGEN(j)  (2304 + 64 * (j))
#define XB_TOP      3328
#define XB_TOPGEN   3392
#define XCD_BAR_WORDS 3456
#define XB_SPIN_CAP (1u << 18)
__device__ __forceinline__ unsigned xb_ld(unsigned* p)              { return __hip_atomic_load(p, __ATOMIC_RELAXED, __HIP_MEMORY_SCOPE_AGENT); }
__device__ __forceinline__ unsigned xb_add(unsigned* p, unsigned v) { return __hip_atomic_fetch_add(p, v, __ATOMIC_RELAXED, __HIP_MEMORY_SCOPE_AGENT); }
__device__ __forceinline__ unsigned xb_xcc_id() { return (unsigned)__builtin_amdgcn_s_getreg((3 << 11) | 20) & 0xFu; }
#define XB_SPIN(cond, bar) do { unsigned _sp = 0; while (cond) { __builtin_amdgcn_s_sleep(1); \
    if ((++_sp & 255u) == 0u) { if (xb_ld(&(bar)[XB_TMO])) break; if (_sp > XB_SPIN_CAP) { atomicAdd(&(bar)[XB_TMO], 1u); break; } } } } while (0)
struct XcdBarrier { unsigned* bar; unsigned x; volatile LAS unsigned* st; };
__device__ __forceinline__ XcdBarrier xcd_barrier_post(unsigned* bar, volatile LAS unsigned* st) {
    XcdBarrier b; b.bar = bar; b.x = xb_xcc_id(); b.st = st;
    if (threadIdx.x == 0) (void)xb_add(&bar[XB_XCNT(b.x)], 1u);
    return b;
}
__device__ __forceinline__ void xcd_barrier_complete(unsigned* bar, unsigned x, unsigned& nloc, unsigned& nx) {
    const unsigned G = gridDim.x * gridDim.y * gridDim.z;
    unsigned sum, cnt, mine, sp = 0u;
    for (;;) {
        sum = 0u; cnt = 0u; mine = 0u;
#pragma unroll
        for (unsigned j = 0; j < 16; ++j) { const unsigned c = xb_ld(&bar[XB_XCNT(j)]); sum += c; cnt += (c > 0u) ? 1u : 0u; mine = (j == x) ? c : mine; }
        if (sum == G) break;
        __builtin_amdgcn_s_sleep(1);
        if ((++sp & 255u) == 0u) { if (xb_ld(&bar[XB_TMO])) break; if (sp > XB_SPIN_CAP) { atomicAdd(&bar[XB_TMO], 1u); break; } }
    }
    nloc = mine > 0u ? mine : 1u; nx = cnt > 0u ? cnt : 1u;
}
__device__ __forceinline__ void xcd_barrier(const XcdBarrier& b) {
    asm volatile("s_waitcnt vmcnt(0)" ::: "memory");
    __syncthreads();
    if (threadIdx.x == 0) {
        unsigned* bar = b.bar;
        __builtin_amdgcn_s_waitcnt(0);
        unsigned nloc = b.st[0], nx = b.st[1];
        if (nloc == 0u) { xcd_barrier_complete(bar, b.x, nloc, nx); b.st[0] = nloc; b.st[1] = nx; }
        const unsigned old = xb_add(&bar[XB_XSUB(b.x)], 1u);
        const unsigned gen = old / nloc;
        if (old + 1u == (gen + 1u) * nloc) {
            __builtin_amdgcn_fence(__ATOMIC_RELEASE, "agent");
            asm volatile("s_waitcnt vmcnt(0)" ::: "memory");
            const unsigned og = xb_add(&bar[XB_TOP], 1u);
            const unsigned tg = og / nx;
            if (og + 1u == (tg + 1u) * nx) xb_add(&bar[XB_TOPGEN], 1u);
            else XB_SPIN(xb_ld(&bar[XB_TOPGEN]) == tg, bar);
            __builtin_amdgcn_fence(__ATOMIC_ACQUIRE, "agent");
            xb_add(&bar[XB_XGEN(b.x)], 1u);
            asm volatile("s_waitcnt vmcnt(0)" ::: "memory");
        } else {
            XB_SPIN(xb_ld(&bar[XB_XGEN(b.x)]) == gen, bar);
            __builtin_amdgcn_fence(__ATOMIC_ACQUIRE, "agent");
            asm volatile("s_waitcnt vmcnt(0)" ::: "memory");
        }
    }
    __syncthreads();
}

__device__ __forceinline__ void p0_transpose_item(const float* W, int K, int N, bf16* WT, const float* kscale, LAS float* scr, int item, int lane) {
    const int nblk = N / 32, kb = item / nblk, nb = item % nblk, k0 = 64 * kb, n0 = 32 * nb;
    float tv[32];
    const float* wp = W + (size_t)(k0 + (lane >> 5)) * N + n0 + (lane & 31);
#pragma unroll
    for (int i = 0; i < 32; ++i) tv[i] = wp[(size_t)(2 * i) * N];
    if (kscale) {
#pragma unroll
        for (int i = 0; i < 32; ++i) tv[i] *= kscale[k0 + 2 * i + (lane >> 5)]; }
#pragma unroll
    for (int i = 0; i < 32; ++i) scr[(2 * i + (lane >> 5)) * 33 + (lane & 31)] = tv[i];
    LDS_WAIT(); asm volatile("" ::: "memory");
    const int c = lane & 7;
#pragma unroll
    for (int j = 0; j < 4; ++j) { const int n = (lane >> 3) + 8 * j; const LAS float* s = scr + (8 * c) * 33 + n;
        v4u o; o.x = cvtpk(s[0 * 33], s[1 * 33]); o.y = cvtpk(s[2 * 33], s[3 * 33]); o.z = cvtpk(s[4 * 33], s[5 * 33]); o.w = cvtpk(s[6 * 33], s[7 * 33]);
        *(GAS v4u*)(WT + (size_t)(n0 + n) * K + k0 + 8 * c) = o; }
    LDS_WAIT(); asm volatile("" ::: "memory");
}

__device__ __forceinline__ void silu_publish(int G, int bx, int tid, const float* c_prompt, const float* c_sample, bf16* S, unsigned* cnt) {
    for (int grp = bx * 512 + tid; grp < 144 * 256; grp += G * 512) { const int row = grp >> 8, k8 = (grp & 255) * 8;
        v4u w = (v4u){0u, 0u, 0u, 0u};
        if (row < 132) { const float* cp = (row < 4 ? c_prompt + (size_t)row * DM : c_sample + (size_t)(row - 4) * DM) + k8;
            const f32x4 a = *(const f32x4*)cp, b = *(const f32x4*)(cp + 4);
            w.x = cvtpk(silu_f(a[0]), silu_f(a[1])); w.y = cvtpk(silu_f(a[2]), silu_f(a[3])); w.z = cvtpk(silu_f(b[0]), silu_f(b[1])); w.w = cvtpk(silu_f(b[2]), silu_f(b[3])); }
        *(v4u*)(S + (size_t)row * DM + k8) = w; }
    asm volatile("s_waitcnt vmcnt(0)" ::: "memory");
    __syncthreads();
    if (tid == 0) { __builtin_amdgcn_fence(__ATOMIC_RELEASE, "agent"); asm volatile("s_waitcnt vmcnt(0)" ::: "memory"); __hip_atomic_fetch_add(cnt, 1u, __ATOMIC_RELAXED, __HIP_MEMORY_SCOPE_AGENT); }
}
__device__ __forceinline__ void silu_wait(int G, int tid, unsigned* cnt) {
    if (tid == 0) { unsigned sp = 0;
        while (__hip_atomic_load(cnt, __ATOMIC_RELAXED, __HIP_MEMORY_SCOPE_AGENT) < (unsigned)G) { __builtin_amdgcn_s_sleep(2); if (++sp > (1u << 22)) break; }
        __builtin_amdgcn_fence(__ATOMIC_ACQUIRE, "agent"); asm volatile("s_waitcnt vmcnt(0)" ::: "memory"); }
    __syncthreads();
}
__device__ __forceinline__ void adaln_phase(LAS unsigned char* lds, int vcu, int G, int tid, int wid, int lane, const bf16* S, const float* w_ada, const float* b_ada, float* mod) {
    const int fr = lane & 15, g = lane >> 4;
    LAS float* scr = (LAS float*)(lds + wid * 16384);
    const unsigned wvoff = (unsigned)(((lane >> 2) * NMOD + 4 * (lane & 3)) * 4);
    const unsigned soff = (unsigned)((fr * DM + 8 * g) * 2);
    const int scr_w = (lane >> 2) * 52 + 4 * (lane & 3);
    for (int strip = vcu; strip < NMOD / 48; strip += G) {
        const int n0 = strip * 48;
        f32x4 acc[9][3];
#pragma unroll
        for (int rf = 0; rf < 9; ++rf)
#pragma unroll
            for (int nf = 0; nf < 3; ++nf) acc[rf][nf] = (f32x4){0.f, 0.f, 0.f, 0.f};
        f32x4 wv[6];
        { const char* wb = (const char*)(w_ada + (size_t)(wid * 256) * NMOD + n0);
#pragma unroll
          for (int i = 0; i < 6; ++i) wv[i] = *(const f32x4*)(wb + (size_t)(16 * (i / 3)) * NMOD * 4 + 64 * (i % 3) + wvoff); }
#pragma unroll 1
        for (int kb = 0; kb < 8; ++kb) {
            const int k0 = wid * 256 + kb * 32;
            bf16x8 af[9];
            { const char* sb = (const char*)(S + k0) + soff;
#pragma unroll
              for (int rf = 0; rf < 9; ++rf) af[rf] = *(const bf16x8*)(sb + (size_t)(16 * rf) * DM * 2); }
#pragma unroll
            for (int i = 0; i < 6; ++i) *(LAS f32x4*)(scr + scr_w + 16 * (i / 3) * 52 + 16 * (i % 3)) = wv[i];
            asm volatile("" ::: "memory");
            if (kb < 7) { const char* wb = (const char*)(w_ada + (size_t)(k0 + 32) * NMOD + n0);
#pragma unroll
                for (int i = 0; i < 6; ++i) wv[i] = *(const f32x4*)(wb + (size_t)(16 * (i / 3)) * NMOD * 4 + 64 * (i % 3) + wvoff); }
            LDS_WAIT(); asm volatile("" ::: "memory");
            bf16x8 bfr[3];
#pragma unroll
            for (int nf = 0; nf < 3; ++nf) { const LAS float* s = scr + (8 * g) * 52 + 16 * nf + fr;
                bfr[nf] = pack8((f32x4){s[0], s[52], s[104], s[156]}, (f32x4){s[208], s[260], s[312], s[364]}); }
#pragma unroll
            for (int rf = 0; rf < 9; ++rf)
#pragma unroll
                for (int nf = 0; nf < 3; ++nf) acc[rf][nf] = MFMA16(af[rf], bfr[nf], acc[rf][nf]);
            LDS_WAIT(); asm volatile("" ::: "memory");
        }
#pragma unroll
        for (int p = 0; p < 3; ++p) {
            __syncthreads();
            LAS float* red = (LAS float*)lds + wid * 2304;
#pragma unroll
            for (int rf = 0; rf < 9; ++rf)
#pragma unroll
                for (int i = 0; i < 4; ++i) red[(16 * rf + 4 * g + i) * 16 + fr] = acc[rf][p][i];
            __syncthreads();
            for (int e = tid; e < 2304; e += 512) { const int r = e >> 4, c = e & 15; float sum = 0.f;
#pragma unroll
                for (int w = 0; w < 8; ++w) sum += ((LAS float*)lds)[w * 2304 + e];
                if (r < 132) mod[(size_t)r * NMOD + n0 + 16 * p + c] = sum + b_ada[n0 + 16 * p + c]; }
        }
        __syncthreads();
    }
}

__device__ __forceinline__ const float* x_row(const float* xp, const float* xs, int m) { return m < MP ? xp + (size_t)m * DM : xs + (size_t)(m - MP) * DM; }
__device__ __forceinline__ int mod_row(int m) { return m < MP ? (m >> 11) : 4 + ((m - MP) >> 2); }

__device__ __forceinline__ float ssq8(const f32x4 (&v)[8]) { float s = 0.f;
#pragma unroll
    for (int j = 0; j < 8; ++j) s += (v[j][0] * v[j][0] + v[j][1] * v[j][1]) + (v[j][2] * v[j][2] + v[j][3] * v[j][3]);
    return s; }
__device__ __forceinline__ float ssq2(const f32x4 (&v)[2]) { return ((v[0][0] * v[0][0] + v[0][1] * v[0][1]) + (v[0][2] * v[0][2] + v[0][3] * v[0][3])) + ((v[1][0] * v[1][0] + v[1][1] * v[1][1]) + (v[1][2] * v[1][2] + v[1][3] * v[1][3])); }
__device__ __forceinline__ float quad_sum(LAS float* red, float v, int wid, int lane) {
    v = wave_sum(v); if (lane == 0) red[wid] = v; __syncthreads();
    const int b = wid & 4; const float t = (red[b] + red[b + 1]) + (red[b + 2] + red[b + 3]); __syncthreads(); return t;
}
__device__ __forceinline__ void p1_rows(LAS unsigned char* lds, int vcu, int G, int gw, int NGW, int wid, int lane, const float* xp, const float* xs, const float* mod, const float* gpre, bf16* H) {
    for (int m0 = gw; m0 < MP; m0 += 4 * NGW) {
        f32x4 v[4][8];
#pragma unroll
        for (int r = 0; r < 4; ++r) { const int m = m0 + r * NGW; if (m < MP) { const f32x4* xr = (const f32x4*)(xp + (size_t)m * DM) + lane;
#pragma unroll
                for (int j = 0; j < 8; ++j) v[r][j] = xr[64 * j]; } }
#pragma unroll
        for (int r = 0; r < 4; ++r) { const int m = m0 + r * NGW; if (m < MP) {
            const float* mr = mod + (size_t)(m >> 11) * NMOD;
            const float rstd = 1.0f / sqrtf(wave_sum(ssq8(v[r])) * (1.0f / DM) + EPS);
            v2u* o8 = (v2u*)(H + (size_t)m * DM) + lane;
#pragma unroll
            for (int j = 0; j < 8; ++j) { const int k = 4 * (lane + 64 * j);
                const f32x4 gg = *(const f32x4*)(gpre + k), sh = *(const f32x4*)(mr + k), sc = *(const f32x4*)(mr + DM + k);
                const f32x4 h = v[r][j] * rstd * gg * (sc + 1.0f) + sh;
                o8[64 * j] = (v2u){cvtpk(h[0], h[1]), cvtpk(h[2], h[3])}; } } }
    }
    LAS float* red = (LAS float*)lds;
    for (int pr = vcu; pr < MS / 2; pr += G) {
        const int r = 2 * pr + (wid >> 2), m = MP + r, c0 = (wid & 3) * 512 + 4 * lane;
        const float* mr = mod + (size_t)(4 + (r >> 2)) * NMOD;
        f32x4 x[2];
#pragma unroll
        for (int j = 0; j < 2; ++j) x[j] = *(const f32x4*)(xs + (size_t)r * DM + c0 + 256 * j);
        const float rstd = 1.0f / sqrtf(quad_sum(red, ssq2(x), wid, lane) * (1.0f / DM) + EPS);
#pragma unroll
        for (int j = 0; j < 2; ++j) { const int k = c0 + 256 * j;
            const f32x4 gg = *(const f32x4*)(gpre + k), sh = *(const f32x4*)(mr + k), sc = *(const f32x4*)(mr + DM + k);
            const f32x4 h = x[j] * rstd * gg * (sc + 1.0f) + sh;
            *(v2u*)(H + (size_t)m * DM + k) = (v2u){cvtpk(h[0], h[1]), cvtpk(h[2], h[3])}; }
    }
}
__device__ __forceinline__ void p5_rows(LAS unsigned char* lds, int vcu, int G, int gw, int NGW, int wid, int lane, const float* xp, const float* xs, const float* mod, const float* O,
                                        const float* ssqo, const float* slab, const float* gpost, const float* gpreff, float* out, bf16* H) {
    f32x4 v[8], o[8], nx[8], no[8]; float nq = 0.f;
    if (gw < MP) { const f32x4* xr = (const f32x4*)(xp + (size_t)gw * DM) + lane; const f32x4* orow = (const f32x4*)(O + (size_t)gw * DM) + lane;
#pragma unroll
        for (int j = 0; j < 8; ++j) { nx[j] = xr[64 * j]; no[j] = orow[64 * j]; }
        nq = lane < 32 ? ssqo[(size_t)gw * 32 + lane] : 0.f; }
    for (int m = gw; m < MP; m += NGW) {
#pragma unroll
        for (int j = 0; j < 8; ++j) { v[j] = nx[j]; o[j] = no[j]; }
        const float q = nq;
        if (m + NGW < MP) { const int mn = m + NGW; const f32x4* xr = (const f32x4*)(xp + (size_t)mn * DM) + lane; const f32x4* orow = (const f32x4*)(O + (size_t)mn * DM) + lane;
#pragma unroll
            for (int j = 0; j < 8; ++j) { nx[j] = xr[64 * j]; no[j] = orow[64 * j]; }
            nq = lane < 32 ? ssqo[(size_t)mn * 32 + lane] : 0.f; }
        const float* mr = mod + (size_t)(m >> 11) * NMOD;
        const float rstdo = 1.0f / sqrtf(wave_sum(q) * (1.0f / DM) + EPS);
#pragma unroll
        for (int j = 0; j < 8; ++j) { const int k = 4 * (lane + 64 * j);
            const f32x4 gt = *(const f32x4*)(mr + 2 * DM + k), gp = *(const f32x4*)(gpost + k);
            v[j] = v[j] + gt * (o[j] * rstdo * gp); }
        const float rstd = 1.0f / sqrtf(wave_sum(ssq8(v)) * (1.0f / DM) + EPS);
        f32x4* xo = (f32x4*)(out + (size_t)m * DM) + lane;
        v2u* o8 = (v2u*)(H + (size_t)m * DM) + lane;
#pragma unroll
        for (int j = 0; j < 8; ++j) { const int k = 4 * (lane + 64 * j);
            xo[64 * j] = v[j];
            const f32x4 gg = *(const f32x4*)(gpreff + k), sh = *(const f32x4*)(mr + 3 * DM + k), sc = *(const f32x4*)(mr + 4 * DM + k);
            const f32x4 h = v[j] * rstd * gg * (sc + 1.0f) + sh;
            o8[64 * j] = (v2u){cvtpk(h[0], h[1]), cvtpk(h[2], h[3])}; }
    }
    LAS float* red = (LAS float*)lds;
    for (int pr = vcu; pr < MS / 2; pr += G) {
        const int r = 2 * pr + (wid >> 2), m = MP + r, c0 = (wid & 3) * 512 + 4 * lane;
        const float* mr = mod + (size_t)(4 + (r >> 2)) * NMOD;
        f32x4 x[2], a[2];
#pragma unroll
        for (int j = 0; j < 2; ++j) { x[j] = *(const f32x4*)(xs + (size_t)r * DM + c0 + 256 * j); a[j] = (f32x4){0.f, 0.f, 0.f, 0.f}; }
#pragma unroll
        for (int sl = 0; sl < pg8::NSL; ++sl)
#pragma unroll
            for (int j = 0; j < 2; ++j) a[j] = a[j] + *(const f32x4*)(slab + ((size_t)sl * 512 + r) * DM + c0 + 256 * j);
        const float rstdo = 1.0f / sqrtf(quad_sum(red, ssq2(a), wid, lane) * (1.0f / DM) + EPS);
#pragma unroll
        for (int j = 0; j < 2; ++j) { const int k = c0 + 256 * j;
            const f32x4 gt = *(const f32x4*)(mr + 2 * DM + k), gp = *(const f32x4*)(gpost + k);
            x[j] = x[j] + gt * (a[j] * rstdo * gp); }
        const float rstd = 1.0f / sqrtf(quad_sum(red, ssq2(x), wid, lane) * (1.0f / DM) + EPS);
#pragma unroll
        for (int j = 0; j < 2; ++j) { const int k = c0 + 256 * j;
            *(f32x4*)(out + (size_t)m * DM + k) = x[j];
            const f32x4 gg = *(const f32x4*)(gpreff + k), sh = *(const f32x4*)(mr + 3 * DM + k), sc = *(const f32x4*)(mr + 4 * DM + k);
            const f32x4 h = x[j] * rstd * gg * (sc + 1.0f) + sh;
            *(v2u*)(H + (size_t)m * DM + k) = (v2u){cvtpk(h[0], h[1]), cvtpk(h[2], h[3])}; }
    }
}
__device__ __forceinline__ void p8_rows(LAS unsigned char* lds, int vcu, int G, int gw, int NGW, int wid, int lane, const float* mod, const float* F, const float* ssqf, const float* slab,
                                        const float* gpostff, float* out) {
    f32x4 v[8], o[8], nx[8], no[8]; float nq = 0.f;
    if (gw < MP) { const f32x4* xr = (const f32x4*)(out + (size_t)gw * DM) + lane; const f32x4* orow = (const f32x4*)(F + (size_t)gw * DM) + lane;
#pragma unroll
        for (int j = 0; j < 8; ++j) { nx[j] = xr[64 * j]; no[j] = orow[64 * j]; }
        nq = lane < 32 ? ssqf[(size_t)gw * 32 + lane] : 0.f; }
    for (int m = gw; m < MP; m += NGW) {
#pragma unroll
        for (int j = 0; j < 8; ++j) { v[j] = nx[j]; o[j] = no[j]; }
        const float q = nq;
        if (m + NGW < MP) { const int mn = m + NGW; const f32x4* xr = (const f32x4*)(out + (size_t)mn * DM) + lane; const f32x4* orow = (const f32x4*)(F + (size_t)mn * DM) + lane;
#pragma unroll
            for (int j = 0; j < 8; ++j) { nx[j] = xr[64 * j]; no[j] = orow[64 * j]; }
            nq = lane < 32 ? ssqf[(size_t)mn * 32 + lane] : 0.f; }
        const float* mr = mod + (size_t)(m >> 11) * NMOD;
        const float rstdf = 1.0f / sqrtf(wave_sum(q) * (1.0f / DM) + EPS);
        f32x4* xo = (f32x4*)(out + (size_t)m * DM) + lane;
#pragma unroll
        for (int j = 0; j < 8; ++j) { const int k = 4 * (lane + 64 * j);
            const f32x4 gt = *(const f32x4*)(mr + 5 * DM + k), gp = *(const f32x4*)(gpostff + k);
            xo[64 * j] = v[j] + gt * (o[j] * rstdf * gp); }
    }
    LAS float* red = (LAS float*)lds;
    for (int pr = vcu; pr < MS / 2; pr += G) {
        const int r = 2 * pr + (wid >> 2), m = MP + r, c0 = (wid & 3) * 512 + 4 * lane;
        const float* mr = mod + (size_t)(4 + (r >> 2)) * NMOD;
        f32x4 x[2], a[2];
#pragma unroll
        for (int j = 0; j < 2; ++j) { x[j] = *(const f32x4*)(out + (size_t)m * DM + c0 + 256 * j); a[j] = (f32x4){0.f, 0.f, 0.f, 0.f}; }
#pragma unroll
        for (int sl = 0; sl < pg8::NSL; ++sl)
#pragma unroll
            for (int j = 0; j < 2; ++j) a[j] = a[j] + *(const f32x4*)(slab + ((size_t)sl * 512 + r) * DM + c0 + 256 * j);
        const float rstdf = 1.0f / sqrtf(quad_sum(red, ssq2(a), wid, lane) * (1.0f / DM) + EPS);
#pragma unroll
        for (int j = 0; j < 2; ++j) { const int k = c0 + 256 * j;
            const f32x4 gt = *(const f32x4*)(mr + 5 * DM + k), gp = *(const f32x4*)(gpostff + k);
            *(f32x4*)(out + (size_t)m * DM + k) = x[j] + gt * (a[j] * rstdf * gp); }
    }
}

constexpr int AT_K = 0, AT_V = 36864, AT_LUT = 70656;
__device__ __forceinline__ void attn_prompt_unit(LAS unsigned char* lds, int b, int nb, int h, const bf16* Qb, const bf16* Kb, const bf16* Vb, bf16* MG, float* ssqm,
                                                 const float* sinks, int tid, int wid, int lane) {
    const int kvh = h >> 3, tokq = b * 2048 + nb * 128, tokk = tokq - 128;
    const LAS int* bkt = (const LAS int*)(lds + X_BKT); const LAS float* tab = (const LAS float*)(lds + X_TAB);
    __syncthreads();
#pragma unroll
    for (int i = 0; i < 4; ++i) { const int idx = tid + 512 * i, key = idx >> 3, ch = idx & 7;
        v4u v = (v4u){0u, 0u, 0u, 0u}; if (nb > 0 || key >= 128) v = *(const v4u*)(Kb + (size_t)(tokk + key) * 128 + kvh * 64 + ch * 8);
        *(LAS v4u*)(lds + AT_K + key * 144 + ch * 16) = v; }
#pragma unroll
    for (int i = 0; i < 4; ++i) { const int idx = tid + 512 * i, key = idx & 255, ch = idx >> 8;
        v4u v = (v4u){0u, 0u, 0u, 0u}; if (nb > 0 || key >= 128) v = *(const v4u*)(Vb + (size_t)(tokk + key) * 128 + kvh * 64 + ch * 8);
        LAS unsigned short* vt = (LAS unsigned short*)(lds + AT_V) + (ch * 8) * 264 + key;
        vt[0 * 264] = (unsigned short)(v.x & 0xffffu); vt[1 * 264] = (unsigned short)(v.x >> 16); vt[2 * 264] = (unsigned short)(v.y & 0xffffu); vt[3 * 264] = (unsigned short)(v.y >> 16);
        vt[4 * 264] = (unsigned short)(v.z & 0xffffu); vt[5 * 264] = (unsigned short)(v.z >> 16); vt[6 * 264] = (unsigned short)(v.w & 0xffffu); vt[7 * 264] = (unsigned short)(v.w >> 16); }
    if (tid < 128) ((LAS float*)(lds + AT_LUT))[tid] = tab[bkt[tid] * 16 + h];
    __syncthreads();
    const int fr = lane & 15, g = lane >> 4, f0 = wid < 6 ? wid : 6, qi = 16 * wid + fr;
    const bf16* qp = Qb + (size_t)(tokq + qi) * 1024 + h * 64 + 8 * g;
    const bf16x8 q0 = *(const bf16x8*)qp, q1 = *(const bf16x8*)(qp + 32);
    f32x4 s[10];
#pragma unroll
    for (int f = 0; f < 10; ++f) { const LAS unsigned char* kp = lds + AT_K + (16 * (f0 + f) + fr) * 144 + 16 * g;
        const bf16x8 k0 = *(const LAS bf16x8*)kp, k1 = *(const LAS bf16x8*)(kp + 64);
        s[f] = MFMA16(k0, q0, ((f32x4){0.f, 0.f, 0.f, 0.f})); s[f] = MFMA16(k1, q1, s[f]); }
    const LAS float* lut = (const LAS float*)(lds + AT_LUT);
    const float sk = sinks[h] * LOG2E;
    float mx = -INFINITY;
#pragma unroll
    for (int f = 0; f < 10; ++f)
#pragma unroll
        for (int i = 0; i < 4; ++i) { const int kj = 16 * (f0 + f) + 4 * g + i, dist = 128 + qi - kj; const bool valid = (dist >= 0) && (dist < 128) && (nb > 0 || kj >= 128);
            const float v = valid ? s[f][i] + lut[dist & 127] : -INFINITY; s[f][i] = v; mx = fmaxf(mx, v); }
    mx = fmaxf(mx, __shfl_xor(mx, 16)); mx = fmaxf(mx, __shfl_xor(mx, 32)); mx = fmaxf(mx, sk);
    float l = 0.f;
#pragma unroll
    for (int f = 0; f < 10; ++f)
#pragma unroll
        for (int i = 0; i < 4; ++i) { const float p = __builtin_amdgcn_exp2f(s[f][i] - mx); s[f][i] = p; l += p; }
    l += __shfl_xor(l, 16); l += __shfl_xor(l, 32); l += __builtin_amdgcn_exp2f(sk - mx);
    const float rl = 1.0f / l;
    f32x4 o[4];
#pragma unroll
    for (int df = 0; df < 4; ++df) o[df] = (f32x4){0.f, 0.f, 0.f, 0.f};
#pragma unroll
    for (int si = 0; si < 5; ++si) { const bf16x8 pb = pack8(s[2 * si], s[2 * si + 1]); const int key0 = 16 * (f0 + 2 * si);
#pragma unroll
        for (int df = 0; df < 4; ++df) { const LAS unsigned char* vp = lds + AT_V + ((16 * df + fr) * 264 + key0 + 4 * g) * 2;
            const v2u lo = *(const LAS v2u*)vp, hi = *(const LAS v2u*)(vp + 32);
            const bf16x8 va = __builtin_bit_cast(bf16x8, ((v4u){lo.x, lo.y, hi.x, hi.y}));
            o[df] = MFMA16(va, pb, o[df]); } }
    float ss = 0.f; bf16* op = MG + (size_t)(tokq + qi) * DM + h * 64 + 4 * g;
#pragma unroll
    for (int df = 0; df < 4; ++df) { const f32x4 v = o[df] * rl; ss += (v[0] * v[0] + v[1] * v[1]) + (v[2] * v[2] + v[3] * v[3]);
        *(v2u*)(op + 16 * df) = (v2u){cvtpk(v[0], v[1]), cvtpk(v[2], v[3])}; }
    ss += __shfl_xor(ss, 16); ss += __shfl_xor(ss, 32);
    if (g == 0) ssqm[(size_t)(tokq + qi) * 24 + h] = ss;
}

constexpr int SA_K = 0, SA_V = 41472, SA_END = 84480;
__device__ __forceinline__ void attn_sample_unit(LAS unsigned char* lds, int db, const bf16* Qb, const bf16* Kb, const bf16* Vb, const float* cache_k, const float* cache_v,
                                                 bf16* MG, float* ssqm, const float* sinks, int tid, int wid, int lane) {
    const LAS int* bkt = (const LAS int*)(lds + X_BKT); const LAS float* tab = (const LAS float*)(lds + X_TAB);
    const int tok0 = MP + db * 4;
    __syncthreads();
    for (int i = tid; i < SA_END / 16; i += 512) *(LAS v4u*)(lds + i * 16) = (v4u){0u, 0u, 0u, 0u};
    __syncthreads();
#pragma unroll
    for (int i = 0; i < 8; ++i) { const int idx = tid + 512 * i, j = idx >> 5, kvh = (idx >> 4) & 1, c4 = idx & 15;
        const f32x4 kv = *(const f32x4*)(cache_k + (size_t)db * 16384 + (size_t)idx * 4), vv = *(const f32x4*)(cache_v + (size_t)db * 16384 + (size_t)idx * 4);
        *(LAS v2u*)(lds + SA_K + (kvh * 144 + j) * 144 + 8 * c4) = (v2u){cvtpk(kv[0], kv[1]), cvtpk(kv[2], kv[3])};
        const unsigned w0 = cvtpk(vv[0], vv[1]), w1 = cvtpk(vv[2], vv[3]);
        LAS unsigned short* vt = (LAS unsigned short*)(lds + SA_V) + (kvh * 64 + 4 * c4) * 168 + j;
        vt[0] = (unsigned short)(w0 & 0xffffu); vt[168] = (unsigned short)(w0 >> 16); vt[336] = (unsigned short)(w1 & 0xffffu); vt[504] = (unsigned short)(w1 >> 16); }
    if (tid < 64) { const int t = tid >> 4, kvh = (tid >> 3) & 1, ch = tid & 7;
        const v4u kv = *(const v4u*)(Kb + (size_t)(tok0 + t) * 128 + kvh * 64 + 8 * ch), vv = *(const v4u*)(Vb + (size_t)(tok0 + t) * 128 + kvh * 64 + 8 * ch);
        *(LAS v4u*)(lds + SA_K + (kvh * 144 + 128 + t) * 144 + 16 * ch) = kv;
        LAS unsigned short* vt = (LAS unsigned short*)(lds + SA_V) + (kvh * 64 + 8 * ch) * 168 + 128 + t;
        vt[0 * 168] = (unsigned short)(vv.x & 0xffffu); vt[1 * 168] = (unsigned short)(vv.x >> 16); vt[2 * 168] = (unsigned short)(vv.y & 0xffffu); vt[3 * 168] = (unsigned short)(vv.y >> 16);
        vt[4 * 168] = (unsigned short)(vv.z & 0xffffu); vt[5 * 168] = (unsigned short)(vv.z >> 16); vt[6 * 168] = (unsigned short)(vv.w & 0xffffu); vt[7 * 168] = (unsigned short)(vv.w >> 16); }
    __syncthreads();
    if (wid < 4) {
        const int fr = lane & 15, g = lane >> 4, kvh = wid >> 1, hh = 4 * wid + (fr >> 2), t = fr & 3;
        const bf16* qp = Qb + (size_t)(tok0 + t) * 1024 + hh * 64 + 8 * g;
        const bf16x8 q0 = *(const bf16x8*)qp, q1 = *(const bf16x8*)(qp + 32);
        f32x4 s[10];
#pragma unroll
        for (int f = 0; f < 9; ++f) { const LAS unsigned char* kp = lds + SA_K + (kvh * 144 + 16 * f + fr) * 144 + 16 * g;
            const bf16x8 k0 = *(const LAS bf16x8*)kp, k1 = *(const LAS bf16x8*)(kp + 64);
            s[f] = MFMA16(k0, q0, ((f32x4){0.f, 0.f, 0.f, 0.f})); s[f] = MFMA16(k1, q1, s[f]); }
        s[9] = (f32x4){0.f, 0.f, 0.f, 0.f};
        const float sk = sinks[hh] * LOG2E;
        float mx = -INFINITY;
#pragma unroll
        for (int f = 0; f < 9; ++f)
#pragma unroll
            for (int i = 0; i < 4; ++i) { const int j = 16 * f + 4 * g + i, dist = 128 + t - j; const bool valid = (dist >= 0) && (dist < 128);
                const float v = valid ? s[f][i] + tab[bkt[dist & 127] * 16 + hh] : -INFINITY; s[f][i] = v; mx = fmaxf(mx, v); }
        mx = fmaxf(mx, __shfl_xor(mx, 16)); mx = fmaxf(mx, __shfl_xor(mx, 32)); mx = fmaxf(mx, sk);
        float l = 0.f;
#pragma unroll
        for (int f = 0; f < 9; ++f)
#pragma unroll
            for (int i = 0; i < 4; ++i) { const float p = __builtin_amdgcn_exp2f(s[f][i] - mx); s[f][i] = p; l += p; }
        l += __shfl_xor(l, 16); l += __shfl_xor(l, 32); l += __builtin_amdgcn_exp2f(sk - mx);
        const float rl = 1.0f / l;
        f32x4 o[4];
#pragma unroll
        for (int df = 0; df < 4; ++df) o[df] = (f32x4){0.f, 0.f, 0.f, 0.f};
#pragma unroll
        for (int si = 0; si < 5; ++si) { const bf16x8 pb = pack8(s[2 * si], s[2 * si + 1]);
#pragma unroll
            for (int df = 0; df < 4; ++df) { const LAS unsigned char* vp = lds + SA_V + ((kvh * 64 + 16 * df + fr) * 168 + 32 * si + 4 * g) * 2;
                const v2u lo = *(const LAS v2u*)vp, hi = *(const LAS v2u*)(vp + 32);
                const bf16x8 va = __builtin_bit_cast(bf16x8, ((v4u){lo.x, lo.y, hi.x, hi.y}));
                o[df] = MFMA16(va, pb, o[df]); } }
        float ss = 0.f; bf16* op = MG + (size_t)(tok0 + t) * DM + hh * 64 + 4 * g;
#pragma unroll
        for (int df = 0; df < 4; ++df) { const f32x4 v = o[df] * rl; ss += (v[0] * v[0] + v[1] * v[1]) + (v[2] * v[2] + v[3] * v[3]);
            *(v2u*)(op + 16 * df) = (v2u){cvtpk(v[0], v[1]), cvtpk(v[2], v[3])}; }
        ss += __shfl_xor(ss, 16); ss += __shfl_xor(ss, 32);
        if (g == 0) ssqm[(size_t)(tok0 + t) * 24 + hh] = ss;
    }
}

constexpr int GM_W = 0, GM_V = 34816, GM_RED = 69632;
__device__ __forceinline__ void gmlp_prompt_unit(LAS unsigned char* lds, int b, int n, int h, const bf16* GU, const bf16* GV, const float* w_s, const float* b_s, const float* vgain,
                                                 bf16* MG, float* ssqm, int tid, int wid, int lane) {
    const int tok0 = b * 2048 + n * 128;
    __syncthreads();
#pragma unroll
    for (int ii = 0; ii < 8; ++ii) { const int idx = tid + 512 * ii, i = idx >> 5, j4 = idx & 31; f32x4 w = *(const f32x4*)(w_s + ((size_t)h * 128 + i) * 128 + 4 * j4);
#pragma unroll
        for (int e = 0; e < 4; ++e) if (4 * j4 + e > i) w[e] = 0.f;
        *(LAS v2u*)(lds + GM_W + i * 272 + 8 * j4) = (v2u){cvtpk(w[0], w[1]), cvtpk(w[2], w[3])}; }
    const int j = tid & 127, chq = tid >> 7;
    v4u vr[4]; float sq = 0.f;
#pragma unroll
    for (int ii = 0; ii < 4; ++ii) { const int ch = chq + 4 * ii; vr[ii] = *(const v4u*)(GV + (size_t)(tok0 + j) * 1024 + h * 128 + 8 * ch);
#pragma unroll
        for (int e = 0; e < 4; ++e) { const float a = bflo(vr[ii][e]), c = bfhi(vr[ii][e]); sq += a * a + c * c; } }
    ((LAS float*)(lds + GM_RED))[chq * 128 + j] = sq;
    __syncthreads();
    { const LAS float* red = (const LAS float*)(lds + GM_RED); const float tot = (red[j] + red[128 + j]) + (red[256 + j] + red[384 + j]);
      const float rstd = 1.0f / sqrtf(tot * (1.0f / 128.0f) + EPS);
      LAS unsigned short* vt = (LAS unsigned short*)(lds + GM_V);
#pragma unroll
      for (int ii = 0; ii < 4; ++ii) { const int ch = chq + 4 * ii; const f32x4 g0 = *(const f32x4*)(vgain + h * 128 + 8 * ch), g1 = *(const f32x4*)(vgain + h * 128 + 8 * ch + 4);
#pragma unroll
          for (int e = 0; e < 4; ++e) { const float ga = e < 2 ? g0[2 * e] : g1[2 * e - 4], gb = e < 2 ? g0[2 * e + 1] : g1[2 * e - 3];
              const unsigned w = cvtpk(bflo(vr[ii][e]) * rstd * ga, bfhi(vr[ii][e]) * rstd * gb);
              vt[(8 * ch + 2 * e) * 136 + j] = (unsigned short)(w & 0xffffu); vt[(8 * ch + 2 * e + 1) * 136 + j] = (unsigned short)(w >> 16); } } }
    __syncthreads();
    const int fr = lane & 15, g = lane >> 4, ns = (wid >> 1) + 1;
    f32x4 acc[8];
#pragma unroll
    for (int cf = 0; cf < 8; ++cf) acc[cf] = (f32x4){0.f, 0.f, 0.f, 0.f};
    for (int s = 0; s < ns; ++s) { const bf16x8 bw = *(const LAS bf16x8*)(lds + GM_W + (16 * wid + fr) * 272 + (32 * s + 8 * g) * 2);
#pragma unroll
        for (int cf = 0; cf < 8; ++cf) { const bf16x8 av = *(const LAS bf16x8*)(lds + GM_V + (16 * cf + fr) * 272 + (32 * s + 8 * g) * 2); acc[cf] = MFMA16(av, bw, acc[cf]); } }
    const int i = 16 * wid + fr, tok = tok0 + i; const float bs = b_s[h * 128 + i]; float ss = 0.f;
    const bf16* up = GU + (size_t)tok * 1024 + h * 128 + 4 * g; bf16* op = MG + (size_t)tok * DM + 1024 + h * 128 + 4 * g;
#pragma unroll
    for (int cf = 0; cf < 8; ++cf) { const v2u uu = *(const v2u*)(up + 16 * cf);
        f32x4 v; v[0] = bflo(uu.x) * (acc[cf][0] + bs); v[1] = bfhi(uu.x) * (acc[cf][1] + bs); v[2] = bflo(uu.y) * (acc[cf][2] + bs); v[3] = bfhi(uu.y) * (acc[cf][3] + bs);
        ss += (v[0] * v[0] + v[1] * v[1]) + (v[2] * v[2] + v[3] * v[3]);
        *(v2u*)(op + 16 * cf) = (v2u){cvtpk(v[0], v[1]), cvtpk(v[2], v[3])}; }
    ss += __shfl_xor(ss, 16); ss += __shfl_xor(ss, 32);
    if (g == 0) ssqm[(size_t)tok * 24 + 16 + h] = ss;
}

__device__ __forceinline__ void gmlp_sample_wave(int db, int h, const bf16* GU, const bf16* GV, const float* w_s, const float* b_s, const float* vgain, bf16* MG, float* ssqm, float* out, int lane) {
    const int tok0 = MP + db * 4, c = 2 * lane;
    const f32x2 gn = *(const f32x2*)(vgain + h * 128 + c);
    float vn[4][2];
#pragma unroll
    for (int t = 0; t < 4; ++t) { const unsigned w = *(const unsigned*)(GV + (size_t)(tok0 + t) * 1024 + h * 128 + c); const float a = bflo(w), b2 = bfhi(w);
        const float rstd = 1.0f / sqrtf(wave_sum(a * a + b2 * b2) * (1.0f / 128.0f) + EPS);
        vn[t][0] = a * rstd * gn[0]; vn[t][1] = b2 * rstd * gn[1];
        *(f32x2*)(out + pg8::OGV + ((size_t)(db * 4 + t) * 8 + h) * 128 + c) = (f32x2){vn[t][0], vn[t][1]}; }
#pragma unroll
    for (int i = 0; i < 4; ++i) { float m0 = b_s[h * 128 + i], m1 = m0;
#pragma unroll
        for (int jj = 0; jj <= i; ++jj) { const float w = w_s[((size_t)h * 128 + i) * 128 + jj]; m0 += w * vn[jj][0]; m1 += w * vn[jj][1]; }
        const unsigned uw = *(const unsigned*)(GU + (size_t)(tok0 + i) * 1024 + h * 128 + c);
        const float o0 = bflo(uw) * m0, o1 = bfhi(uw) * m1;
        *(unsigned*)(MG + (size_t)(tok0 + i) * DM + 1024 + h * 128 + c) = cvtpk(o0, o1);
        const float ss = wave_sum(o0 * o0 + o1 * o1);
        if (lane == 0) ssqm[(size_t)(tok0 + i) * 24 + 16 + h] = ss; }
}

__device__ __forceinline__ const float* in_ptr(LAS unsigned char* lds, int i) {
    const unsigned long long v = ((const LAS unsigned long long*)(lds + X_PTR))[i];
    const unsigned lo = __builtin_amdgcn_readfirstlane((unsigned)v), hi = __builtin_amdgcn_readfirstlane((unsigned)(v >> 32));
    return (const float*)(const GAS float*)(((unsigned long long)hi << 32) | lo);
}
struct Args { const float* in[23]; float* out; unsigned char* ws; int ph_lo, ph_hi; };
__global__ void __launch_bounds__(NWAVES * 64, 2) mk_fwd(Args args) {
    extern __shared__ __attribute__((aligned(16))) unsigned char lds_raw[];
    LAS unsigned char* lds = (LAS unsigned char*)lds_raw;
    const int tid = threadIdx.x, lane = tid & 63, wid = __builtin_amdgcn_readfirstlane(tid >> 6);
    const int G = gridDim.x, bx = blockIdx.x, vcu = (G % 8 == 0) ? (bx % 8) * (G / 8) + bx / 8 : bx;
    const int gw = vcu * NWAVES + wid, NGW = G * NWAVES;
    unsigned char* ws = args.ws;
    float* out = args.out;
    bf16* Win_t = (bf16*)(ws + WS_WIN); bf16* Wout_t = (bf16*)(ws + WS_WOUT); bf16* Wff1_t = (bf16*)(ws + WS_WFF1); bf16* Wff2_t = (bf16*)(ws + WS_WFF2);
    float* mod = (float*)(ws + WS_MOD); float* ssqm = (float*)(ws + WS_SSQM); float* ssqo = (float*)(ws + WS_SSQO); float* ssqf = (float*)(ws + WS_SSQF);
    bf16* H = (bf16*)(ws + WS_H); bf16* Qb = (bf16*)(ws + WS_Q); bf16* Kb = (bf16*)(ws + WS_K); bf16* Vb = (bf16*)(ws + WS_V); bf16* GU = (bf16*)(ws + WS_GU); bf16* GV = (bf16*)(ws + WS_GV);
    bf16* MG = (bf16*)(ws + WS_MG); float* Ob = (float*)(ws + WS_O); bf16* F1 = (bf16*)(ws + WS_F1); float* Fb = (float*)(ws + WS_F);

    for (int u = tid; u < (LDS_BYTES - X_MISC) / 4; u += NWAVES * 64) ((LAS unsigned*)(lds + X_MISC))[u] = 0u;
    if (tid < 128) { const int n = tid; int bk = n; if (n >= 16) { bk = 16 + (int)(logf((float)n / 16.0f) / 2.0794415416798357f * 16.0f); bk = bk < 31 ? bk : 31; } ((LAS int*)(lds + X_BKT))[tid] = bk; }
    ((LAS float*)(lds + X_TAB))[tid] = args.in[6][tid] * LOG2E;
    if (tid < 23) ((LAS unsigned long long*)(lds + X_PTR))[tid] = (unsigned long long)args.in[tid];
    __syncthreads();
#define INP(i) in_ptr(lds, (i))
#if !MK_CG_SYNC
    XcdBarrier bar = xcd_barrier_post((unsigned*)(ws + WS_CTL) + CW_BAR, (volatile LAS unsigned*)(lds + X_MISC));
#define GRID_BAR(seam) xcd_barrier(bar)
    if (args.ph_lo < 0) cg::this_grid().sync();
#else
#define GRID_BAR(seam) cg::this_grid().sync()
#endif
    const int lo = args.ph_lo, hi = args.ph_hi;
#ifndef PROBE_PHASE
#define PROBE_PHASE -1
#endif
#define PROBE_MULT 4
    unsigned long long pt0_ = 0, pdt_ = 0;
#define PSTART(k) do { if (PROBE_PHASE == (k) && bx == 0 && tid == 0) pt0_ = __builtin_amdgcn_s_memrealtime(); } while (0)
#define PEND(k) do { if (PROBE_PHASE == (k) && bx == 0 && tid == 0) pdt_ = __builtin_amdgcn_s_memrealtime() - pt0_; } while (0)
#ifndef PH_MASK
#define PH_MASK 0x1ff
#endif
#define IN(k) ((((PH_MASK) >> (k)) & 1) && lo <= (k) && (k) < hi)
#ifndef DUP_MASK
#define DUP_MASK 0
#endif
#define REP(k) for (int rep_ = 0; rep_ < 1 + (((DUP_MASK) >> (k)) & 1); ++rep_)
#define BOTH(k) (IN(k) && IN((k) + 1))

    PSTART(0);
    if (IN(0)) REP(0) {
        silu_publish(G, bx, tid, INP(4), INP(5), (bf16*)(ws + WS_S), (unsigned*)(ws + WS_CTL) + CW_SCNT);
        LAS float* scr = (LAS float*)(lds + wid * 16384);
        constexpr int I_IN = (DM / 64) * (INC / 32), I_OUT = (DM / 64) * (DM / 32), I_F1 = (DM / 64) * (DFF / 32), I_F2 = (DFF / 64) * (DM / 32);
        constexpr int NITEMS = I_IN + I_OUT + I_F1 + I_F2;
        for (int it = gw; it < NITEMS; it += NGW) {
            int r = it;
            if (r < I_IN) { p0_transpose_item(INP(10), DM, INC, Win_t, nullptr, scr, r, lane); continue; } r -= I_IN;
            if (r < I_OUT) { const int kb = r / (DM / 32); p0_transpose_item(INP(17), DM, DM, Wout_t, kb < 16 ? INP(15) : INP(16) - 1024, scr, r, lane); continue; } r -= I_OUT;
            if (r < I_F1) { p0_transpose_item(INP(20), DM, DFF, Wff1_t, nullptr, scr, r, lane); continue; } r -= I_F1;
            p0_transpose_item(INP(21), DFF, DM, Wff2_t, nullptr, scr, r, lane);
        }
        silu_wait(G, tid, (unsigned*)(ws + WS_CTL) + CW_SCNT);
        adaln_phase(lds, vcu, G, tid, wid, lane, (const bf16*)(ws + WS_S), INP(7), INP(8), mod);
        if (BOTH(0)) GRID_BAR(0);
    }
    PEND(0);
    PSTART(1);
    if (IN(1)) REP(1) { p1_rows(lds, vcu, G, gw, NGW, wid, lane, INP(0), INP(1), mod, INP(9), H); if (BOTH(1)) GRID_BAR(1); }
    PEND(1);
    PSTART(2);
    if (IN(2)) REP(2) {
        pg8::Gemm g{H, Win_t, M, INC, DM}; pg8::StaticOrder S; S.init(M, INC, DM, G, bx);
        pg8::EpiInProj E{Qb, Kb, Vb, GU, GV, out};
        pg8::gemm_phase<pg8::EpiInProj, pg8::StaticOrder, true, true>(lds, g, S, E);
        if (BOTH(2)) GRID_BAR(2);
    }
    PEND(2);
    PSTART(3);
    if (IN(3)) REP(3) {
        constexpr int N_AP = 1024, N_GP = 512, N_SA = 128, N_SG = 128;
        for (int r = vcu; r < N_AP; r += G) attn_prompt_unit(lds, r >> 8, (r >> 4) & 15, r & 15, Qb, Kb, Vb, MG, ssqm, INP(11), tid, wid, lane);
        for (int r = vcu; r < N_GP; r += G) gmlp_prompt_unit(lds, r >> 7, (r >> 3) & 15, r & 7, GU, GV, INP(13), INP(14), INP(12), MG, ssqm, tid, wid, lane);
        for (int r = vcu; r < N_SA; r += G) attn_sample_unit(lds, r, Qb, Kb, Vb, INP(2), INP(3), MG, ssqm, INP(11), tid, wid, lane);
        for (int r = (vcu + G - (G >> 1)) % G; r < N_SG; r += G) { const int wu = r * 8 + wid; gmlp_sample_wave(wu >> 3, wu & 7, GU, GV, INP(13), INP(14), INP(12), MG, ssqm, out, lane); }
        __syncthreads();
        if (BOTH(3)) GRID_BAR(3);
    }
    PEND(3);
    PSTART(4);
    if (IN(4)) REP(4) {
        pg8::Gemm g{MG, Wout_t, M, DM, DM}; pg8::SplitOrder S; S.init(DM, G, bx);
        pg8::EpiF32Ssq<true> E{Ob, ssqo, ssqm, (LAS float*)(lds + X_RATIO), (float*)(ws + WS_SLAB4)};
        pg8::gemm_phase<pg8::EpiF32Ssq<true>, pg8::SplitOrder, true, true>(lds, g, S, E);
        if (BOTH(4)) GRID_BAR(4);
    }
    PEND(4);
    PSTART(5);
    if (IN(5)) REP(5) { p5_rows(lds, vcu, G, gw, NGW, wid, lane, INP(0), INP(1), mod, Ob, ssqo, (const float*)(ws + WS_SLAB4), INP(18), INP(19), out, H); if (BOTH(5)) GRID_BAR(5); }
    PEND(5);
    PSTART(6);
    if (IN(6)) REP(6) {
        pg8::Gemm g{H, Wff1_t, M, DFF, DM}; pg8::StaticOrder S; S.init(M, DFF, DM, G, bx);
        pg8::EpiRelu2 E{F1, DFF};
        pg8::gemm_phase<pg8::EpiRelu2, pg8::StaticOrder, true, true>(lds, g, S, E);
        if (BOTH(6)) GRID_BAR(6);
    }
    PEND(6);
    PSTART(7);
    if (IN(7)) REP(7) {
        pg8::Gemm g{F1, Wff2_t, M, DM, DFF}; pg8::SplitOrder S; S.init(DFF, G, bx);
        pg8::EpiF32Ssq<false> E{Fb, ssqf, nullptr, (LAS float*)(lds + X_RATIO), (float*)(ws + WS_SLAB7)};
        pg8::gemm_phase<pg8::EpiF32Ssq<false>, pg8::SplitOrder, true, true>(lds, g, S, E);
        if (BOTH(7)) GRID_BAR(7);
    }
    PEND(7);
    PSTART(8);
    if (IN(8)) { p8_rows(lds, vcu, G, gw, NGW, wid, lane, mod, Fb, ssqf, (const float*)(ws + WS_SLAB7), INP(22), out); }
    PEND(8);
    if (PROBE_PHASE >= 0 && bx == 0 && tid == 0) { const unsigned long long te = __builtin_amdgcn_s_memrealtime(); while (__builtin_amdgcn_s_memrealtime() - te < PROBE_MULT * pdt_) __builtin_amdgcn_s_sleep(8); }
#undef IN
#undef BOTH
}

extern "C" void kernel_launch(void* const* d_in, const int* in_sizes, int n_in, void* d_out, int out_size, void* d_ws, size_t ws_size, hipStream_t stream) {
    static int grid = 0;
    if (grid == 0) {
        if (n_in != 23 || out_size != pg8::OUT_TOTAL || ws_size < WS_END) { fprintf(stderr, "kernel_launch: unexpected shapes: n_in %d out %d ws %zu (need >= %zu)\n", n_in, out_size, ws_size, (size_t)WS_END); grid = -1; return; }
        int dev = 0, cus = 0, per_cu = 0;
        if (hipGetDevice(&dev) != hipSuccess || hipDeviceGetAttribute(&cus, hipDeviceAttributeMultiprocessorCount, dev) != hipSuccess) { grid = -1; return; }
        if (hipFuncSetAttribute((const void*)mk_fwd, hipFuncAttributeMaxDynamicSharedMemorySize, LDS_BYTES) != hipSuccess) { fprintf(stderr, "kernel_launch: hipFuncSetAttribute failed\n"); grid = -1; return; }
        if (hipOccupancyMaxActiveBlocksPerMultiprocessor(&per_cu, (const void*)mk_fwd, NWAVES * 64, LDS_BYTES) != hipSuccess || per_cu < 1) { fprintf(stderr, "kernel_launch: occupancy query says %d\n", per_cu); (void)hipGetLastError(); grid = -1; return; }
        grid = cus;
    }
    if (grid < 0) return;
    (void)hipMemsetAsync((char*)d_ws + WS_CTL, 0, CTL_ZERO_BYTES, stream);
    Args a{};
    for (int i = 0; i < 23; ++i) a.in[i] = (const float*)d_in[i];
    a.out = (float*)d_out; a.ws = (unsigned char*)d_ws;
    if (N_LAUNCHES == 1) {
        a.ph_lo = 0; a.ph_hi = N_PHASES;
        void* kargs[] = {&a};
        hipError_t e = hipLaunchCooperativeKernel((const void*)mk_fwd, dim3(grid), dim3(NWAVES * 64), kargs, LDS_BYTES, stream);
        if (e != hipSuccess) fprintf(stderr, "kernel_launch: cooperative launch failed: %s (grid %d)\n", hipGetErrorString(e), grid);
    } else {
        for (int p = 0; p < N_PHASES; ++p) { a.ph_lo = p; a.ph_hi = p + 1;
            hipLaunchKernelGGL(mk_fwd, dim3(grid), dim3(NWAVES * 64), LDS_BYTES, stream, a); }
    }
}
```
